# Optimizing an MI355X kernel written in HIP

```python
import jax, jax.numpy as jnp
from jax import lax
import numpy as np

D_MODEL = 1024
BATCH = 1
SEQ = 16384
DEPTH = 1
DEC_BATCH = 16
DEC_SEQ = 4096
PAST_LEN = 128

M_HEADS = 4
M_HEAD_DIM = 128
M_WIDTH = M_HEADS * M_HEAD_DIM
M_CHUNK = 128
A_HEADS = 8
A_KV_HEADS = 4
A_HEAD_DIM = 64
A_WIDTH = A_HEADS * A_HEAD_DIM
A_KV_WIDTH = A_KV_HEADS * A_HEAD_DIM
WINDOW = 128
A_BLOCK = 128
ROT_DIM = A_HEAD_DIM // 4
ROPE_THETA = 500000.0
D_FF = 2816
CONV_WIDTH = 3
EPS = 1e-6
D_IN = 4 * M_WIDTH + 4 * M_HEADS + A_WIDTH + 2 * A_KV_WIDTH + 2 * D_MODEL

kernel_name = "bidir_mlstm_swa_hybrid_encoder"


def _split_points():
    sizes = [M_WIDTH] * 4 + [2 * M_HEADS] * 2 + [A_WIDTH, A_KV_WIDTH, A_KV_WIDTH, D_MODEL, D_MODEL]
    return np.cumsum(sizes)[:-1].tolist()


def rmsnorm(x, w):
    xf = x.astype(jnp.float32)
    y = xf * lax.rsqrt(jnp.mean(xf * xf, axis=-1, keepdims=True) + EPS)
    return (y * w.astype(jnp.float32)).astype(x.dtype)


def mlstm_chunkwise(q, k, v, i_pre, f_pre):
    B, H, S, dh = q.shape
    L = M_CHUNK
    N = S // L
    q = q.reshape(B, H, N, L, dh)
    k = k.reshape(B, H, N, L, dh)
    v = v.reshape(B, H, N, L, dh)
    ig = i_pre.reshape(B, H, N, L)
    b = jnp.cumsum(jax.nn.log_sigmoid(f_pre).reshape(B, H, N, L), axis=-1)
    b_tot = b[..., -1]
    a = b_tot[..., None] - b + ig
    m_loc = jnp.max(a, axis=-1)
    wgt = jnp.exp(a - m_loc[..., None])
    C_loc = jnp.einsum('bhnlk,bhnlv->bhnkv', wgt[..., None] * k, v)
    n_loc = jnp.einsum('bhnl,bhnlk->bhnk', wgt, k)

    def step(carry, inp):
        C, n, m = carry
        bt, ml, Cl, nl = inp
        m_new = jnp.maximum(bt + m, ml)
        s_prev = jnp.exp(bt + m - m_new)
        s_loc = jnp.exp(ml - m_new)
        C_new = s_prev[..., None, None] * C + s_loc[..., None, None] * Cl
        n_new = s_prev[..., None] * n + s_loc[..., None] * nl
        return (C_new, n_new, m_new), (C, n, m)

    init = (jnp.zeros((B, H, dh, dh), jnp.float32), jnp.zeros((B, H, dh), jnp.float32),
            jnp.zeros((B, H), jnp.float32))
    xs = (jnp.moveaxis(b_tot, 2, 0), jnp.moveaxis(m_loc, 2, 0),
          jnp.moveaxis(C_loc, 2, 0), jnp.moveaxis(n_loc, 2, 0))
    _, (C_prev, n_prev, m_prev) = lax.scan(step, init, xs)
    C_prev = jnp.moveaxis(C_prev, 0, 2)
    n_prev = jnp.moveaxis(n_prev, 0, 2)
    m_prev = jnp.moveaxis(m_prev, 0, 2)

    D = b[..., :, None] - b[..., None, :] + ig[..., None, :]
    tril = jnp.tril(jnp.ones((L, L), dtype=bool))
    D = jnp.where(tril, D, -jnp.inf)
    inter_log = b + m_prev[..., None]
    m_t = jnp.maximum(inter_log, jnp.max(D, axis=-1))
    Dw = jnp.exp(D - m_t[..., None])
    inter_w = jnp.exp(inter_log - m_t)
    qk = jnp.einsum('bhntd,bhnsd->bhnts', q, k) * Dw
    num = jnp.einsum('bhnts,bhnsd->bhntd', qk, v) + inter_w[..., None] * jnp.einsum('bhntk,bhnkv->bhntv', q, C_prev)
    den = jnp.sum(qk, axis=-1) + inter_w * jnp.einsum('bhntk,bhnk->bhnt', q, n_prev)
    h = num / jnp.maximum(jnp.abs(den), jnp.exp(-m_t))[..., None]
    return h.reshape(B, H, S, dh)


def rope_partial(x, pos):
    half = ROT_DIM // 2
    inv = ROPE_THETA ** (-jnp.arange(half, dtype=jnp.float32) / half)
    ang = pos.astype(jnp.float32)[:, None] * inv[None, :]
    cos, sin = jnp.cos(ang), jnp.sin(ang)
    xr = x[..., :ROT_DIM].astype(jnp.float32)
    x1, x2 = xr[..., :half], xr[..., half:]
    rot = jnp.concatenate([x1 * cos - x2 * sin, x2 * cos + x1 * sin], axis=-1)
    return jnp.concatenate([rot.astype(x.dtype), x[..., ROT_DIM:]], axis=-1)


def window_attention(q, k, v, sinks):
    B, Hq, S, dh = q.shape
    Hkv = k.shape[1]
    G = Hq // Hkv
    L = A_BLOCK
    N = S // L
    qb = q.reshape(B, Hkv, G, N, L, dh)

    def band(t):
        tp = jnp.pad(t, ((0, 0), (0, 0), (L, L), (0, 0))).reshape(B, Hkv, N + 2, L, dh)
        return jnp.concatenate([tp[:, :, :-2], tp[:, :, 1:-1], tp[:, :, 2:]], axis=3)

    kb, vb = band(k), band(v)
    s = jnp.einsum('bhgnqd,bhnkd->bhgnqk', qb, kb).astype(jnp.float32) * (dh ** -0.5)
    qi = jnp.arange(L)
    kj = jnp.arange(3 * L)
    rel = kj[None, :] - L - qi[:, None]
    key_pos = jnp.arange(N)[:, None] * L - L + kj[None, :]
    mask = (jnp.abs(rel) <= WINDOW)[None, :, :] & ((key_pos >= 0) & (key_pos < S))[:, None, :]
    s = jnp.where(mask, s, -jnp.inf)
    sink = sinks.astype(jnp.float32).reshape(Hkv, G)[None, :, :, None, None, None]
    m = jnp.maximum(jnp.max(s, axis=-1, keepdims=True), sink)
    p = jnp.exp(s - m)
    p = p / (jnp.sum(p, axis=-1, keepdims=True) + jnp.exp(sink - m))
    o = jnp.einsum('bhgnqk,bhnkd->bhgnqd', p.astype(v.dtype), vb)
    return o.reshape(B, Hq, S, dh)


def hybrid_mixer(xn, w_in, i_bias, f_bias, mh_norm_w, attn_sink, w_proj_m, w_proj_a, w_out):
    B, S, _ = xn.shape
    proj = xn @ w_in
    mq, mk, mv, mo, mig, mfg, aq, ak, av, gm, ga = jnp.split(proj, _split_points(), axis=-1)

    def heads(t, H):
        return t.reshape(B, S, H, -1).transpose(0, 2, 1, 3)

    f32 = jnp.float32
    q = heads(mq, M_HEADS).astype(f32)
    k = heads(mk, M_HEADS).astype(f32) * (M_HEAD_DIM ** -0.5)
    v = heads(mv, M_HEADS).astype(f32)
    ig = (mig.astype(f32).reshape(B, S, 2, M_HEADS) + i_bias.astype(f32)).transpose(2, 0, 3, 1)
    fg = (mfg.astype(f32).reshape(B, S, 2, M_HEADS) + f_bias.astype(f32)).transpose(2, 0, 3, 1)
    flip = lambda t: jnp.flip(t, axis=2)
    h_fwd = mlstm_chunkwise(q, k, v, ig[0], fg[0])
    h_bwd = flip(mlstm_chunkwise(flip(q), flip(k), flip(v), flip(ig[1]), flip(fg[1])))
    h = h_fwd + h_bwd
    h = h - jnp.mean(h, axis=-1, keepdims=True)
    h = h * lax.rsqrt(jnp.mean(h * h, axis=-1, keepdims=True) + EPS)
    h = h.transpose(0, 2, 1, 3).reshape(B, S, M_WIDTH) * mh_norm_w.astype(f32)
    h = (jax.nn.sigmoid(mo.astype(f32)) * h).astype(xn.dtype)
    y_m = h @ w_proj_m

    pos = jnp.arange(S)
    qa = rope_partial(heads(aq, A_HEADS), pos)
    ka = rope_partial(heads(ak, A_KV_HEADS), pos)
    va = heads(av, A_KV_HEADS)
    oa = window_attention(qa, ka, va, attn_sink)
    y_a = oa.transpose(0, 2, 1, 3).reshape(B, S, A_WIDTH) @ w_proj_a

    y = jax.nn.sigmoid(gm) * y_m + jax.nn.sigmoid(ga) * y_a
    return y @ w_out


def conv_ffn(xn, w_up, conv_w, conv_b, w_down):
    S = xn.shape[1]
    u = xn @ w_up
    pad = CONV_WIDTH // 2
    up = jnp.pad(u, ((0, 0), (pad, pad), (0, 0)))
    u = sum(up[:, j:j + S] * conv_w[j] for j in range(CONV_WIDTH)) + conv_b
    a, b = jnp.split(u, 2, axis=-1)
    return (jax.nn.silu(a) * b) @ w_down


def encoder(x, norm1_w, w_in, i_bias, f_bias, mh_norm_w, attn_sink, w_proj_m, w_proj_a, w_out,
            norm2_w, w_up, conv_w, conv_b, w_down, norm_f_w):
    for l in range(DEPTH):
        x = x + hybrid_mixer(rmsnorm(x, norm1_w[l]), w_in[l], i_bias[l], f_bias[l], mh_norm_w[l],
                             attn_sink[l], w_proj_m[l], w_proj_a[l], w_out[l])
        x = x + conv_ffn(rmsnorm(x, norm2_w[l]), w_up[l], conv_w[l], conv_b[l], w_down[l])
    return rmsnorm(x, norm_f_w)


def setup_inputs(seed: int = 0) -> dict:
    key = jax.random.key(seed)
    ks = jax.random.split(key, 18)
    f32 = jnp.float32
    nrm = lambda k, shape: jax.random.normal(k, shape, f32)
    lin = lambda k, shape, fan_in: nrm(k, shape) * (fan_in ** -0.5)
    return {
        "x_prompt": nrm(ks[0], (BATCH, SEQ, D_MODEL)),
        "x_sample": nrm(ks[1], (DEC_BATCH, DEC_SEQ, D_MODEL)),
        "norm1_w": 1.0 + 0.02 * nrm(ks[2], (DEPTH, D_MODEL)),
        "w_in": lin(ks[3], (DEPTH, D_MODEL, D_IN), D_MODEL),
        "i_bias": 0.1 * nrm(ks[4], (DEPTH, 2, M_HEADS)),
        "f_bias": jax.random.uniform(ks[5], (DEPTH, 2, M_HEADS), f32, 3.0, 6.0),
        "mh_norm_w": 1.0 + 0.02 * nrm(ks[6], (DEPTH, M_WIDTH)),
        "attn_sink": 0.5 * nrm(ks[7], (DEPTH, A_HEADS)),
        "w_proj_m": lin(ks[8], (DEPTH, M_WIDTH, D_MODEL), M_WIDTH),
        "w_proj_a": lin(ks[9], (DEPTH, A_WIDTH, D_MODEL), A_WIDTH),
        "w_out": lin(ks[10], (DEPTH, D_MODEL, D_MODEL), D_MODEL),
        "norm2_w": 1.0 + 0.02 * nrm(ks[11], (DEPTH, D_MODEL)),
        "w_up": lin(ks[12], (DEPTH, D_MODEL, 2 * D_FF), D_MODEL),
        "conv_w": lin(ks[13], (DEPTH, CONV_WIDTH, 2 * D_FF), CONV_WIDTH),
        "conv_b": 0.02 * nrm(ks[14], (DEPTH, 2 * D_FF)),
        "w_down": lin(ks[15], (DEPTH, D_FF, D_MODEL), D_FF),
        "norm_f_w": 1.0 + 0.02 * nrm(ks[16], (D_MODEL,)),
    }


def reference(x_prompt, x_sample, norm1_w, w_in, i_bias, f_bias, mh_norm_w, attn_sink, w_proj_m, w_proj_a,
              w_out, norm2_w, w_up, conv_w, conv_b, w_down, norm_f_w):
    y_prompt = encoder(x_prompt, norm1_w, w_in, i_bias, f_bias, mh_norm_w, attn_sink, w_proj_m, w_proj_a,
                       w_out, norm2_w, w_up, conv_w, conv_b, w_down, norm_f_w)
    y_sample = encoder(x_sample, norm1_w, w_in, i_bias, f_bias, mh_norm_w, attn_sink, w_proj_m, w_proj_a,
                       w_out, norm2_w, w_up, conv_w, conv_b, w_down, norm_f_w)
    return (y_prompt, y_sample)
```

```cpp
#include <hip/hip_runtime.h>
#include <hip/hip_cooperative_groups.h>
#include <cstdio>
#include <cstdint>
namespace cg = cooperative_groups;

#ifndef DUP_MASK
#define DUP_MASK 0
#endif
#ifndef MK_SINGLE
#define MK_SINGLE 1
#endif

#define LAS __attribute__((address_space(3)))
#define DI __device__ __forceinline__
typedef unsigned short bf16_t;
typedef short bf16x8 __attribute__((ext_vector_type(8)));
typedef short s16x4 __attribute__((ext_vector_type(4)));
typedef float f32x4 __attribute__((ext_vector_type(4)));
typedef unsigned u32x4 __attribute__((ext_vector_type(4)));
typedef unsigned u32x2 __attribute__((ext_vector_type(2)));

constexpr int MTOK = 81920, DM = 1024, NPROJ = 5120, DIN = 5136, DFF = 2816, NUP = 5632;
constexpr int NCHUNK = 640, PROMPT = 16384;
constexpr float EPS = 1e-6f;
constexpr int ST_ELEMS = 129 * 128;
constexpr size_t ST_BYTES = (size_t)ST_ELEMS * 2;

constexpr size_t MiB = 1u << 20;
constexpr size_t WS_BAR = 512 * 1024;
constexpr size_t WS_CTL = 0;
constexpr size_t WS_W1 = 2 * MiB, WS_WPM = 13 * MiB, WS_WPA = 14 * MiB, WS_WO = 15 * MiB, WS_WUP = 17 * MiB, WS_WD = 28 * MiB;
constexpr size_t WS_ROPE = 34 * MiB, WS_GATES = 35 * MiB, WS_SS = 40 * MiB, WS_CHSC = 46 * MiB, WS_MPREV = 47 * MiB;
constexpr size_t WS_MQ = 64 * MiB, WS_MK = 144 * MiB, WS_MV = 224 * MiB, WS_MO = 304 * MiB, WS_AQ = 384 * MiB, WS_AK = 464 * MiB, WS_AV = 504 * MiB,
                 WS_GM = 544 * MiB, WS_GA = 704 * MiB, WS_END = 864 * MiB;
constexpr size_t WS_Y = 64 * MiB, WS_HN = 224 * MiB, WS_G = 384 * MiB;
constexpr size_t WS_OA = 864 * MiB, WS_HM = 944 * MiB, WS_END2 = 1024 * MiB;
constexpr size_t OUT_CST = 0;
constexpr size_t WS_XN = WS_GM, WS_QSCR = WS_GA;
constexpr size_t WS_HMOA = 864 * MiB;
constexpr int LDS_BYTES = 152064;

typedef __bf16 bf16n2 __attribute__((ext_vector_type(2)));
typedef float f32n2 __attribute__((ext_vector_type(2)));
DI unsigned pk2(float lo, float hi) { const f32n2 v = {lo, hi}; return __builtin_bit_cast(unsigned, __builtin_convertvector(v, bf16n2)); }
DI unsigned f2bf(float f) { return pk2(f, f) & 0xffffu; }
DI float bflo(unsigned w) { return __uint_as_float(w << 16); }
DI float bfhi(unsigned w) { return __uint_as_float(w & 0xffff0000u); }
DI unsigned cvt_pk_bf16_asm(float lo, float hi) { unsigned r; asm volatile("v_cvt_pk_bf16_f32 %0, %1, %2" : "=v"(r) : "v"(lo), "v"(hi)); return r; }
DI unsigned cvt_pk_bf16(float lo, float hi) { return pk2(lo, hi); }
DI float wave_sum(float v) {
#pragma unroll
    for (int o = 1; o < 64; o <<= 1) v += __shfl_xor(v, o);
    return v;
}
DI float sigmoidf_(float x) { return __builtin_amdgcn_rcpf(1.f + __expf(-x)); }
DI float logsigmoid_(float x) { return x >= 0.f ? -log1pf(expf(-x)) : x - log1pf(expf(x)); }
#define MFMA16(a, b, c) __builtin_amdgcn_mfma_f32_16x16x32_bf16((a), (b), (c), 0, 0, 0)
DI bf16x8 pack8(const float (&p)[8]) {
    u32x4 w; w.x = pk2(p[0], p[1]); w.y = pk2(p[2], p[3]); w.z = pk2(p[4], p[5]); w.w = pk2(p[6], p[7]);
    return __builtin_bit_cast(bf16x8, w);
}
DI const float* xrow_ptr(const float* xp, const float* xs, int t) { return t < PROMPT ? xp + (size_t)t * DM : xs + (size_t)(t - PROMPT) * DM; }
DI bool seq_start(int t) { return t == 0 || (t >= PROMPT && (t & 4095) == 0); }

namespace pg8 {
constexpr int BM = 256, BK = 64, HALF = 128, HTB = HALF * BK * 2, STAGE_BYTES = 8 * HTB, NXCD = 8, WGM = 8;
DI int lds_byte(int r, int c) { const int st = (r >> 4) * 2 + (c >> 5), rr = r & 15, cc = c & 31, ob = rr * 64 + cc * 2; return st * 1024 + (ob ^ (((ob >> 9) & 1) << 5)); }
DI void stage_rc(int b, int& R, int& C) { const int st = b / 1024, sb = b % 1024, swz = sb ^ (((sb >> 9) & 1) << 5); R = (st >> 1) * 16 + swz / 64; C = (st & 1) * 32 + (swz % 64) / 2; }
DI int perm32(int rho) { const int n = rho >> 4, i = rho & 15; return 8 * (i >> 2) + 4 * n + (i & 3); }

struct Unit { int pm, pn, sel; };
struct Gemm { const bf16_t* A; const bf16_t* Bt; const bf16_t* A2; const bf16_t* Bt2; int K; int ntk = 0; };

struct StaticOrder {
    int nM, nN, nwg, G, c;
    DI void init(int nM_, int nN_, int G_, int c_) { nM = nM_; nN = nN_; nwg = nM * nN; G = G_; c = c_; }
    DI bool next(int i, Unit& u) const {
        const long L = (long)i * G + c; if (L >= nwg) return false;
        int wgid = (int)L; { const int q = nwg / NXCD, r = nwg % NXCD, xcd = wgid % NXCD, off = wgid / NXCD; wgid = (xcd < r ? xcd * (q + 1) : r * (q + 1) + (xcd - r) * q) + off; }
        const int nig = WGM * nN, gid = wgid / nig, fm = gid * WGM, gsz = (nM - fm) < WGM ? (nM - fm) : WGM;
        u.pm = fm + ((wgid % nig) % gsz); u.pn = (wgid % nig) / gsz; u.sel = 0; return true;
    }
};
struct DupOrder { StaticOrder s; int dup; DI bool next(int i, Unit& u) const { return s.next(dup ? (i >> 1) : i, u); } };
struct TileOrder { int pm, pn; DI bool next(int i, Unit& u) const { if (i >= 2) return false; u.pm = pm; u.pn = pn; u.sel = i; return true; } };
struct PairOrder {
    StaticOrder s;
    DI bool next(int i, Unit& u) const { if (!s.next(i >> 1, u)) return false; u.sel = i & 1; return true; }
};

template <class Epi, class Sched, bool ALIGN_EPI, bool CONVA>
DI void gemm_phase(LAS unsigned char* lds, const Gemm g, const Sched& S, const Epi& E) {
    const int tid = threadIdx.x, wid = __builtin_amdgcn_readfirstlane(tid >> 6), lane = tid & 63, wr = wid >> 2, wc = wid & 3, fr = lane & 15, fq = lane >> 4;
    const int K = g.K; const int nt = g.ntk ? g.ntk : K / BK;
    unsigned voffA[2], voffB[2];
#pragma unroll
    for (int i = 0; i < 2; ++i) { int R, C; stage_rc(tid * 16 + i * 8192, R, C); const int Rb = Epi::PERM ? ((R & ~31) + perm32(R & 31)) : R;
        const int Ra = CONVA ? (128 * (R >> 6) + 8 * (R & 15) + ((R >> 4) & 3)) : R;
        voffA[i] = (unsigned)(Ra * K + C) * 2u; voffB[i] = (unsigned)(Rb * K + C) * 2u; }
    const size_t kstep = (size_t)(BK * 2);
    const size_t hstepB = (size_t)HALF * K * 2, tstepB = 2 * hstepB;
    const size_t hstepA = CONVA ? (size_t)4 * K * 2 : hstepB, tstepA = CONVA ? (size_t)254 * K * 2 : tstepB;
    const long abias = CONVA ? -(long)K * 2 : 0;
    const unsigned ldsw = (unsigned)wid * 1024u;
    const int aoff = lds_byte(wr * 64 + fr, fq * 8), boff = lds_byte(wc * 32 + fr, fq * 8);
#define PG8_SA(b, h) (((b) * 2 + (h)) * HTB)
#define PG8_SB(b, h) ((4 + (b) * 2 + (h)) * HTB)
#define PG8_STAGE(bufoff, gbase, voff) do { _Pragma("unroll") for (int _i = 0; _i < 2; ++_i) \
        __builtin_amdgcn_global_load_lds((const unsigned*)((const char*)(gbase) + (voff)[_i]), (LAS unsigned*)(lds + (bufoff) + ldsw + _i * 8192), 16, 0, 0); } while (0)
#define PG8_LDA(dst, b, h) do { _Pragma("unroll") for (int m = 0; m < 4; ++m) _Pragma("unroll") for (int k = 0; k < 2; ++k) dst[m][k] = *(const LAS bf16x8*)(lds + PG8_SA(b, h) + aoff + m * 2048 + k * 1024); } while (0)
#define PG8_LDB(dst, b, h) do { _Pragma("unroll") for (int n = 0; n < 2; ++n) _Pragma("unroll") for (int k = 0; k < 2; ++k) dst[n][k] = *(const LAS bf16x8*)(lds + PG8_SB(b, h) + boff + n * 2048 + k * 1024); } while (0)
#define PG8_MMA(ai, bj, At, Bt) do { __builtin_amdgcn_s_setprio(1); _Pragma("unroll") for (int m = 0; m < 4; ++m) _Pragma("unroll") for (int n = 0; n < 2; ++n) _Pragma("unroll") for (int k = 0; k < 2; ++k) \
        acc[ai][bj][m][n] = __builtin_amdgcn_mfma_f32_16x16x32_bf16(Bt[n][k], At[m][k], acc[ai][bj][m][n], 0, 0, 0); __builtin_amdgcn_s_setprio(0); } while (0)
#define PG8_WAIT_V(n) asm volatile("s_waitcnt vmcnt(" #n ")" ::: "memory")
#define PG8_WAIT_L(n) asm volatile("s_waitcnt lgkmcnt(" #n ")" ::: "memory")
#define PG8_WAIT_VN(n) asm volatile("s_waitcnt vmcnt(%0)" :: "n"(n) : "memory")
#define PG8_BAR __builtin_amdgcn_s_barrier()
#define PG8_SCHED __builtin_amdgcn_sched_barrier(0)
    Unit cur, nxt; int ui = 0;
    if (!S.next(0, cur)) return;
    f32x4 acc[2][2][4][2];
#pragma unroll
    for (int a = 0; a < 2; ++a)
#pragma unroll
        for (int b = 0; b < 2; ++b)
#pragma unroll
            for (int m = 0; m < 4; ++m)
#pragma unroll
                for (int n = 0; n < 2; ++n) acc[a][b][m][n] = (f32x4){0.f, 0.f, 0.f, 0.f};
    bf16x8 At[4][2], B0[2][2], B1[2][2];
    const char* cA = (const char*)(cur.sel ? g.A2 : g.A) + (size_t)cur.pm * tstepA + abias; const char* cB = (const char*)(cur.sel ? g.Bt2 : g.Bt) + (size_t)cur.pn * tstepB;
    PG8_STAGE(PG8_SB(0, 0), cB, voffB); PG8_STAGE(PG8_SB(0, 1), cB + hstepB, voffB); PG8_STAGE(PG8_SA(0, 0), cA, voffA); PG8_STAGE(PG8_SA(0, 1), cA + hstepA, voffA);
    if (wr == 1) PG8_BAR;
    PG8_WAIT_V(2); PG8_BAR;
    PG8_STAGE(PG8_SB(1, 0), cB + kstep, voffB); PG8_STAGE(PG8_SA(1, 0), cA + kstep, voffA); PG8_STAGE(PG8_SB(1, 1), cB + hstepB + kstep, voffB);
    PG8_WAIT_V(6); PG8_BAR;
    for (;;) {
        const bool has_next = S.next(ui + 1, nxt);
        const char* nA = has_next ? (const char*)(nxt.sel ? g.A2 : g.A) + (size_t)nxt.pm * tstepA + abias : cA;
        const char* nB = has_next ? (const char*)(nxt.sel ? g.Bt2 : g.Bt) + (size_t)nxt.pn * tstepB : cB;
#define PG8_KBODY(W12) do { \
            PG8_LDB(B0, 0, 0); PG8_LDB(B1, 0, 1); PG8_SCHED; PG8_LDA(At, 0, 0); PG8_STAGE(PG8_SA(1, 1), a1 + hstepA, voffA); \
            W12; PG8_WAIT_L(0); PG8_BAR; PG8_MMA(0, 0, At, B0); PG8_MMA(0, 1, At, B1); PG8_BAR; PG8_SCHED; \
            PG8_LDA(At, 0, 1); PG8_STAGE(PG8_SB(0, 0), b2, voffB); PG8_STAGE(PG8_SB(0, 1), b2 + hstepB, voffB); PG8_STAGE(PG8_SA(0, 0), a2, voffA); \
            W12; PG8_WAIT_L(0); PG8_BAR; PG8_MMA(1, 0, At, B0); PG8_MMA(1, 1, At, B1); PG8_BAR; PG8_SCHED; \
            PG8_LDB(B0, 1, 0); PG8_LDB(B1, 1, 1); PG8_SCHED; PG8_LDA(At, 1, 0); PG8_STAGE(PG8_SA(0, 1), a2 + hstepA, voffA); \
            PG8_WAIT_V(8); PG8_WAIT_L(0); PG8_BAR; PG8_MMA(0, 0, At, B0); PG8_MMA(0, 1, At, B1); PG8_BAR; PG8_SCHED; \
            PG8_LDA(At, 1, 1); PG8_STAGE(PG8_SB(1, 0), b3, voffB); PG8_STAGE(PG8_SB(1, 1), b3 + hstepB, voffB); PG8_STAGE(PG8_SA(1, 0), a3, voffA); \
            PG8_WAIT_V(8); PG8_WAIT_L(0); PG8_BAR; PG8_MMA(1, 0, At, B0); PG8_MMA(1, 1, At, B1); PG8_BAR; PG8_SCHED; } while (0)
        for (int t = 0; t < nt; t += 2) {
            const bool last = (t == nt - 2);
            const char* a1 = cA + (size_t)(t + 1) * kstep;
            const char* a2 = last ? nA : cA + (size_t)(t + 2) * kstep; const char* b2 = last ? nB : cB + (size_t)(t + 2) * kstep;
            const char* a3 = a2 + kstep; const char* b3 = b2 + kstep;
            PG8_KBODY(PG8_WAIT_V(8));
        }
#undef PG8_KBODY
        if constexpr (ALIGN_EPI) { if (wr == 0) PG8_BAR; }
        E(acc, cur, wr, wc, fr, fq);
        if (!has_next) break;
        if (!E.keep(cur)) {
#pragma unroll
            for (int a = 0; a < 2; ++a)
#pragma unroll
                for (int b = 0; b < 2; ++b)
#pragma unroll
                    for (int m = 0; m < 4; ++m)
#pragma unroll
                        for (int n = 0; n < 2; ++n) acc[a][b][m][n] = (f32x4){0.f, 0.f, 0.f, 0.f};
        }
        cur = nxt; cA = nA; cB = nB; ++ui;
        if constexpr (ALIGN_EPI) { if (wr == 1) PG8_BAR; }
    }
    PG8_WAIT_V(0);
    if constexpr (!ALIGN_EPI) { if (wr == 0) PG8_BAR; }
    PG8_BAR;
#undef PG8_SA
#undef PG8_SB
#undef PG8_STAGE
#undef PG8_LDA
#undef PG8_LDB
#undef PG8_MMA
#undef PG8_WAIT_V
#undef PG8_WAIT_L
#undef PG8_WAIT_VN
#undef PG8_BAR
#undef PG8_SCHED
}

struct EpiProj {
    static constexpr bool PERM = true; static constexpr int NVM = 16;
    unsigned char* ws;
    DI bool keep(const Unit&) const { return false; }
    DI void operator()(f32x4 (&acc)[2][2][4][2], const Unit& u, int wr, int wc, int fr, int fq) const {
        const int ct = u.pn; bf16_t* base; int ldc, colt;
        if (ct < 8) { base = (bf16_t*)(ws + WS_MQ + (size_t)(ct >> 1) * (80 * MiB)); ldc = 512; colt = (ct & 1) * 256; }
        else if (ct < 10) { base = (bf16_t*)(ws + WS_AQ); ldc = 512; colt = (ct - 8) * 256; }
        else if (ct == 10) { base = (bf16_t*)(ws + WS_AK); ldc = 256; colt = 0; }
        else if (ct == 11) { base = (bf16_t*)(ws + WS_AV); ldc = 256; colt = 0; }
        else if (ct < 16) { base = (bf16_t*)(ws + WS_GM); ldc = 1024; colt = (ct - 12) * 256; }
        else { base = (bf16_t*)(ws + WS_GA); ldc = 1024; colt = (ct - 16) * 256; }
        const int row0 = u.pm * BM + wr * 64 + fr, col0 = colt + wc * 32 + 8 * fq;
#pragma unroll
        for (int ai = 0; ai < 2; ++ai)
#pragma unroll
            for (int m = 0; m < 4; ++m) { bf16_t* rowp = base + (size_t)(row0 + ai * HALF + m * 16) * ldc + col0;
#pragma unroll
                for (int bj = 0; bj < 2; ++bj) { const f32x4 v0 = acc[ai][bj][m][0], v1 = acc[ai][bj][m][1];
                    u32x4 w; w.x = cvt_pk_bf16(v0[0], v0[1]); w.y = cvt_pk_bf16(v0[2], v0[3]); w.z = cvt_pk_bf16(v1[0], v1[1]); w.w = cvt_pk_bf16(v1[2], v1[3]);
                    *(u32x4*)(rowp + bj * HALF) = w; } }
    }
};
#define PG8_SCR_SETUP const unsigned lo16 = (threadIdx.x & 63u) * 16u; const int wid_ = __builtin_amdgcn_readfirstlane(threadIdx.x >> 6); \
        unsigned char* sa_u = scr + ((size_t)(blockIdx.x * 2 + 0) * 8 + wid_) * 16384; unsigned char* sb_u = scr + ((size_t)(blockIdx.x * 2 + 1) * 8 + wid_) * 16384;
#define sa(k) (sa_u + (k) * 1024 + lo16)
#define sb(k) (sb_u + (k) * 1024 + lo16)
struct EpiGate {
    static constexpr bool PERM = true; static constexpr int NVM = 16;
    unsigned char* scr;
    DI bool keep(const Unit&) const { return false; }
    DI void operator()(f32x4 (&acc)[2][2][4][2], const Unit& u, int wr, int wc, int fr, int fq) const {
        PG8_SCR_SETUP
        if (u.sel == 0) {
#pragma unroll
            for (int ai = 0; ai < 2; ++ai)
#pragma unroll
                for (int m = 0; m < 4; ++m)
#pragma unroll
                    for (int bj = 0; bj < 2; ++bj) { float v[8];
#pragma unroll
                        for (int e = 0; e < 8; ++e) v[e] = sigmoidf_(acc[ai][bj][m][e >> 2][e & 3]);
                        u32x4 w; w.x = pk2(v[0], v[1]); w.y = pk2(v[2], v[3]); w.z = pk2(v[4], v[5]); w.w = pk2(v[6], v[7]);
                        *(u32x4*)sa(ai * 8 + m * 2 + bj) = w; }
        } else {
#pragma unroll
            for (int ai = 0; ai < 2; ++ai) {
                u32x4 A8[4][2];
#pragma unroll
                for (int m = 0; m < 4; ++m)
#pragma unroll
                    for (int bj = 0; bj < 2; ++bj) A8[m][bj] = *(const u32x4*)sa(ai * 8 + m * 2 + bj);
#pragma unroll
                for (int m = 0; m < 4; ++m)
#pragma unroll
                    for (int bj = 0; bj < 2; ++bj) { float r[8], b[8];
#pragma unroll
                        for (int e = 0; e < 8; ++e) { const float av = (e & 1) ? bfhi(A8[m][bj][e >> 1]) : bflo(A8[m][bj][e >> 1]); const float den = 1.f + __expf(-acc[ai][bj][m][e >> 2][e & 3]);
                            b[e] = __builtin_amdgcn_rcpf(den); r[e] = av * den; }
                        u32x4 wr_, wb_; wr_.x = pk2(r[0], r[1]); wr_.y = pk2(r[2], r[3]); wr_.z = pk2(r[4], r[5]); wr_.w = pk2(r[6], r[7]);
                        wb_.x = pk2(b[0], b[1]); wb_.y = pk2(b[2], b[3]); wb_.z = pk2(b[4], b[5]); wb_.w = pk2(b[6], b[7]);
                        *(u32x4*)sa(ai * 8 + m * 2 + bj) = wr_; *(u32x4*)sb(ai * 8 + m * 2 + bj) = wb_; }
            }
        }
    }
};
struct EpiMix {
    static constexpr bool PERM = true; static constexpr int NVM = 16;
    bf16_t* Y; unsigned char* scr;
    DI bool keep(const Unit& u) const { return u.sel == 0; }
    DI void operator()(f32x4 (&acc)[2][2][4][2], const Unit& u, int wr, int wc, int fr, int fq) const {
        PG8_SCR_SETUP
        if (u.sel == 0) {
#pragma unroll
            for (int ai = 0; ai < 2; ++ai) {
                u32x4 A8[4][2];
#pragma unroll
                for (int m = 0; m < 4; ++m)
#pragma unroll
                    for (int bj = 0; bj < 2; ++bj) A8[m][bj] = *(const u32x4*)sa(ai * 8 + m * 2 + bj);
#pragma unroll
                for (int m = 0; m < 4; ++m)
#pragma unroll
                    for (int bj = 0; bj < 2; ++bj)
#pragma unroll
                        for (int e = 0; e < 8; ++e) { const float rv = (e & 1) ? bfhi(A8[m][bj][e >> 1]) : bflo(A8[m][bj][e >> 1]); acc[ai][bj][m][e >> 2][e & 3] *= rv; }
            }
        } else {
            const int row0 = u.pm * BM + wr * 64 + fr, col0 = u.pn * BM + wc * 32 + 8 * fq;
#pragma unroll
            for (int ai = 0; ai < 2; ++ai) {
                u32x4 B8[4][2];
#pragma unroll
                for (int m = 0; m < 4; ++m)
#pragma unroll
                    for (int bj = 0; bj < 2; ++bj) B8[m][bj] = *(const u32x4*)sb(ai * 8 + m * 2 + bj);
#pragma unroll
                for (int m = 0; m < 4; ++m)
#pragma unroll
                    for (int bj = 0; bj < 2; ++bj) { float v[8];
#pragma unroll
                        for (int e = 0; e < 8; ++e) { const float bv = (e & 1) ? bfhi(B8[m][bj][e >> 1]) : bflo(B8[m][bj][e >> 1]); v[e] = acc[ai][bj][m][e >> 2][e & 3] * bv; }
                        u32x4 w; w.x = pk2(v[0], v[1]); w.y = pk2(v[2], v[3]); w.z = pk2(v[4], v[5]); w.w = pk2(v[6], v[7]);
                        *(u32x4*)(Y + (size_t)(row0 + ai * HALF + m * 16) * DM + col0 + bj * HALF) = w; }
            }
        }
    }
};
#undef PG8_SCR_SETUP
#undef sa
#undef sb
template <bool WITH_HN> struct EpiRes {
    static constexpr bool PERM = true; static constexpr int NVM = 16;
    const float* xp; const float* xs; float* out; bf16_t* hn; float* ss;
    DI bool keep(const Unit&) const { return false; }
    template <int Q> DI void ld(f32x4 (&B)[2][2][2], const Unit& u, int wr, int fr, int cb0) const {
#pragma unroll
        for (int mm = 0; mm < 2; ++mm) { const int t = u.pm * BM + (Q >> 1) * HALF + wr * 64 + (2 * (Q & 1) + mm) * 16 + fr; const float* br = xrow_ptr(xp, xs, t);
#pragma unroll
            for (int bj = 0; bj < 2; ++bj)
#pragma unroll
                for (int n = 0; n < 2; ++n) B[mm][bj][n] = *(const f32x4*)(br + cb0 + bj * HALF + 4 * n); }
    }
    template <int Q> DI void st(const f32x4 (&B)[2][2][2], const f32x4 (&acc)[2][2][4][2], const Unit& u, int wr, int wc, int fr, int fq, int cb0) const {
#pragma unroll
        for (int mm = 0; mm < 2; ++mm) { const int m = 2 * (Q & 1) + mm, ai = Q >> 1; const int t = u.pm * BM + ai * HALF + wr * 64 + m * 16 + fr; float ssq = 0.f;
#pragma unroll
            for (int bj = 0; bj < 2; ++bj) { const int c = cb0 + bj * HALF;
                const f32x4 h0 = B[mm][bj][0] + acc[ai][bj][m][0], h1 = B[mm][bj][1] + acc[ai][bj][m][1];
                ssq += ((h0[0] * h0[0] + h0[1] * h0[1]) + (h0[2] * h0[2] + h0[3] * h0[3])) + ((h1[0] * h1[0] + h1[1] * h1[1]) + (h1[2] * h1[2] + h1[3] * h1[3]));
                u32x4 w; w.x = cvt_pk_bf16(h0[0], h0[1]); w.y = cvt_pk_bf16(h0[2], h0[3]); w.z = cvt_pk_bf16(h1[0], h1[1]); w.w = cvt_pk_bf16(h1[2], h1[3]); *(u32x4*)(hn + (size_t)t * DM + c) = w; }
            ssq += __shfl_xor(ssq, 16); ssq += __shfl_xor(ssq, 32); if (fq == 0) ss[(size_t)t * 16 + u.pn * 4 + wc] = ssq; }
    }
    DI void operator()(f32x4 (&acc)[2][2][4][2], const Unit& u, int wr, int wc, int fr, int fq) const {
        const int cb0 = u.pn * BM + wc * 32 + 8 * fq;
        f32x4 B0[2][2][2], B1[2][2][2];
        ld<0>(B0, u, wr, fr, cb0); ld<1>(B1, u, wr, fr, cb0);
        st<0>(B0, acc, u, wr, wc, fr, fq, cb0); ld<2>(B0, u, wr, fr, cb0);
        st<1>(B1, acc, u, wr, wc, fr, fq, cb0); ld<3>(B1, u, wr, fr, cb0);
        st<2>(B0, acc, u, wr, wc, fr, fq, cb0); st<3>(B1, acc, u, wr, wc, fr, fq, cb0);
    }
};
DI float dpp_ror1(float x) { return __builtin_bit_cast(float, __builtin_amdgcn_update_dpp(0, __builtin_bit_cast(int, x), 0x121, 0xf, 0xf, false)); }
DI float dpp_rol1(float x) { return __builtin_bit_cast(float, __builtin_amdgcn_update_dpp(0, __builtin_bit_cast(int, x), 0x12F, 0xf, 0xf, false)); }
struct EpiConv {
    static constexpr bool PERM = true; static constexpr int NVM = 0;
    bf16_t* G; const float* ss; const float* cw; const float* cb; LAS float* xch;
    DI bool keep(const Unit&) const { return false; }
    DI void operator()(f32x4 (&acc)[2][2][4][2], const Unit& u, int wr, int wc, int fr, int fq) const {
        const int t0 = 254 * u.pm - 1 + 128 * wr + 8 * fr;
        unsigned upz = 0, dnz = 0, stm = 0;
        f32x4 P8[8];
#pragma unroll
        for (int idx = 0; idx < 8; ++idx) { const int t = t0 + idx; const int tc = t < 0 ? 0 : (t >= MTOK ? MTOK - 1 : t); P8[idx] = *(const f32x4*)(ss + (size_t)tc * 16 + 4 * fq); }
#pragma unroll
        for (int idx = 0; idx < 8; ++idx) { const int rho = 128 * wr + 8 * fr + idx, t = t0 + idx;
            const f32x4 p = P8[idx]; float s = (p[0] + p[1]) + (p[2] + p[3]); s += __shfl_xor(s, 16); s += __shfl_xor(s, 32);
            const float rs = __builtin_amdgcn_rsqf(s * (1.f / DM) + EPS);
#pragma unroll
            for (int bj = 0; bj < 2; ++bj)
#pragma unroll
                for (int n = 0; n < 2; ++n) acc[idx >> 2][bj][idx & 3][n] *= rs;
            if (seq_start(t)) upz |= 1u << idx;
            if (t + 1 >= MTOK || seq_start(t + 1)) dnz |= 1u << idx;
            if (rho >= 1 && rho <= 254 && t < MTOK) stm |= 1u << idx; }
        const bool anyb = __builtin_amdgcn_ballot_w64((upz | dnz) != 0u) != 0ull;
        f32x4 X[2][2];
        { LAS float* xw = xch + ((wr * 4 + wc) * 4 + fq) * 16; LAS const float* xr = xch + (((wr ^ 1) * 4 + wc) * 4 + fq) * 16;
          if (wr == 0) { if (fr == 15) {
#pragma unroll
              for (int bj = 0; bj < 2; ++bj)
#pragma unroll
                  for (int n = 0; n < 2; ++n) *(LAS f32x4*)(xw + (bj * 2 + n) * 4) = acc[1][bj][3][n]; } }
          else { if (fr == 0) {
#pragma unroll
              for (int bj = 0; bj < 2; ++bj)
#pragma unroll
                  for (int n = 0; n < 2; ++n) *(LAS f32x4*)(xw + (bj * 2 + n) * 4) = acc[0][bj][0][n]; } }
          asm volatile("s_waitcnt lgkmcnt(0)" ::: "memory"); __builtin_amdgcn_s_barrier(); asm volatile("" ::: "memory");
#pragma unroll
          for (int bj = 0; bj < 2; ++bj)
#pragma unroll
              for (int n = 0; n < 2; ++n) X[bj][n] = *(LAS const f32x4*)(xr + (bj * 2 + n) * 4); }
        const bool xup = (wr == 1) && (fr == 0), xdn = (wr == 0) && (fr == 15);
        f32x4 W[2][4];
#define LOADW(n_) _Pragma("unroll") for (int bj = 0; bj < 2; ++bj) { const int cc = bj * DFF + u.pn * 128 + wc * 32 + 8 * fq + 4 * (n_); \
            W[bj][0] = *(const f32x4*)(cw + cc); W[bj][1] = *(const f32x4*)(cw + NUP + cc); W[bj][2] = *(const f32x4*)(cw + 2 * NUP + cc); W[bj][3] = *(const f32x4*)(cb + cc); }
        LOADW(0)
#pragma unroll
        for (int n = 0; n < 2; ++n) {
            const int ch = u.pn * 128 + wc * 32 + 8 * fq + 4 * n;
            float ca[8][4]; unsigned pk[8][2];
#pragma unroll
            for (int bj = 0; bj < 2; ++bj) {
                const f32x4 w0 = W[bj][0], w1 = W[bj][1], w2 = W[bj][2], bb = W[bj][3];
#pragma unroll
                for (int j = 0; j < 4; ++j) {
                    float v[8];
#pragma unroll
                    for (int idx = 0; idx < 8; ++idx) v[idx] = acc[idx >> 2][bj][idx & 3][n][j];
                    float up0 = dpp_ror1(v[7]), dn7 = dpp_rol1(v[0]);
                    up0 = xup ? X[bj][n][j] : up0; dn7 = xdn ? X[bj][n][j] : dn7;
                    float cv[8];
#pragma unroll
                    for (int idx = 0; idx < 8; ++idx) { float up = idx ? v[idx > 0 ? idx - 1 : 0] : up0, dn = idx < 7 ? v[idx < 7 ? idx + 1 : 7] : dn7;
                        if (anyb) { up = ((upz >> idx) & 1u) ? 0.f : up; dn = ((dnz >> idx) & 1u) ? 0.f : dn; }
                        cv[idx] = w0[j] * up + w1[j] * v[idx] + w2[j] * dn + bb[j]; }
                    if (bj == 0) {
#pragma unroll
                        for (int idx = 0; idx < 8; ++idx) ca[idx][j] = cv[idx];
                    } else {
#pragma unroll
                        for (int idx = 0; idx < 8; ++idx) ca[idx][j] = ca[idx][j] * sigmoidf_(ca[idx][j]) * cv[idx];
                    } } }
#pragma unroll
            for (int idx = 0; idx < 8; ++idx) { pk[idx][0] = cvt_pk_bf16_asm(ca[idx][0], ca[idx][1]); pk[idx][1] = cvt_pk_bf16_asm(ca[idx][2], ca[idx][3]); }
            if (n == 0) { LOADW(1) }
#pragma unroll
            for (int idx = 0; idx < 8; ++idx) if ((stm >> idx) & 1u) { u32x2 w; w.x = pk[idx][0]; w.y = pk[idx][1]; *(u32x2*)(G + (size_t)(t0 + idx) * DFF + ch) = w; }
        }
#undef LOADW
    }
};
struct EpiFinal {
    static constexpr bool PERM = true; static constexpr int NVM = 32;
    float* out; const bf16_t* hn; const float* nfw; unsigned* xs; unsigned* cnt;
    DI bool keep(const Unit&) const { return false; }
    template <int Q> DI void ld(f32x4 (&B)[2][2][2], const Unit& u, int wr, int fr, int cb0) const {
#pragma unroll
        for (int mm = 0; mm < 2; ++mm) { const int t = u.pm * BM + (Q >> 1) * HALF + wr * 64 + (2 * (Q & 1) + mm) * 16 + fr; const bf16_t* br = hn + (size_t)t * DM;
#pragma unroll
            for (int bj = 0; bj < 2; ++bj) { const u32x4 w = *(const u32x4*)(br + cb0 + bj * HALF);
                B[mm][bj][0] = (f32x4){bflo(w.x), bfhi(w.x), bflo(w.y), bfhi(w.y)}; B[mm][bj][1] = (f32x4){bflo(w.z), bfhi(w.z), bflo(w.w), bfhi(w.w)}; } }
    }
    template <int Q> DI void add(const f32x4 (&B)[2][2][2], f32x4 (&acc)[2][2][4][2], const Unit& u, int wr, int wc, int fr, int fq) const {
#pragma unroll
        for (int mm = 0; mm < 2; ++mm) { const int m = 2 * (Q & 1) + mm, ai = Q >> 1; const int t = u.pm * BM + ai * HALF + wr * 64 + m * 16 + fr; float ssq = 0.f;
#pragma unroll
            for (int bj = 0; bj < 2; ++bj)
#pragma unroll
                for (int n = 0; n < 2; ++n) { const f32x4 hv = B[mm][bj][n] + acc[ai][bj][m][n]; acc[ai][bj][m][n] = hv; ssq += (hv[0] * hv[0] + hv[1] * hv[1]) + (hv[2] * hv[2] + hv[3] * hv[3]); }
            ssq += __shfl_xor(ssq, 16); ssq += __shfl_xor(ssq, 32);
            if (fq == 0) __hip_atomic_store(xs + (size_t)t * 16 + u.pn * 4 + wc, __float_as_uint(ssq), __ATOMIC_RELAXED, __HIP_MEMORY_SCOPE_AGENT); }
    }
    DI void operator()(f32x4 (&acc)[2][2][4][2], const Unit& u, int wr, int wc, int fr, int fq) const {
        const int lane = threadIdx.x & 63, cb0 = u.pn * BM + wc * 32 + 8 * fq;
        { f32x4 B0[2][2][2], B1[2][2][2];
          ld<0>(B0, u, wr, fr, cb0); ld<1>(B1, u, wr, fr, cb0);
          add<0>(B0, acc, u, wr, wc, fr, fq); ld<2>(B0, u, wr, fr, cb0);
          add<1>(B1, acc, u, wr, wc, fr, fq); ld<3>(B1, u, wr, fr, cb0);
          add<2>(B0, acc, u, wr, wc, fr, fq); add<3>(B1, acc, u, wr, wc, fr, fq); }
        asm volatile("s_waitcnt vmcnt(0)" ::: "memory");
        unsigned* cw_ = cnt + 64 * u.pm;
        if (lane == 0) __hip_atomic_fetch_add(cw_, 1u, __ATOMIC_RELAXED, __HIP_MEMORY_SCOPE_AGENT);
        f32x4 W4[2][2];
#pragma unroll
        for (int bj = 0; bj < 2; ++bj)
#pragma unroll
            for (int n = 0; n < 2; ++n) W4[bj][n] = *(const f32x4*)(nfw + cb0 + bj * HALF + 4 * n);
        while ((unsigned)__builtin_amdgcn_readfirstlane(__hip_atomic_load(cw_, __ATOMIC_RELAXED, __HIP_MEMORY_SCOPE_AGENT)) < 32u) __builtin_amdgcn_s_sleep(2);
        __builtin_amdgcn_fence(__ATOMIC_ACQUIRE, "agent");
        unsigned Pp[8][4];
#pragma unroll
        for (int idx = 0; idx < 8; ++idx) { const int t = u.pm * BM + (idx >> 2) * HALF + wr * 64 + (idx & 3) * 16 + fr; const unsigned* xp_ = xs + (size_t)t * 16 + 4 * fq;
#pragma unroll
            for (int q = 0; q < 4; ++q) Pp[idx][q] = __hip_atomic_load(xp_ + q, __ATOMIC_RELAXED, __HIP_MEMORY_SCOPE_AGENT); }
#pragma unroll
        for (int idx = 0; idx < 8; ++idx) { const int ai = idx >> 2, m = idx & 3; const int t = u.pm * BM + ai * HALF + wr * 64 + m * 16 + fr; float* orow = out + (size_t)t * DM;
            float s = (__uint_as_float(Pp[idx][0]) + __uint_as_float(Pp[idx][1])) + (__uint_as_float(Pp[idx][2]) + __uint_as_float(Pp[idx][3]));
            s += __shfl_xor(s, 16); s += __shfl_xor(s, 32);
            const float rs = 1.f / sqrtf(s * (1.f / DM) + EPS);
#pragma unroll
            for (int bj = 0; bj < 2; ++bj)
#pragma unroll
                for (int n = 0; n < 2; ++n) *(f32x4*)(orow + cb0 + bj * HALF + 4 * n) = acc[ai][bj][m][n] * rs * W4[bj][n]; }
    }
};
}

DI void transpose_item(const float* W, int ldw, int src_col0, int k0, bf16_t* WT, int K, int dst_row0, const float* kscale, float nscale, LAS float* scr, int lane) {
    float wv[32];
#pragma unroll
    for (int i = 0; i < 32; ++i) { const int kk = 2 * i + (lane >> 5); wv[i] = W[(size_t)(k0 + kk) * ldw + src_col0 + (lane & 31)]; }
#pragma unroll
    for (int i = 0; i < 32; ++i) { const int kk = 2 * i + (lane >> 5); const float s = kscale ? kscale[k0 + kk] * nscale : nscale;
        scr[kk * 33 + (lane & 31)] = wv[i] * s; }
    asm volatile("s_waitcnt lgkmcnt(0)" ::: "memory");
    const int c = lane & 7;
#pragma unroll
    for (int j = 0; j < 4; ++j) { const int n = (lane >> 3) + 8 * j; const LAS float* s = scr + (8 * c) * 33 + n;
        u32x4 o; o.x = pk2(s[0 * 33], s[1 * 33]); o.y = pk2(s[2 * 33], s[3 * 33]); o.z = pk2(s[4 * 33], s[5 * 33]); o.w = pk2(s[6 * 33], s[7 * 33]);
        *(u32x4*)(WT + (size_t)(dst_row0 + n) * K + k0 + 8 * c) = o; }
    asm volatile("s_waitcnt lgkmcnt(0)" ::: "memory");
}
DI float reduce16(const float (&p)[16], int lane) {
    const bool b5 = lane & 32, b4 = lane & 16, b3 = lane & 8, b2 = lane & 4;
    float q[8], r[4], s[2];
#pragma unroll
    for (int j = 0; j < 8; ++j) { const float send = b5 ? p[j] : p[j + 8], keep = b5 ? p[j + 8] : p[j]; q[j] = keep + __shfl_xor(send, 32); }
#pragma unroll
    for (int j = 0; j < 4; ++j) { const float send = b4 ? q[j] : q[j + 4], keep = b4 ? q[j + 4] : q[j]; r[j] = keep + __shfl_xor(send, 16); }
#pragma unroll
    for (int j = 0; j < 2; ++j) { const float send = b3 ? r[j] : r[j + 2], keep = b3 ? r[j + 2] : r[j]; s[j] = keep + __shfl_xor(send, 8); }
    const float send = b2 ? s[0] : s[1], keep = b2 ? s[1] : s[0]; float v = keep + __shfl_xor(send, 4);
    v += __shfl_xor(v, 2); v += __shfl_xor(v, 1); return v;
}

struct ChunkVec { float g0, g1, b0, b1, cm0, cm1, btot, gmax; int s0, s1; };
DI ChunkVec chunk_vectors(int d, const float* gates, int t0, int head, int lane) {
    ChunkVec r; const int e0 = 2 * lane, e1 = e0 + 1; r.s0 = d ? 127 - e0 : e0; r.s1 = d ? 127 - e1 : e1;
    const float* g0p = gates + (size_t)(t0 + r.s0) * 16 + d * 4 + head; const float* g1p = gates + (size_t)(t0 + r.s1) * 16 + d * 4 + head;
    const float i0 = g0p[0], f0 = g0p[8], i1 = g1p[0], f1 = g1p[8];
    const float lf0 = logsigmoid_(f0), lf1 = logsigmoid_(f1);
    float ps = lf0 + lf1;
#pragma unroll
    for (int o = 1; o < 64; o <<= 1) { const float t = __shfl_up(ps, o); if (lane >= o) ps += t; }
    const float excl = ps - (lf0 + lf1); r.b0 = excl + lf0; r.b1 = r.b0 + lf1;
    r.g0 = i0 - r.b0; r.g1 = i1 - r.b1;
    float cm = fmaxf(r.g0, r.g1);
#pragma unroll
    for (int o = 1; o < 64; o <<= 1) { const float t = __shfl_up(cm, o); if (lane >= o) cm = fmaxf(cm, t); }
    float ex = __shfl_up(cm, 1); if (lane == 0) ex = -INFINITY;
    r.cm0 = fmaxf(ex, r.g0); r.cm1 = fmaxf(r.cm0, r.g1);
    r.btot = __shfl(r.b1, 63); r.gmax = __shfl(r.cm1, 63);
    return r;
}

struct Ctx {
    const float* in[17]; float* out; unsigned char* ws;
};

DI void summary_unit(LAS unsigned char* lds, const Ctx& c, int chunk, int head, int tid, int lane, int wid) {
    asm volatile("" : "+v"(tid), "+v"(lane));
    const int t0 = chunk * 128, fr = lane & 15, fq = lane >> 4;
    LAS bf16_t* LVT = (LAS bf16_t*)lds; LAS bf16_t* LKF = (LAS bf16_t*)(lds + 34816); LAS bf16_t* LKB = (LAS bf16_t*)(lds + 69632); LAS float* vW = (LAS float*)(lds + 104448);
    const float* gates = (const float*)(c.ws + WS_GATES);
    const bf16_t* MK = (const bf16_t*)(c.ws + WS_MK); const bf16_t* MV = (const bf16_t*)(c.ws + WS_MV);
    u32x4 v8r[4], k8r[4];
#pragma unroll
    for (int i = 0; i < 4; ++i) { const int idx = tid + 512 * i, s = idx & 127, ch = idx >> 7; const size_t go = (size_t)(t0 + s) * 512 + head * 128 + ch * 8; v8r[i] = *(const u32x4*)(MV + go); k8r[i] = *(const u32x4*)(MK + go); }
    if (wid < 2) { const int d = wid; const ChunkVec v = chunk_vectors(d, gates, t0, head, lane);
        vW[d * 128 + v.s0] = __expf(v.g0 - v.gmax); vW[d * 128 + v.s1] = __expf(v.g1 - v.gmax);
        if (lane == 0) { float* sc = (float*)(c.ws + WS_CHSC) + ((size_t)(d * NCHUNK + chunk) * 4 + head) * 2; sc[0] = v.btot; sc[1] = v.btot + v.gmax; } }
    __syncthreads();
#pragma unroll
    for (int i = 0; i < 4; ++i) { const int idx = tid + 512 * i, s = idx & 127, ch = idx >> 7;
        const u32x4 v8 = v8r[i], k8 = k8r[i]; const float wf = vW[s], wb = vW[128 + s];
#pragma unroll
        for (int e = 0; e < 8; ++e) { const unsigned vw = v8[e >> 1], kw = k8[e >> 1]; const float kf = (e & 1) ? bfhi(kw) : bflo(kw);
            LVT[(8 * ch + e) * 136 + s] = (bf16_t)((e & 1) ? (vw >> 16) : (vw & 0xffffu));
            const unsigned fb = pk2(wf * kf, wb * kf); LKF[(8 * ch + e) * 136 + s] = (bf16_t)(fb & 0xffffu); LKB[(8 * ch + e) * 136 + s] = (bf16_t)(fb >> 16); } }
    __syncthreads();
    const int d = wid & 1, cgp = wid >> 1;
    LAS const unsigned char* LKD = (LAS const unsigned char*)(d ? LKB : LKF);
    bf16x8 Y[2][4];
#pragma unroll
    for (int ci = 0; ci < 2; ++ci)
#pragma unroll
        for (int ks = 0; ks < 4; ++ks) Y[ci][ks] = *(LAS const bf16x8*)(LKD + (16 * (2 * cgp + ci) + fr) * 272 + (32 * ks + 8 * fq) * 2);
    bf16_t* ST = (bf16_t*)(c.out) + ((size_t)(d * NCHUNK + chunk) * 4 + head) * ST_ELEMS;
#pragma unroll
    for (int rt = 0; rt < 9; ++rt) {
        bf16x8 X[4];
#pragma unroll
        for (int ks = 0; ks < 4; ++ks) {
            if (rt < 8) X[ks] = *(LAS const bf16x8*)((LAS const unsigned char*)LVT + (16 * rt + fr) * 272 + (32 * ks + 8 * fq) * 2);
            else { const short o = fr == 0 ? (short)0x3F80 : (short)0; X[ks] = (bf16x8){o, o, o, o, o, o, o, o}; } }
#pragma unroll
        for (int ci = 0; ci < 2; ++ci) { f32x4 a = (f32x4){0.f, 0.f, 0.f, 0.f};
#pragma unroll
            for (int ks = 0; ks < 4; ++ks) a = MFMA16(Y[ci][ks], X[ks], a);
            const int v = 16 * rt + fr, k = 16 * (2 * cgp + ci) + 4 * fq;
            if (rt < 8 || fr == 0) { u32x2 w; w.x = pk2(a[0], a[1]); w.y = pk2(a[2], a[3]); *(u32x2*)(ST + (size_t)v * 128 + k) = w; } }
    }
    __syncthreads();
}

DI void attn_unit(LAS unsigned char* lds, const Ctx& c, int qb2, int hk, int tid, int lane, int wid) {
    asm volatile("" : "+v"(tid), "+v"(lane));
    const int t0 = qb2 * 256, fr = lane & 15, fq = lane >> 4;
    const int nseq = qb2 < 64 ? qb2 : ((qb2 - 64) & 15), Nseq = qb2 < 64 ? 64 : 16, pos0 = nseq * 256;
    const bool bv0 = nseq >= 1, bv3 = nseq + 1 < Nseq;
    LAS unsigned char* LKB = lds; LAS bf16_t* LVT = (LAS bf16_t*)(lds + 73728);
    const bf16_t* AK = (const bf16_t*)(c.ws + WS_AK); const bf16_t* AV = (const bf16_t*)(c.ws + WS_AV); const bf16_t* AQ = (const bf16_t*)(c.ws + WS_AQ);
    const float* rope = (const float*)(c.ws + WS_ROPE);
    const int g = wid >> 2, rg = wid & 3, hq = 2 * hk + g, r0 = 64 * rg;
#define ATT_OK(j) ((((j) >> 7) == 0) ? bv0 : ((((j) >> 7) == 3) ? bv3 : true))
    u32x4 kb[6];
#pragma unroll
    for (int i = 0; i < 6; ++i) { const int idx = tid + 512 * i; const int j = idx / 6, ch = 2 + (idx - 6 * j); const bool ok = ATT_OK(j);
        const int tok = ok ? t0 - 128 + j : t0 + (j & 127); kb[i] = *(const u32x4*)((const char*)AK + (unsigned)((tok * 256 + hk * 64 + ch * 8) * 2)); }
    u32x4 kx1, kx2; f32x4 ktb[4];
    { const int j = tid; const bool ok = ATT_OK(j); const int tok = ok ? t0 - 128 + j : t0 + (j & 127);
      const unsigned ko = (unsigned)((tok * 256 + hk * 64) * 2); kx1 = *(const u32x4*)((const char*)AK + ko); kx2 = *(const u32x4*)((const char*)AK + ko + 16u);
      const unsigned to = (unsigned)((ok ? pos0 - 128 + j : 0) * 64);
#pragma unroll
      for (int q = 0; q < 4; ++q) ktb[q] = *(const f32x4*)((const char*)rope + to + 16u * q); }
    u32x4 vb[8];
#pragma unroll
    for (int i = 0; i < 8; ++i) { const int idx = tid + 512 * i, ch = idx >> 9, j = idx & 511; const bool ok = ATT_OK(j);
        const int tok = ok ? t0 - 128 + j : t0 + (j & 127); vb[i] = *(const u32x4*)((const char*)AV + (unsigned)((tok * 256 + hk * 64 + ch * 8) * 2)); }
#pragma unroll
    for (int i = 0; i < 6; ++i) { const int idx = tid + 512 * i; const int j = idx / 6, ch = 2 + (idx - 6 * j); const bool ok = ATT_OK(j);
        *(LAS u32x4*)(LKB + j * 144 + ch * 16) = ok ? kb[i] : (u32x4){0u, 0u, 0u, 0u}; }
    { const int j = tid; const bool ok = ATT_OK(j);
      float ra[8], rb[8];
#pragma unroll
      for (int e = 0; e < 8; ++e) { const float a = (e & 1) ? bfhi(kx1[e >> 1]) : bflo(kx1[e >> 1]), b = (e & 1) ? bfhi(kx2[e >> 1]) : bflo(kx2[e >> 1]); const float cs = ktb[e >> 2][e & 3], sn = ktb[2 + (e >> 2)][e & 3];
          ra[e] = a * cs - b * sn; rb[e] = b * cs + a * sn; }
      u32x4 o1, o2; o1.x = pk2(ra[0], ra[1]); o1.y = pk2(ra[2], ra[3]); o1.z = pk2(ra[4], ra[5]); o1.w = pk2(ra[6], ra[7]); o2.x = pk2(rb[0], rb[1]); o2.y = pk2(rb[2], rb[3]); o2.z = pk2(rb[4], rb[5]); o2.w = pk2(rb[6], rb[7]);
      if (!ok) { o1 = (u32x4){0u, 0u, 0u, 0u}; o2 = o1; }
      *(LAS u32x4*)(LKB + j * 144) = o1; *(LAS u32x4*)(LKB + j * 144 + 16) = o2; }
#pragma unroll
    for (int i = 0; i < 8; ++i) { const int idx = tid + 512 * i, ch = idx >> 9, j = idx & 511; const bool ok = ATT_OK(j);
        const u32x4 v8 = ok ? vb[i] : (u32x4){0u, 0u, 0u, 0u};
#pragma unroll
        for (int e = 0; e < 8; ++e) { const unsigned vw = v8[e >> 1]; LVT[(8 * ch + e) * 520 + j] = (bf16_t)((e & 1) ? (vw >> 16) : (vw & 0xffffu)); } }
    asm volatile("" ::: "memory");
    const float sink = c.in[7][hq] * 1.4426950408889634f;
    bf16x8 Xq[4][2];
#pragma unroll
    for (int mi = 0; mi < 4; ++mi) { const int rho = r0 + 16 * mi + fr; const unsigned qo = (unsigned)(((t0 + rho) * 512 + hq * 64 + 8 * fq) * 2);
#pragma unroll
        for (int ks = 0; ks < 2; ++ks) {
            u32x4 q = *(const u32x4*)((const char*)AQ + qo + 64u * ks);
            if (ks == 0) { u32x4 pr; pr.x = __shfl_xor(q.x, 16); pr.y = __shfl_xor(q.y, 16); pr.z = __shfl_xor(q.z, 16); pr.w = __shfl_xor(q.w, 16);
                if (fq < 2) { float r[8]; const float* tb = rope + (size_t)(pos0 + rho) * 16;
#pragma unroll
                    for (int e = 0; e < 8; ++e) { const float own = (e & 1) ? bfhi(q[e >> 1]) : bflo(q[e >> 1]), oth = (e & 1) ? bfhi(pr[e >> 1]) : bflo(pr[e >> 1]); const float cs = tb[e], sn = tb[8 + e];
                        r[e] = fq == 0 ? (own * cs - oth * sn) : (own * cs + oth * sn); }
                    q.x = pk2(r[0], r[1]); q.y = pk2(r[2], r[3]); q.z = pk2(r[4], r[5]); q.w = pk2(r[6], r[7]); } }
            Xq[mi][ks] = __builtin_bit_cast(bf16x8, q); } }
    __syncthreads();
    f32x4 O[4][4]; float mrow[4], lrow[4];
#pragma unroll
    for (int mi = 0; mi < 4; ++mi) { mrow[mi] = sink; lrow[mi] = fq == 0 ? 1.f : 0.f;
#pragma unroll
        for (int nd = 0; nd < 4; ++nd) O[mi][nd] = (f32x4){0.f, 0.f, 0.f, 0.f}; }
    for (int kt = 0; kt < 10; ++kt) {
        const int j0 = r0 + 32 * kt;
        if (!ATT_OK(j0)) continue;
#pragma unroll
        for (int mh = 0; mh < 2; ++mh) {
            const int ra0 = r0 + 32 * mh;
            if (j0 + 31 < ra0 || j0 > ra0 + 31 + 256) continue;
            f32x4 S[2][2];
#pragma unroll
            for (int m2 = 0; m2 < 2; ++m2)
#pragma unroll
                for (int ni = 0; ni < 2; ++ni) S[m2][ni] = (f32x4){0.f, 0.f, 0.f, 0.f};
#pragma unroll
            for (int ks = 0; ks < 2; ++ks)
#pragma unroll
                for (int ni = 0; ni < 2; ++ni) { const bf16x8 Yk = *(LAS const bf16x8*)(LKB + (j0 + 16 * ni + fr) * 144 + (32 * ks + 8 * fq) * 2);
#pragma unroll
                    for (int m2 = 0; m2 < 2; ++m2) S[m2][ni] = MFMA16(Yk, Xq[2 * mh + m2][ks], S[m2][ni]); }
            bf16x8 Xp[2];
#pragma unroll
            for (int m2 = 0; m2 < 2; ++m2) { const int mi = 2 * mh + m2; const int rhoa = r0 + 16 * mi, rho = rhoa + fr;
                const bool full = (j0 >= rhoa + 15) && (j0 + 31 <= rhoa + 256);
                float mx = -INFINITY;
                if (full) {
#pragma unroll
                    for (int ni = 0; ni < 2; ++ni)
#pragma unroll
                        for (int jj = 0; jj < 4; ++jj) mx = fmaxf(mx, S[m2][ni][jj]);
                } else {
#pragma unroll
                    for (int ni = 0; ni < 2; ++ni)
#pragma unroll
                        for (int jj = 0; jj < 4; ++jj) { const int j = j0 + 16 * ni + 4 * fq + jj; const bool ok = (j >= rho) && (j <= rho + 256);
                            const float sv = ok ? S[m2][ni][jj] : -INFINITY; S[m2][ni][jj] = sv; mx = fmaxf(mx, sv); }
                }
                mx = fmaxf(mx, __shfl_xor(mx, 16)); mx = fmaxf(mx, __shfl_xor(mx, 32));
                const float mnew = fmaxf(mrow[mi], mx);
                float p[8], ps = 0.f;
#pragma unroll
                for (int e = 0; e < 8; ++e) { p[e] = __builtin_amdgcn_exp2f(S[m2][e >> 2][e & 3] - mnew); ps += p[e]; }
                if (__builtin_amdgcn_ballot_w64(mnew != mrow[mi]) != 0ull) { const float alpha = __builtin_amdgcn_exp2f(mrow[mi] - mnew); mrow[mi] = mnew; lrow[mi] *= alpha;
#pragma unroll
                    for (int nd = 0; nd < 4; ++nd) O[mi][nd] *= alpha; }
                lrow[mi] += ps;
                Xp[m2] = pack8(p); }
#pragma unroll
            for (int nd = 0; nd < 4; ++nd) { const LAS bf16_t* vp = LVT + (16 * nd + fr) * 520 + j0 + 4 * fq;
                const s16x4 lo = *(LAS const s16x4*)vp, hi = *(LAS const s16x4*)(vp + 16);
                const bf16x8 Yv = (bf16x8){lo[0], lo[1], lo[2], lo[3], hi[0], hi[1], hi[2], hi[3]};
#pragma unroll
                for (int m2 = 0; m2 < 2; ++m2) O[2 * mh + m2][nd] = MFMA16(Yv, Xp[m2], O[2 * mh + m2][nd]); }
        }
    }
#pragma unroll
    for (int mi = 0; mi < 4; ++mi) { float l = lrow[mi]; l += __shfl_xor(l, 16); l += __shfl_xor(l, 32); const float inv = 1.f / l;
        bf16_t* op = (bf16_t*)(c.ws + WS_HMOA) + (size_t)(t0 + r0 + 16 * mi + fr) * 1024 + 512 + hq * 64 + 4 * fq;
#pragma unroll
        for (int nd = 0; nd < 4; ++nd) { const f32x4 o = O[mi][nd] * inv; u32x2 w; w.x = pk2(o[0], o[1]); w.y = pk2(o[2], o[3]); *(u32x2*)(op + 16 * nd) = w; } }
    __syncthreads();
#undef ATT_OK
}

DI void scan_item(const Ctx& c, int st, int slice, int lane) {
    const int seq = st >> 3, head = (st >> 1) & 3, d = st & 1;
    const int chunk0 = seq == 0 ? 0 : 128 + 32 * (seq - 1), nch = seq == 0 ? 128 : 32;
    const int e0 = slice * 512 + lane * 8; const bool act = e0 < ST_ELEMS;
    bf16_t* CST = (bf16_t*)c.out; const float* CHSC = (const float*)(c.ws + WS_CHSC); float* MP = (float*)(c.ws + WS_MPREV);
    float C[8];
#pragma unroll
    for (int e = 0; e < 8; ++e) C[e] = 0.f;
    float m = 0.f;
    for (int i0 = 0; i0 < nch; i0 += 8) {
        u32x4 ld[8]; float bt[8], ml[8];
#pragma unroll
        for (int u = 0; u < 8; ++u) { const int ch = d ? chunk0 + nch - 1 - (i0 + u) : chunk0 + i0 + u; const size_t ti = (size_t)(d * NCHUNK + ch) * 4 + head;
            ld[u] = act ? *(const u32x4*)(CST + ti * ST_ELEMS + e0) : (u32x4){0u, 0u, 0u, 0u}; bt[u] = CHSC[ti * 2]; ml[u] = CHSC[ti * 2 + 1]; }
#pragma unroll
        for (int u = 0; u < 8; ++u) { const int ch = d ? chunk0 + nch - 1 - (i0 + u) : chunk0 + i0 + u; const size_t ti = (size_t)(d * NCHUNK + ch) * 4 + head;
            if (slice == 0 && lane == 0) MP[ti] = m;
            u32x4 o; o.x = pk2(C[0], C[1]); o.y = pk2(C[2], C[3]); o.z = pk2(C[4], C[5]); o.w = pk2(C[6], C[7]);
            if (act) *(u32x4*)(CST + ti * ST_ELEMS + e0) = o;
            const float mn = fmaxf(bt[u] + m, ml[u]), sp = __expf(bt[u] + m - mn), sl = __expf(ml[u] - mn); m = mn;
#pragma unroll
            for (int e = 0; e < 8; ++e) { const unsigned w = ld[u][e >> 1]; const float cl = (e & 1) ? bfhi(w) : bflo(w); C[e] = sp * C[e] + sl * cl; } }
    }
}

template <int DIR> DI void dir_pass(const f32x4 (&S)[8], const bf16x8 (&Xq)[4], LAS const unsigned char* LS, LAS const unsigned char* LVTb, LAS const float* vec, int trow, int fr, int fq, f32x4 (&hs)[8]) {
    f32x4 acc[9];
#pragma unroll
    for (int nt = 0; nt < 9; ++nt) { acc[nt] = (f32x4){0.f, 0.f, 0.f, 0.f};
#pragma unroll
        for (int ks = 0; ks < 4; ++ks) { const bf16x8 Y = *(LAS const bf16x8*)(LS + (16 * nt + fr) * 272 + (32 * ks + 8 * fq) * 2); acc[nt] = MFMA16(Y, Xq[ks], acc[nt]); } asm volatile("" ::: "memory"); }
    const float Mt = vec[128 + trow], ex = vec[256 + trow], iw = vec[384 + trow];
#pragma unroll
    for (int nt = 0; nt < 9; ++nt) acc[nt] *= iw;
    bf16x8 Xp[4];
#pragma unroll
    for (int kp = 0; kp < 4; ++kp) { float p[8];
#pragma unroll
        for (int h2 = 0; h2 < 2; ++h2) { const int n = 2 * kp + h2; const f32x4 g4 = *(LAS const f32x4*)(vec + 16 * n + 4 * fq);
#pragma unroll
            for (int j = 0; j < 4; ++j) { const int s = 16 * n + 4 * fq + j; const bool ok = DIR == 0 ? (s <= trow) : (s >= trow);
                p[4 * h2 + j] = ok ? S[n][j] * __builtin_amdgcn_exp2f(g4[j] - Mt) : 0.f; } }
        Xp[kp] = pack8(p); }
#pragma unroll
    for (int nt = 0; nt < 8; ++nt)
#pragma unroll
        for (int kp = 0; kp < 4; ++kp) { LAS const unsigned char* vp = LVTb + (16 * nt + fr) * 272 + (32 * kp + 4 * fq) * 2;
            const s16x4 lo = *(LAS const s16x4*)vp, hi = *(LAS const s16x4*)(vp + 32);
            const bf16x8 Y = (bf16x8){lo[0], lo[1], lo[2], lo[3], hi[0], hi[1], hi[2], hi[3]};
            acc[nt] = MFMA16(Y, Xp[kp], acc[nt]); if (kp == 3) asm volatile("" ::: "memory"); }
    { const short o = fr == 0 ? (short)0x3F80 : (short)0; const bf16x8 ones = (bf16x8){o, o, o, o, o, o, o, o};
#pragma unroll
        for (int kp = 0; kp < 4; ++kp) acc[8] = MFMA16(ones, Xp[kp], acc[8]); }
    const float den = __shfl(acc[8][0], fr);
    const float inv = 1.f / fmaxf(fabsf(den), ex);
#pragma unroll
    for (int nt = 0; nt < 8; ++nt) { if (DIR == 0) hs[nt] = acc[nt] * inv; else hs[nt] += acc[nt] * inv; }
}
DI void mlstm_out_unit(LAS unsigned char* lds, const Ctx& c, int chunk, int head, int tid, int lane, int wid) {
    asm volatile("" : "+v"(tid), "+v"(lane));
    const int t0 = chunk * 128, fr = lane & 15, fq = lane >> 4;
    LAS unsigned char* LQ = lds; LAS unsigned char* LK = lds + 34816; LAS unsigned char* LVTb = lds + 73984; LAS unsigned char* LSB = lds + 108800; LAS float* vec = (LAS float*)(lds + 147968);
    LAS bf16_t* LVT = (LAS bf16_t*)LVTb;
    const bf16_t* MQ = (const bf16_t*)(c.ws + WS_MQ); const bf16_t* MK = (const bf16_t*)(c.ws + WS_MK); const bf16_t* MV = (const bf16_t*)(c.ws + WS_MV); bf16_t* MO = (bf16_t*)(c.ws + WS_MO);
    const bf16_t* CSTF = (const bf16_t*)c.out + ((size_t)(0 * NCHUNK + chunk) * 4 + head) * ST_ELEMS; const bf16_t* CSTB = (const bf16_t*)c.out + ((size_t)(1 * NCHUNK + chunk) * 4 + head) * ST_ELEMS;
    u32x4 qr[4], kr[4], vr[4], sbr[5], sfr[5];
#pragma unroll
    for (int i = 0; i < 4; ++i) { const int idx = tid + 512 * i, r = idx >> 4, ch = idx & 15; const size_t go = (size_t)(t0 + r) * 512 + head * 128 + ch * 8; qr[i] = *(const u32x4*)(MQ + go); kr[i] = *(const u32x4*)(MK + go); }
#pragma unroll
    for (int i = 0; i < 4; ++i) { const int idx = tid + 512 * i, s = idx & 127, ch = idx >> 7; vr[i] = *(const u32x4*)(MV + (size_t)(t0 + s) * 512 + head * 128 + ch * 8); }
#pragma unroll
    for (int i = 0; i < 5; ++i) { int idx = tid + 512 * i; idx = idx < 2304 ? idx : 2303; const int r = idx >> 4, ch = idx & 15, rc = r < 129 ? r : 128;
        sbr[i] = *(const u32x4*)(CSTB + rc * 128 + ch * 8); sfr[i] = *(const u32x4*)(CSTF + rc * 128 + ch * 8); }
#pragma unroll
    for (int i = 0; i < 4; ++i) { const int idx = tid + 512 * i, r = idx >> 4, ch = idx & 15; *(LAS u32x4*)(LQ + r * 272 + ch * 16) = qr[i]; *(LAS u32x4*)(LK + r * 272 + ch * 16) = kr[i]; }
#pragma unroll
    for (int i = 0; i < 4; ++i) { const int idx = tid + 512 * i, s = idx & 127, ch = idx >> 7; const u32x4 v8 = vr[i];
#pragma unroll
        for (int e = 0; e < 8; ++e) { const unsigned vw = v8[e >> 1]; LVT[(8 * ch + e) * 136 + s] = (bf16_t)((e & 1) ? (vw >> 16) : (vw & 0xffffu)); } }
#pragma unroll
    for (int i = 0; i < 5; ++i) { int idx = tid + 512 * i; idx = idx < 2304 ? idx : 2303; const int r = idx >> 4, ch = idx & 15;
        *(LAS u32x4*)(LSB + r * 272 + ch * 16) = r < 129 ? sbr[i] : (u32x4){0u, 0u, 0u, 0u}; }
    if (wid < 2) { const int d = wid; const ChunkVec v = chunk_vectors(d, (const float*)(c.ws + WS_GATES), t0, head, lane);
        const float mp = ((const float*)(c.ws + WS_MPREV))[(size_t)(d * NCHUNK + chunk) * 4 + head];
        LAS float* vd = vec + d * 512; const float M0 = fmaxf(mp, v.cm0), M1 = fmaxf(mp, v.cm1);
        constexpr float L2E = 1.4426950408889634f;
        vd[v.s0] = v.g0 * L2E; vd[128 + v.s0] = M0 * L2E; vd[256 + v.s0] = __expf(-(v.b0 + M0)); vd[384 + v.s0] = __expf(mp - M0);
        vd[v.s1] = v.g1 * L2E; vd[128 + v.s1] = M1 * L2E; vd[256 + v.s1] = __expf(-(v.b1 + M1)); vd[384 + v.s1] = __expf(mp - M1); }
    __syncthreads();
    const int trow = 16 * wid + fr;
    bf16x8 Xq[4];
#pragma unroll
    for (int ks = 0; ks < 4; ++ks) Xq[ks] = *(LAS const bf16x8*)(LQ + trow * 272 + (32 * ks + 8 * fq) * 2);
    f32x4 S[8];
#pragma unroll
    for (int n = 0; n < 8; ++n) { S[n] = (f32x4){0.f, 0.f, 0.f, 0.f};
#pragma unroll
        for (int ks = 0; ks < 4; ++ks) { const bf16x8 Yk = *(LAS const bf16x8*)(LK + (16 * n + fr) * 272 + (32 * ks + 8 * fq) * 2); S[n] = MFMA16(Yk, Xq[ks], S[n]); } }
    __syncthreads();
#pragma unroll
    for (int i = 0; i < 5; ++i) { int idx = tid + 512 * i; idx = idx < 2304 ? idx : 2303; const int r = idx >> 4, ch = idx & 15;
        *(LAS u32x4*)(LK + r * 272 + ch * 16) = r < 129 ? sfr[i] : (u32x4){0u, 0u, 0u, 0u}; }
    __syncthreads();
    f32x4 hs[8];
    dir_pass<0>(S, Xq, LK, LVTb, vec, trow, fr, fq, hs);
    dir_pass<1>(S, Xq, LSB, LVTb, vec + 512, trow, fr, fq, hs);
    float sum = 0.f;
#pragma unroll
    for (int nt = 0; nt < 8; ++nt) sum += (hs[nt][0] + hs[nt][1]) + (hs[nt][2] + hs[nt][3]);
    sum += __shfl_xor(sum, 16); sum += __shfl_xor(sum, 32);
    const float mean = sum * (1.f / 128.f); float var = 0.f;
#pragma unroll
    for (int nt = 0; nt < 8; ++nt) { hs[nt] -= mean; var += (hs[nt][0] * hs[nt][0] + hs[nt][1] * hs[nt][1]) + (hs[nt][2] * hs[nt][2] + hs[nt][3] * hs[nt][3]); }
    var += __shfl_xor(var, 16); var += __shfl_xor(var, 32);
    const float rstd = __builtin_amdgcn_rsqf(var * (1.f / 128.f) + EPS);
    const float* nw = c.in[6] + head * 128; bf16_t* mop = MO + (size_t)(t0 + trow) * 512 + head * 128;
#pragma unroll
    for (int nt = 0; nt < 8; ++nt) { const int v = 16 * nt + 4 * fq; const u32x2 mo4 = *(const u32x2*)(mop + v); const f32x4 w4 = *(const f32x4*)(nw + v);
        const float o0 = hs[nt][0] * rstd * w4[0] * sigmoidf_(bflo(mo4.x)), o1 = hs[nt][1] * rstd * w4[1] * sigmoidf_(bfhi(mo4.x));
        const float o2 = hs[nt][2] * rstd * w4[2] * sigmoidf_(bflo(mo4.y)), o3 = hs[nt][3] * rstd * w4[3] * sigmoidf_(bfhi(mo4.y));
        u32x2 w; w.x = pk2(o0, o1); w.y = pk2(o2, o3); *(u32x2*)((bf16_t*)(c.ws + WS_HMOA) + (size_t)(t0 + trow) * 1024 + head * 128 + v) = w; }
    __syncthreads();
}

DI void fast_grid_barrier(unsigned* ctr, unsigned target) {
    asm volatile("s_waitcnt vmcnt(0) lgkmcnt(0)" ::: "memory");
    __syncthreads();
    if (threadIdx.x == 0) {
        __builtin_amdgcn_fence(__ATOMIC_RELEASE, "agent");
        asm volatile("s_waitcnt vmcnt(0)" ::: "memory");
        __hip_atomic_fetch_add(ctr, 1u, __ATOMIC_RELAXED, __HIP_MEMORY_SCOPE_AGENT);
        while (__hip_atomic_load(ctr, __ATOMIC_RELAXED, __HIP_MEMORY_SCOPE_AGENT) < target) __builtin_amdgcn_s_sleep(2);
        __builtin_amdgcn_fence(__ATOMIC_ACQUIRE, "agent");
        asm volatile("s_waitcnt vmcnt(0)" ::: "memory");
    }
    __syncthreads();
}

struct Args { const float* in[17]; float* out; unsigned char* ws; int ph_lo, ph_hi; };
constexpr int NPHASE = 9;

__global__ void __launch_bounds__(512, 2) mega(Args args) {
    extern __shared__ __attribute__((aligned(16))) unsigned char lds_raw[];
    LAS unsigned char* lds = (LAS unsigned char*)lds_raw;
    cg::grid_group grid = cg::this_grid();
    const int tid = threadIdx.x, lane = tid & 63, wid = __builtin_amdgcn_readfirstlane(tid >> 6);
    const int G = gridDim.x, gw = blockIdx.x * 8 + wid, NGW = G * 8;
    Ctx c;
#pragma unroll
    for (int i = 0; i < 17; ++i) c.in[i] = args.in[i];
    c.out = args.out; c.ws = args.ws;
    unsigned char* ws = args.ws;
    const int lo = args.ph_lo, hi = args.ph_hi;
#ifndef PH_MASK
#define PH_MASK 0x3ff
#endif
#define IN(k) (((PH_MASK >> (k)) & 1) && lo <= (k) && (k) < hi)
#define REP(k) for (int rep_ = 0; rep_ < (((DUP_MASK >> (k)) & 1) ? 2 : 1); ++rep_)
#define SEAM(k) do { if (IN(k) && IN((k) + 1)) { if ((k) == 0) grid.sync(); else fast_grid_barrier((unsigned*)(ws + WS_BAR), (unsigned)(k) * (unsigned)G); } } while (0)

    REP(0) if (IN(0)) {
        LAS float* scr = (LAS float*)(lds + wid * 16384);
        for (int i = blockIdx.x * 512 + tid; i < 320 * 64; i += G * 512) ((unsigned*)(ws + WS_CTL))[i] = 0u;
        constexpr int I_W1 = 160 * 16, I_PM = 32 * 8, I_PA = 32 * 8, I_WO = 32 * 16, I_UP = 176 * 16, I_WD = 32 * 44;
        constexpr int NITEMS = I_W1 + I_PM + I_PA + I_WO + I_UP + I_WD;
        for (int it = gw; it < NITEMS; it += NGW) {
            int r = it;
            if (r < I_W1) { const int nb = r >> 4, kb = r & 15, dr = 32 * nb, sc = dr < 2048 ? dr : dr + 16;
                const float ns = (dr >= 512 && dr < 1024) ? 0.08838834764831845f : ((dr >= 2048 && dr < 2560) ? 0.18033688011112042f   : 1.f);
                transpose_item(c.in[3], DIN, sc, 64 * kb, (bf16_t*)(ws + WS_W1), 1024, dr, c.in[2], ns, scr, lane); continue; } r -= I_W1;
            if (r < I_PM) { const int nb = r >> 3, kb = r & 7; transpose_item(c.in[8], 1024, 32 * nb, 64 * kb, (bf16_t*)(ws + WS_W1) + (size_t)5120 * 1024, 1024, 32 * nb, nullptr, 1.f, scr, lane); continue; } r -= I_PM;
            if (r < I_PA) { const int nb = r >> 3, kb = r & 7; transpose_item(c.in[9], 1024, 32 * nb, 64 * kb, (bf16_t*)(ws + WS_W1) + (size_t)5120 * 1024 + 512, 1024, 32 * nb, nullptr, 1.f, scr, lane); continue; } r -= I_PA;
            if (r < I_WO) { const int nb = r >> 4, kb = r & 15; transpose_item(c.in[10], 1024, 32 * nb, 64 * kb, (bf16_t*)(ws + WS_WO), 1024, 32 * nb, nullptr, 1.f, scr, lane); continue; } r -= I_WO;
            if (r < I_UP) { const int nb = r >> 4, kb = r & 15, sc = 32 * nb; const int half = sc >= DFF ? 1 : 0, ch = sc - half * DFF; const int dr = 256 * (ch >> 7) + 128 * half + (ch & 127);
                transpose_item(c.in[12], NUP, sc, 64 * kb, (bf16_t*)(ws + WS_WUP), 1024, dr, c.in[11], 1.f, scr, lane); continue; } r -= I_UP;
            { const int nb = r / 44, kb = r - nb * 44; transpose_item(c.in[15], 1024, 32 * nb, 64 * kb, (bf16_t*)(ws + WS_WD), DFF, 32 * nb, nullptr, 1.f, scr, lane); }
        }
        {
            float* rope = (float*)(ws + WS_ROPE);
            for (int i = blockIdx.x * 512 + tid; i < 16384 * 8; i += G * 512) { const int pos = i >> 3, d = i & 7;
                const float invf = d == 0 ? 1.0f : d == 1 ? 0.1939227432012558f : d == 2 ? 0.03760603070259094f : d == 3 ? 0.007292664609849453f : d == 4 ? 0.0014142135623842478f
                                 : d == 5 ? 0.00027424818836152554f : d == 6 ? 5.3182957344688475e-05f : 1.0313385246263351e-05f;
                const float ang = (float)pos * invf; const float k = rintf(ang * 0.15915494309189535f);
                float rr = fmaf(-k, 6.2831854820251465f, ang); rr = fmaf(-k, -1.7484556025237907e-07f, rr);
                rope[pos * 16 + d] = cosf(rr); rope[pos * 16 + 8 + d] = sinf(rr); }
        }
        __syncthreads();
        LAS float* wg = (LAS float*)lds;
        for (int i = tid; i < 16384; i += 512) { const int k = i >> 4, j = i & 15; wg[j * 1024 + k] = c.in[2][k] * c.in[3][(size_t)k * DIN + 2048 + j]; }
        __syncthreads();
        bf16_t* XN = (bf16_t*)(ws + WS_XN); float* gates = (float*)(ws + WS_GATES);
        const float bias = (lane >> 2) < 8 ? c.in[4][lane >> 2] : c.in[5][(lane >> 2) - 8];
        f32x4 va[4], vb[4];
        { const int r0 = gw * 2 < MTOK ? gw * 2 : 0; const f32x4* xa = (const f32x4*)xrow_ptr(c.in[0], c.in[1], r0) + lane; const f32x4* xb = (const f32x4*)xrow_ptr(c.in[0], c.in[1], r0 + 1) + lane;
#pragma unroll
          for (int j = 0; j < 4; ++j) { va[j] = xa[64 * j]; vb[j] = xb[64 * j]; } }
        for (int r0 = gw * 2; r0 < MTOK; r0 += NGW * 2) {
            f32x4 na[4], nb[4];
            { const int rn = r0 + NGW * 2 < MTOK ? r0 + NGW * 2 : r0; const f32x4* xa = (const f32x4*)xrow_ptr(c.in[0], c.in[1], rn) + lane; const f32x4* xb = (const f32x4*)xrow_ptr(c.in[0], c.in[1], rn + 1) + lane;
#pragma unroll
              for (int j = 0; j < 4; ++j) { na[j] = xa[64 * j]; nb[j] = xb[64 * j]; } }
            float sa = 0.f, sb = 0.f;
#pragma unroll
            for (int j = 0; j < 4; ++j) {
                sa += (va[j][0] * va[j][0] + va[j][1] * va[j][1]) + (va[j][2] * va[j][2] + va[j][3] * va[j][3]); sb += (vb[j][0] * vb[j][0] + vb[j][1] * vb[j][1]) + (vb[j][2] * vb[j][2] + vb[j][3] * vb[j][3]); }
            const float rsa = 1.f / sqrtf(wave_sum(sa) * (1.f / DM) + EPS), rsb = 1.f / sqrtf(wave_sum(sb) * (1.f / DM) + EPS);
            float pa[16], pb[16];
#pragma unroll
            for (int g = 0; g < 16; ++g) { float qa = 0.f, qb = 0.f;
#pragma unroll
                for (int j = 0; j < 4; ++j) { const f32x4 w = *(LAS const f32x4*)(wg + g * 1024 + 256 * j + 4 * lane);
                    qa += (va[j][0] * w[0] + va[j][1] * w[1]) + (va[j][2] * w[2] + va[j][3] * w[3]); qb += (vb[j][0] * w[0] + vb[j][1] * w[1]) + (vb[j][2] * w[2] + vb[j][3] * w[3]); }
                pa[g] = qa; pb[g] = qb; asm volatile("" ::: "memory"); }
            const float ga_ = reduce16(pa, lane), gb_ = reduce16(pb, lane);
            if ((lane & 3) == 0) { gates[(size_t)r0 * 16 + (lane >> 2)] = rsa * ga_ + bias; gates[(size_t)(r0 + 1) * 16 + (lane >> 2)] = rsb * gb_ + bias; }
            unsigned long long* oa = (unsigned long long*)(XN + (size_t)r0 * DM) + lane; unsigned long long* ob = (unsigned long long*)(XN + (size_t)(r0 + 1) * DM) + lane;
#pragma unroll
            for (int j = 0; j < 4; ++j) {
                oa[64 * j] = (unsigned long long)pk2(va[j][0] * rsa, va[j][1] * rsa) | ((unsigned long long)pk2(va[j][2] * rsa, va[j][3] * rsa) << 32);
                ob[64 * j] = (unsigned long long)pk2(vb[j][0] * rsb, vb[j][1] * rsb) | ((unsigned long long)pk2(vb[j][2] * rsb, vb[j][3] * rsb) << 32); }
#pragma unroll
            for (int j = 0; j < 4; ++j) { va[j] = na[j]; vb[j] = nb[j]; }
        }
        __syncthreads();
    }
    SEAM(0);

    if (IN(1)) {
        pg8::Gemm g{(const bf16_t*)(ws + WS_XN), (const bf16_t*)(ws + WS_W1), nullptr, nullptr, 1024};
        pg8::DupOrder S; S.s.init(MTOK / 256, 12, G, (int)blockIdx.x); S.dup = (DUP_MASK >> 1) & 1;
        pg8::EpiProj E{ws};
        pg8::gemm_phase<pg8::EpiProj, pg8::DupOrder, true, false>(lds, g, S, E);
    }
    SEAM(1);

    if (IN(2)) {
        constexpr int NSU = NCHUNK * 4, NAU = (NCHUNK / 2) * 4;
        for (int it0 = blockIdx.x; it0 < (((DUP_MASK >> 2) & 1) ? 2 : 1) * (NSU + NAU); it0 += G) { const int it = it0 >= NSU + NAU ? it0 - (NSU + NAU) : it0;
            if (it < NSU) summary_unit(lds, c, it >> 2, it & 3, tid, lane, wid);
            else { const int a = it - NSU; attn_unit(lds, c, a >> 2, a & 3, tid, lane, wid); }
        }
    }
    SEAM(2);

    REP(3) if (IN(3)) {
        constexpr int NPI = 8 * 33, NSI = 128 * 33;
        if (NGW > 2 * NPI) {
            if (gw < NPI) scan_item(c, gw / 33, gw % 33, lane);
            else { const int stride = NGW - NPI; for (int j = gw - NPI; j < NSI; j += stride) scan_item(c, 8 + j / 33, j % 33, lane); }
        } else {
            for (int j = gw; j < NPI + NSI; j += NGW) scan_item(c, j / 33, j % 33, lane);
        }
    }
    SEAM(3);

    REP(4) if (IN(4)) {
        for (int it = blockIdx.x; it < NCHUNK * 4; it += G) mlstm_out_unit(lds, c, it >> 2, it & 3, tid, lane, wid);
    }
    SEAM(4);

    if (IN(5)) {
        const bf16_t* W1t = (const bf16_t*)(ws + WS_W1);
        pg8::Gemm gg{(const bf16_t*)(ws + WS_XN), W1t + (size_t)3072 * 1024, (const bf16_t*)(ws + WS_XN), W1t + (size_t)4096 * 1024, 1024, 0};
        pg8::Gemm gx{(const bf16_t*)(ws + WS_HMOA), W1t + (size_t)5120 * 1024, (const bf16_t*)(ws + WS_HMOA) + 512, W1t + (size_t)5120 * 1024 + 512, 1024, 8};
        pg8::StaticOrder SO; SO.init(MTOK / 256, DM / 256, G, (int)blockIdx.x);
        pg8::EpiGate EG{ws + WS_QSCR}; pg8::EpiMix EM{(bf16_t*)(ws + WS_Y), ws + WS_QSCR};
        pg8::Unit tu;
        for (int k = 0; SO.next(k, tu); ++k) {
            pg8::TileOrder T{tu.pm, tu.pn};
            pg8::gemm_phase<pg8::EpiGate, pg8::TileOrder, true, false>(lds, gg, T, EG);
            pg8::gemm_phase<pg8::EpiMix, pg8::TileOrder, true, false>(lds, gx, T, EM);
        }
    }
    SEAM(5);

    if (IN(6)) {
        pg8::Gemm g{(const bf16_t*)(ws + WS_Y), (const bf16_t*)(ws + WS_WO), nullptr, nullptr, 1024};
        pg8::DupOrder S; S.s.init(MTOK / 256, DM / 256, G, (int)blockIdx.x); S.dup = (DUP_MASK >> 6) & 1;
        pg8::EpiRes<true> E{c.in[0], c.in[1], c.out, (bf16_t*)(ws + WS_HN), (float*)(ws + WS_SS)};
        pg8::gemm_phase<pg8::EpiRes<true>, pg8::DupOrder, true, false>(lds, g, S, E);
    }
    SEAM(6);

    if (IN(7)) {
        pg8::Gemm g{(const bf16_t*)(ws + WS_HN), (const bf16_t*)(ws + WS_WUP), nullptr, nullptr, 1024};
        pg8::DupOrder S; S.s.init(323, NUP / 256, G, (int)blockIdx.x); S.dup = (DUP_MASK >> 7) & 1;
        pg8::EpiConv E{(bf16_t*)(ws + WS_G), (const float*)(ws + WS_SS), c.in[13], c.in[14], (LAS float*)(lds + 131072)};
        pg8::gemm_phase<pg8::EpiConv, pg8::DupOrder, true, true>(lds, g, S, E);
    }
    SEAM(7);

    if (IN(8)) {
        pg8::Gemm g{(const bf16_t*)(ws + WS_G), (const bf16_t*)(ws + WS_WD), nullptr, nullptr, DFF};
        pg8::StaticOrder S; S.init(MTOK / 256, DM / 256, G, (int)blockIdx.x);
        pg8::EpiFinal E{c.out, (const bf16_t*)(ws + WS_HN), c.in[16], (unsigned*)(ws + WS_SS), (unsigned*)(ws + WS_CTL)};
        pg8::gemm_phase<pg8::EpiFinal, pg8::StaticOrder, true, false>(lds, g, S, E);
    }
#undef IN
#undef SEAM
}

extern "C" void kernel_launch(void* const* d_in, const int* in_sizes, int n_in, void* d_out, int out_size, void* d_ws, size_t ws_size, hipStream_t stream) {
    static int grid = 0;
    if (grid == 0) {
        if (n_in != 17 || out_size != MTOK * DM || ws_size < WS_END2) { fprintf(stderr, "kernel_launch: unexpected problem (n_in %d out %d ws %zu)\n", n_in, out_size, ws_size); grid = -1; return; }
        int dev = 0, cus = 0, per_cu = 0;
        if (hipGetDevice(&dev) != hipSuccess || hipDeviceGetAttribute(&cus, hipDeviceAttributeMultiprocessorCount, dev) != hipSuccess) { grid = -1; return; }
        if (hipFuncSetAttribute((const void*)mega, hipFuncAttributeMaxDynamicSharedMemorySize, LDS_BYTES) != hipSuccess) { fprintf(stderr, "kernel_launch: hipFuncSetAttribute failed\n"); grid = -1; return; }
        if (hipOccupancyMaxActiveBlocksPerMultiprocessor(&per_cu, (const void*)mega, 512, LDS_BYTES) != hipSuccess || per_cu < 1) { fprintf(stderr, "kernel_launch: occupancy query says %d\n", per_cu); per_cu = 1; }
        (void)hipGetLastError();
        grid = cus * per_cu;
    }
    if (grid < 0) return;
    Args a{};
    for (int i = 0; i < 17; ++i) a.in[i] = (const float*)d_in[i];
    a.out = (float*)d_out; a.ws = (unsigned char*)d_ws;
#if MK_SINGLE
    if (hipMemsetAsync((unsigned char*)d_ws + WS_BAR, 0, 256, stream) != hipSuccess) { fprintf(stderr, "kernel_launch: memset of the barrier word failed\n"); return; }
    a.ph_lo = 0; a.ph_hi = NPHASE;
    void* kargs[] = {&a};
    hipError_t e = hipLaunchCooperativeKernel((const void*)mega, dim3(grid), dim3(512), kargs, LDS_BYTES, stream);
    if (e != hipSuccess) fprintf(stderr, "cooperative launch failed: %s (grid %d)\n", hipGetErrorString(e), grid);
#else
    for (int p = 0; p < NPHASE; ++p) { a.ph_lo = p; a.ph_hi = p + 1; hipLaunchKernelGGL(mega, dim3(grid), dim3(512), LDS_BYTES, stream, a); }
#endif
}
```

```cpp
#include <hip/hip_runtime.h>
#include <hip/hip_cooperative_groups.h>
#include <cstdio>
#include <cstdint>
namespace cg = cooperative_groups;

#ifndef DUP_MASK
#define DUP_MASK 0
#endif
#ifndef MK_SINGLE
#define MK_SINGLE 1
#endif

#define LAS __attribute__((address_space(3)))
#define DI __device__ __forceinline__
typedef unsigned short bf16_t;
typedef short bf16x8 __attribute__((ext_vector_type(8)));
typedef short s16x4 __attribute__((ext_vector_type(4)));
typedef float f32x4 __attribute__((ext_vector_type(4)));
typedef unsigned u32x4 __attribute__((ext_vector_type(4)));
typedef unsigned u32x2 __attribute__((ext_vector_type(2)));

constexpr int MTOK = 81920, DM = 1024, NPROJ = 5120, DIN = 5136, DFF = 2816, NUP = 5632;
constexpr int NCHUNK = 640, PROMPT = 16384;
constexpr float EPS = 1e-6f;
constexpr int ST_ELEMS = 129 * 128;
constexpr size_t ST_BYTES = (size_t)ST_ELEMS * 2;

constexpr size_t MiB = 1u << 20;
constexpr size_t WS_CTL = 0;
constexpr size_t WS_W1 = 2 * MiB, WS_WPM = 13 * MiB, WS_WPA = 14 * MiB, WS_WO = 15 * MiB, WS_WUP = 17 * MiB, WS_WD = 28 * MiB;
constexpr size_t WS_ROPE = 34 * MiB, WS_GATES = 35 * MiB, WS_SS = 40 * MiB, WS_CHSC = 46 * MiB, WS_MPREV = 47 * MiB;
constexpr size_t WS_MQ = 64 * MiB, WS_MK = 144 * MiB, WS_MV = 224 * MiB, WS_MO = 304 * MiB, WS_AQ = 384 * MiB, WS_AK = 464 * MiB, WS_AV = 504 * MiB,
                 WS_GM = 544 * MiB, WS_GA = 704 * MiB, WS_END = 864 * MiB;
constexpr size_t WS_Y = 64 * MiB, WS_HN = 224 * MiB, WS_G = 384 * MiB;
constexpr size_t WS_OA = 864 * MiB, WS_HM = 944 * MiB, WS_END2 = 1024 * MiB;
constexpr size_t OUT_CST = 0;
constexpr size_t WS_XN = WS_GM, WS_QSCR = WS_GA;
constexpr size_t WS_HMOA = 864 * MiB;
constexpr int LDS_BYTES = 152064;

typedef __bf16 bf16n2 __attribute__((ext_vector_type(2)));
typedef float f32n2 __attribute__((ext_vector_type(2)));
DI unsigned pk2(float lo, float hi) { const f32n2 v = {lo, hi}; return __builtin_bit_cast(unsigned, __builtin_convertvector(v, bf16n2)); }
DI unsigned f2bf(float f) { return pk2(f, f) & 0xffffu; }
DI float bflo(unsigned w) { return __uint_as_float(w << 16); }
DI float bfhi(unsigned w) { return __uint_as_float(w & 0xffff0000u); }
DI unsigned cvt_pk_bf16_asm(float lo, float hi) { unsigned r; asm volatile("v_cvt_pk_bf16_f32 %0, %1, %2" : "=v"(r) : "v"(lo), "v"(hi)); return r; }
DI unsigned cvt_pk_bf16(float lo, float hi) { return pk2(lo, hi); }
DI float wave_sum(float v) {
#pragma unroll
    for (int o = 1; o < 64; o <<= 1) v += __shfl_xor(v, o);
    return v;
}
DI float sigmoidf_(float x) { return __builtin_amdgcn_rcpf(1.f + __expf(-x)); }
DI float logsigmoid_(float x) { return x >= 0.f ? -log1pf(expf(-x)) : x - log1pf(expf(x)); }
#define MFMA16(a, b, c) __builtin_amdgcn_mfma_f32_16x16x32_bf16((a), (b), (c), 0, 0, 0)
DI bf16x8 pack8(const float (&p)[8]) {
    u32x4 w; w.x = pk2(p[0], p[1]); w.y = pk2(p[2], p[3]); w.z = pk2(p[4], p[5]); w.w = pk2(p[6], p[7]);
    return __builtin_bit_cast(bf16x8, w);
}
DI const float* xrow_ptr(const float* xp, const float* xs, int t) { return t < PROMPT ? xp + (size_t)t * DM : xs + (size_t)(t - PROMPT) * DM; }
DI bool seq_start(int t) { return t == 0 || (t >= PROMPT && (t & 4095) == 0); }

namespace pg8 {
constexpr int BM = 256, BK = 64, HALF = 128, HTB = HALF * BK * 2, STAGE_BYTES = 8 * HTB, NXCD = 8, WGM = 8;
DI int lds_byte(int r, int c) { const int st = (r >> 4) * 2 + (c >> 5), rr = r & 15, cc = c & 31, ob = rr * 64 + cc * 2; return st * 1024 + (ob ^ (((ob >> 9) & 1) << 5)); }
DI void stage_rc(int b, int& R, int& C) { const int st = b / 1024, sb = b % 1024, swz = sb ^ (((sb >> 9) & 1) << 5); R = (st >> 1) * 16 + swz / 64; C = (st & 1) * 32 + (swz % 64) / 2; }
DI int perm32(int rho) { const int n = rho >> 4, i = rho & 15; return 8 * (i >> 2) + 4 * n + (i & 3); }

struct Unit { int pm, pn, sel; };
struct Gemm { const bf16_t* A; const bf16_t* Bt; const bf16_t* A2; const bf16_t* Bt2; int K; int ntk = 0; };

struct StaticOrder {
    int nM, nN, nwg, G, c;
    DI void init(int nM_, int nN_, int G_, int c_) { nM = nM_; nN = nN_; nwg = nM * nN; G = G_; c = c_; }
    DI bool next(int i, Unit& u) const {
        const long L = (long)i * G + c; if (L >= nwg) return false;
        int wgid = (int)L; { const int q = nwg / NXCD, r = nwg % NXCD, xcd = wgid % NXCD, off = wgid / NXCD; wgid = (xcd < r ? xcd * (q + 1) : r * (q + 1) + (xcd - r) * q) + off; }
        const int nig = WGM * nN, gid = wgid / nig, fm = gid * WGM, gsz = (nM - fm) < WGM ? (nM - fm) : WGM;
        u.pm = fm + ((wgid % nig) % gsz); u.pn = (wgid % nig) / gsz; u.sel = 0; return true;
    }
};
struct DupOrder { StaticOrder s; int dup; DI bool next(int i, Unit& u) const { return s.next(dup ? (i >> 1) : i, u); } };
struct TileOrder { int pm, pn; DI bool next(int i, Unit& u) const { if (i >= 2) return false; u.pm = pm; u.pn = pn; u.sel = i; return true; } };
struct PairOrder {
    StaticOrder s;
    DI bool next(int i, Unit& u) const { if (!s.next(i >> 1, u)) return false; u.sel = i & 1; return true; }
};

template <class Epi, class Sched, bool ALIGN_EPI, bool CONVA>
DI void gemm_phase(LAS unsigned char* lds, const Gemm g, const Sched& S, const Epi& E) {
    const int tid = threadIdx.x, wid = __builtin_amdgcn_readfirstlane(tid >> 6), lane = tid & 63, wr = wid >> 2, wc = wid & 3, fr = lane & 15, fq = lane >> 4;
    const int K = g.K; const int nt = g.ntk ? g.ntk : K / BK;
    unsigned voffA[2], voffB[2];
#pragma unroll
    for (int i = 0; i < 2; ++i) { int R, C; stage_rc(tid * 16 + i * 8192, R, C); const int Rb = Epi::PERM ? ((R & ~31) + perm32(R & 31)) : R;
        const int Ra = CONVA ? (128 * (R >> 6) + 8 * (R & 15) + ((R >> 4) & 3)) : R;
        voffA[i] = (unsigned)(Ra * K + C) * 2u; voffB[i] = (unsigned)(Rb * K + C) * 2u; }
    const size_t kstep = (size_t)(BK * 2);
    const size_t hstepB = (size_t)HALF * K * 2, tstepB = 2 * hstepB;
    const size_t hstepA = CONVA ? (size_t)4 * K * 2 : hstepB, tstepA = CONVA ? (size_t)254 * K * 2 : tstepB;
    const long abias = CONVA ? -(long)K * 2 : 0;
    const unsigned ldsw = (unsigned)wid * 1024u;
    const int aoff = lds_byte(wr * 64 + fr, fq * 8), boff = lds_byte(wc * 32 + fr, fq * 8);
#define PG8_SA(b, h) (((b) * 2 + (h)) * HTB)
#define PG8_SB(b, h) ((4 + (b) * 2 + (h)) * HTB)
#define PG8_STAGE(bufoff, gbase, voff) do { _Pragma("unroll") for (int _i = 0; _i < 2; ++_i) \
        __builtin_amdgcn_global_load_lds((const unsigned*)((const char*)(gbase) + (voff)[_i]), (LAS unsigned*)(lds + (bufoff) + ldsw + _i * 8192), 16, 0, 0); } while (0)
#define PG8_LDA(dst, b, h) do { _Pragma("unroll") for (int m = 0; m < 4; ++m) _Pragma("unroll") for (int k = 0; k < 2; ++k) dst[m][k] = *(const LAS bf16x8*)(lds + PG8_SA(b, h) + aoff + m * 2048 + k * 1024); } while (0)
#define PG8_LDB(dst, b, h) do { _Pragma("unroll") for (int n = 0; n < 2; ++n) _Pragma("unroll") for (int k = 0; k < 2; ++k) dst[n][k] = *(const LAS bf16x8*)(lds + PG8_SB(b, h) + boff + n * 2048 + k * 1024); } while (0)
#define PG8_MMA(ai, bj, At, Bt) do { __builtin_amdgcn_s_setprio(1); _Pragma("unroll") for (int m = 0; m < 4; ++m) _Pragma("unroll") for (int n = 0; n < 2; ++n) _Pragma("unroll") for (int k = 0; k < 2; ++k) \
        acc[ai][bj][m][n] = __builtin_amdgcn_mfma_f32_16x16x32_bf16(Bt[n][k], At[m][k], acc[ai][bj][m][n], 0, 0, 0); __builtin_amdgcn_s_setprio(0); } while (0)
#define PG8_WAIT_V(n) asm volatile("s_waitcnt vmcnt(" #n ")" ::: "memory")
#define PG8_WAIT_L(n) asm volatile("s_waitcnt lgkmcnt(" #n ")" ::: "memory")
#define PG8_WAIT_VN(n) asm volatile("s_waitcnt vmcnt(%0)" :: "n"(n) : "memory")
#define PG8_BAR __builtin_amdgcn_s_barrier()
#define PG8_SCHED __builtin_amdgcn_sched_barrier(0)
    Unit cur, nxt; int ui = 0;
    if (!S.next(0, cur)) return;
    f32x4 acc[2][2][4][2];
#pragma unroll
    for (int a = 0; a < 2; ++a)
#pragma unroll
        for (int b = 0; b < 2; ++b)
#pragma unroll
            for (int m = 0; m < 4; ++m)
#pragma unroll
                for (int n = 0; n < 2; ++n) acc[a][b][m][n] = (f32x4){0.f, 0.f, 0.f, 0.f};
    bf16x8 At[4][2], B0[2][2], B1[2][2];
    const char* cA = (const char*)(cur.sel ? g.A2 : g.A) + (size_t)cur.pm * tstepA + abias; const char* cB = (const char*)(cur.sel ? g.Bt2 : g.Bt) + (size_t)cur.pn * tstepB;
    PG8_STAGE(PG8_SB(0, 0), cB, voffB); PG8_STAGE(PG8_SB(0, 1), cB + hstepB, voffB); PG8_STAGE(PG8_SA(0, 0), cA, voffA); PG8_STAGE(PG8_SA(0, 1), cA + hstepA, voffA);
    if (wr == 1) PG8_BAR;
    PG8_WAIT_V(2); PG8_BAR;
    PG8_STAGE(PG8_SB(1, 0), cB + kstep, voffB); PG8_STAGE(PG8_SA(1, 0), cA + kstep, voffA); PG8_STAGE(PG8_SB(1, 1), cB + hstepB + kstep, voffB);
    PG8_WAIT_V(6); PG8_BAR;
    for (;;) {
        const bool has_next = S.next(ui + 1, nxt);
        const char* nA = has_next ? (const char*)(nxt.sel ? g.A2 : g.A) + (size_t)nxt.pm * tstepA + abias : cA;
        const char* nB = has_next ? (const char*)(nxt.sel ? g.Bt2 : g.Bt) + (size_t)nxt.pn * tstepB : cB;
#define PG8_KBODY(W12) do { \
            PG8_LDB(B0, 0, 0); PG8_LDB(B1, 0, 1); PG8_SCHED; PG8_LDA(At, 0, 0); PG8_STAGE(PG8_SA(1, 1), a1 + hstepA, voffA); \
            W12; PG8_WAIT_L(0); PG8_BAR; PG8_MMA(0, 0, At, B0); PG8_MMA(0, 1, At, B1); PG8_BAR; PG8_SCHED; \
            PG8_LDA(At, 0, 1); PG8_STAGE(PG8_SB(0, 0), b2, voffB); PG8_STAGE(PG8_SB(0, 1), b2 + hstepB, voffB); PG8_STAGE(PG8_SA(0, 0), a2, voffA); \
            W12; PG8_WAIT_L(0); PG8_BAR; PG8_MMA(1, 0, At, B0); PG8_MMA(1, 1, At, B1); PG8_BAR; PG8_SCHED; \
            PG8_LDB(B0, 1, 0); PG8_LDB(B1, 1, 1); PG8_SCHED; PG8_LDA(At, 1, 0); PG8_STAGE(PG8_SA(0, 1), a2 + hstepA, voffA); \
            PG8_WAIT_V(8); PG8_WAIT_L(0); PG8_BAR; PG8_MMA(0, 0, At, B0); PG8_MMA(0, 1, At, B1); PG8_BAR; PG8_SCHED; \
            PG8_LDA(At, 1, 1); PG8_STAGE(PG8_SB(1, 0), b3, voffB); PG8_STAGE(PG8_SB(1, 1), b3 + hstepB, voffB); PG8_STAGE(PG8_SA(1, 0), a3, voffA); \
            PG8_WAIT_V(8); PG8_WAIT_L(0); PG8_BAR; PG8_MMA(1, 0, At, B0); PG8_MMA(1, 1, At, B1); PG8_BAR; PG8_SCHED; } while (0)
        for (int t = 0; t < nt; t += 2) {
            const bool last = (t == nt - 2);
            const char* a1 = cA + (size_t)(t + 1) * kstep;
            const char* a2 = last ? nA : cA + (size_t)(t + 2) * kstep; const char* b2 = last ? nB : cB + (size_t)(t + 2) * kstep;
            const char* a3 = a2 + kstep; const char* b3 = b2 + kstep;
            PG8_KBODY(PG8_WAIT_V(8));
        }
#undef PG8_KBODY
        if constexpr (ALIGN_EPI) { if (wr == 0) PG8_BAR; }
        E(acc, cur, wr, wc, fr, fq);
        if (!has_next) break;
        if (!E.keep(cur)) {
#pragma unroll
            for (int a = 0; a < 2; ++a)
#pragma unroll
                for (int b = 0; b < 2; ++b)
#pragma unroll
                    for (int m = 0; m < 4; ++m)
#pragma unroll
                        for (int n = 0; n < 2; ++n) acc[a][b][m][n] = (f32x4){0.f, 0.f, 0.f, 0.f};
        }
        cur = nxt; cA = nA; cB = nB; ++ui;
        if constexpr (ALIGN_EPI) { if (wr == 1) PG8_BAR; }
    }
    PG8_WAIT_V(0);
    if constexpr (!ALIGN_EPI) { if (wr == 0) PG8_BAR; }
    PG8_BAR;
#undef PG8_SA
#undef PG8_SB
#undef PG8_STAGE
#undef PG8_LDA
#undef PG8_LDB
#undef PG8_MMA
#undef PG8_WAIT_V
#undef PG8_WAIT_L
#undef PG8_WAIT_VN
#undef PG8_BAR
#undef PG8_SCHED
}

struct EpiProj {
    static constexpr bool PERM = true; static constexpr int NVM = 16;
    unsigned char* ws;
    DI bool keep(const Unit&) const { return false; }
    DI void operator()(f32x4 (&acc)[2][2][4][2], const Unit& u, int wr, int wc, int fr, int fq) const {
        const int ct = u.pn; bf16_t* base; int ldc, colt;
        if (ct < 8) { base = (bf16_t*)(ws + WS_MQ + (size_t)(ct >> 1) * (80 * MiB)); ldc = 512; colt = (ct & 1) * 256; }
        else if (ct < 10) { base = (bf16_t*)(ws + WS_AQ); ldc = 512; colt = (ct - 8) * 256; }
        else if (ct == 10) { base = (bf16_t*)(ws + WS_AK); ldc = 256; colt = 0; }
        else if (ct == 11) { base = (bf16_t*)(ws + WS_AV); ldc = 256; colt = 0; }
        else if (ct < 16) { base = (bf16_t*)(ws + WS_GM); ldc = 1024; colt = (ct - 12) * 256; }
        else { base = (bf16_t*)(ws + WS_GA); ldc = 1024; colt = (ct - 16) * 256; }
        const int row0 = u.pm * BM + wr * 64 + fr, col0 = colt + wc * 32 + 8 * fq;
#pragma unroll
        for (int ai = 0; ai < 2; ++ai)
#pragma unroll
            for (int m = 0; m < 4; ++m) { bf16_t* rowp = base + (size_t)(row0 + ai * HALF + m * 16) * ldc + col0;
#pragma unroll
                for (int bj = 0; bj < 2; ++bj) { const f32x4 v0 = acc[ai][bj][m][0], v1 = acc[ai][bj][m][1];
                    u32x4 w; w.x = cvt_pk_bf16(v0[0], v0[1]); w.y = cvt_pk_bf16(v0[2], v0[3]); w.z = cvt_pk_bf16(v1[0], v1[1]); w.w = cvt_pk_bf16(v1[2], v1[3]);
                    *(u32x4*)(rowp + bj * HALF) = w; } }
    }
};
#define PG8_SCR_SETUP const unsigned lo16 = (threadIdx.x & 63u) * 16u; const int wid_ = __builtin_amdgcn_readfirstlane(threadIdx.x >> 6); \
        unsigned char* sa_u = scr + ((size_t)(blockIdx.x * 2 + 0) * 8 + wid_) * 16384; unsigned char* sb_u = scr + ((size_t)(blockIdx.x * 2 + 1) * 8 + wid_) * 16384;
#define sa(k) (sa_u + (k) * 1024 + lo16)
#define sb(k) (sb_u + (k) * 1024 + lo16)
struct EpiGate {
    static constexpr bool PERM = true; static constexpr int NVM = 16;
    unsigned char* scr;
    DI bool keep(const Unit&) const { return false; }
    DI void operator()(f32x4 (&acc)[2][2][4][2], const Unit& u, int wr, int wc, int fr, int fq) const {
        PG8_SCR_SETUP
        if (u.sel == 0) {
#pragma unroll
            for (int ai = 0; ai < 2; ++ai)
#pragma unroll
                for (int m = 0; m < 4; ++m)
#pragma unroll
                    for (int bj = 0; bj < 2; ++bj) { float v[8];
#pragma unroll
                        for (int e = 0; e < 8; ++e) v[e] = sigmoidf_(acc[ai][bj][m][e >> 2][e & 3]);
                        u32x4 w; w.x = pk2(v[0], v[1]); w.y = pk2(v[2], v[3]); w.z = pk2(v[4], v[5]); w.w = pk2(v[6], v[7]);
                        *(u32x4*)sa(ai * 8 + m * 2 + bj) = w; }
        } else {
#pragma unroll
            for (int ai = 0; ai < 2; ++ai) {
                u32x4 A8[4][2];
#pragma unroll
                for (int m = 0; m < 4; ++m)
#pragma unroll
                    for (int bj = 0; bj < 2; ++bj) A8[m][bj] = *(const u32x4*)sa(ai * 8 + m * 2 + bj);
#pragma unroll
                for (int m = 0; m < 4; ++m)
#pragma unroll
                    for (int bj = 0; bj < 2; ++bj) { float r[8], b[8];
#pragma unroll
                        for (int e = 0; e < 8; ++e) { const float av = (e & 1) ? bfhi(A8[m][bj][e >> 1]) : bflo(A8[m][bj][e >> 1]); const float den = 1.f + __expf(-acc[ai][bj][m][e >> 2][e & 3]);
                            b[e] = __builtin_amdgcn_rcpf(den); r[e] = av * den; }
                        u32x4 wr_, wb_; wr_.x = pk2(r[0], r[1]); wr_.y = pk2(r[2], r[3]); wr_.z = pk2(r[4], r[5]); wr_.w = pk2(r[6], r[7]);
                        wb_.x = pk2(b[0], b[1]); wb_.y = pk2(b[2], b[3]); wb_.z = pk2(b[4], b[5]); wb_.w = pk2(b[6], b[7]);
                        *(u32x4*)sa(ai * 8 + m * 2 + bj) = wr_; *(u32x4*)sb(ai * 8 + m * 2 + bj) = wb_; }
            }
        }
    }
};
struct EpiMix {
    static constexpr bool PERM = true; static constexpr int NVM = 16;
    bf16_t* Y; unsigned char* scr;
    DI bool keep(const Unit& u) const { return u.sel == 0; }
    DI void operator()(f32x4 (&acc)[2][2][4][2], const Unit& u, int wr, int wc, int fr, int fq) const {
        PG8_SCR_SETUP
        if (u.sel == 0) {
#pragma unroll
            for (int ai = 0; ai < 2; ++ai) {
                u32x4 A8[4][2];
#pragma unroll
                for (int m = 0; m < 4; ++m)
#pragma unroll
                    for (int bj = 0; bj < 2; ++bj) A8[m][bj] = *(const u32x4*)sa(ai * 8 + m * 2 + bj);
#pragma unroll
                for (int m = 0; m < 4; ++m)
#pragma unroll
                    for (int bj = 0; bj < 2; ++bj)
#pragma unroll
                        for (int e = 0; e < 8; ++e) { const float rv = (e & 1) ? bfhi(A8[m][bj][e >> 1]) : bflo(A8[m][bj][e >> 1]); acc[ai][bj][m][e >> 2][e & 3] *= rv; }
            }
        } else {
            const int row0 = u.pm * BM + wr * 64 + fr, col0 = u.pn * BM + wc * 32 + 8 * fq;
#pragma unroll
            for (int ai = 0; ai < 2; ++ai) {
                u32x4 B8[4][2];
#pragma unroll
                for (int m = 0; m < 4; ++m)
#pragma unroll
                    for (int bj = 0; bj < 2; ++bj) B8[m][bj] = *(const u32x4*)sb(ai * 8 + m * 2 + bj);
#pragma unroll
                for (int m = 0; m < 4; ++m)
#pragma unroll
                    for (int bj = 0; bj < 2; ++bj) { float v[8];
#pragma unroll
                        for (int e = 0; e < 8; ++e) { const float bv = (e & 1) ? bfhi(B8[m][bj][e >> 1]) : bflo(B8[m][bj][e >> 1]); v[e] = acc[ai][bj][m][e >> 2][e & 3] * bv; }
                        u32x4 w; w.x = pk2(v[0], v[1]); w.y = pk2(v[2], v[3]); w.z = pk2(v[4], v[5]); w.w = pk2(v[6], v[7]);
                        *(u32x4*)(Y + (size_t)(row0 + ai * HALF + m * 16) * DM + col0 + bj * HALF) = w; }
            }
        }
    }
};
#undef PG8_SCR_SETUP
#undef sa
#undef sb
template <bool WITH_HN> struct EpiRes {
    static constexpr bool PERM = true; static constexpr int NVM = 16;
    const float* xp; const float* xs; float* out; bf16_t* hn; float* ss;
    DI bool keep(const Unit&) const { return false; }
    template <int Q> DI void ld(f32x4 (&B)[2][2][2], const Unit& u, int wr, int fr, int cb0) const {
#pragma unroll
        for (int mm = 0; mm < 2; ++mm) { const int t = u.pm * BM + (Q >> 1) * HALF + wr * 64 + (2 * (Q & 1) + mm) * 16 + fr; const float* br = xrow_ptr(xp, xs, t);
#pragma unroll
            for (int bj = 0; bj < 2; ++bj)
#pragma unroll
                for (int n = 0; n < 2; ++n) B[mm][bj][n] = *(const f32x4*)(br + cb0 + bj * HALF + 4 * n); }
    }
    template <int Q> DI void st(const f32x4 (&B)[2][2][2], const f32x4 (&acc)[2][2][4][2], const Unit& u, int wr, int wc, int fr, int fq, int cb0) const {
#pragma unroll
        for (int mm = 0; mm < 2; ++mm) { const int m = 2 * (Q & 1) + mm, ai = Q >> 1; const int t = u.pm * BM + ai * HALF + wr * 64 + m * 16 + fr; float ssq = 0.f;
#pragma unroll
            for (int bj = 0; bj < 2; ++bj) { const int c = cb0 + bj * HALF;
                const f32x4 h0 = B[mm][bj][0] + acc[ai][bj][m][0], h1 = B[mm][bj][1] + acc[ai][bj][m][1];
                ssq += ((h0[0] * h0[0] + h0[1] * h0[1]) + (h0[2] * h0[2] + h0[3] * h0[3])) + ((h1[0] * h1[0] + h1[1] * h1[1]) + (h1[2] * h1[2] + h1[3] * h1[3]));
                u32x4 w; w.x = cvt_pk_bf16(h0[0], h0[1]); w.y = cvt_pk_bf16(h0[2], h0[3]); w.z = cvt_pk_bf16(h1[0], h1[1]); w.w = cvt_pk_bf16(h1[2], h1[3]); *(u32x4*)(hn + (size_t)t * DM + c) = w; }
            ssq += __shfl_xor(ssq, 16); ssq += __shfl_xor(ssq, 32); if (fq == 0) ss[(size_t)t * 16 + u.pn * 4 + wc] = ssq; }
    }
    DI void operator()(f32x4 (&acc)[2][2][4][2], const Unit& u, int wr, int wc, int fr, int fq) const {
        const int cb0 = u.pn * BM + wc * 32 + 8 * fq;
        f32x4 B0[2][2][2], B1[2][2][2];
        ld<0>(B0, u, wr, fr, cb0); ld<1>(B1, u, wr, fr, cb0);
        st<0>(B0, acc, u, wr, wc, fr, fq, cb0); ld<2>(B0, u, wr, fr, cb0);
        st<1>(B1, acc, u, wr, wc, fr, fq, cb0); ld<3>(B1, u, wr, fr, cb0);
        st<2>(B0, acc, u, wr, wc, fr, fq, cb0); st<3>(B1, acc, u, wr, wc, fr, fq, cb0);
    }
};
DI float dpp_ror1(float x) { return __builtin_bit_cast(float, __builtin_amdgcn_update_dpp(0, __builtin_bit_cast(int, x), 0x121, 0xf, 0xf, false)); }
DI float dpp_rol1(float x) { return __builtin_bit_cast(float, __builtin_amdgcn_update_dpp(0, __builtin_bit_cast(int, x), 0x12F, 0xf, 0xf, false)); }
struct EpiConv {
    static constexpr bool PERM = true; static constexpr int NVM = 0;
    bf16_t* G; const float* ss; const float* cw; const float* cb; LAS float* xch;
    DI bool keep(const Unit&) const { return false; }
    DI void operator()(f32x4 (&acc)[2][2][4][2], const Unit& u, int wr, int wc, int fr, int fq) const {
        const int t0 = 254 * u.pm - 1 + 128 * wr + 8 * fr;
        unsigned upz = 0, dnz = 0, stm = 0;
        f32x4 P8[8];
#pragma unroll
        for (int idx = 0; idx < 8; ++idx) { const int t = t0 + idx; const int tc = t < 0 ? 0 : (t >= MTOK ? MTOK - 1 : t); P8[idx] = *(const f32x4*)(ss + (size_t)tc * 16 + 4 * fq); }
#pragma unroll
        for (int idx = 0; idx < 8; ++idx) { const int rho = 128 * wr + 8 * fr + idx, t = t0 + idx;
            const f32x4 p = P8[idx]; float s = (p[0] + p[1]) + (p[2] + p[3]); s += __shfl_xor(s, 16); s += __shfl_xor(s, 32);
            const float rs = __builtin_amdgcn_rsqf(s * (1.f / DM) + EPS);
#pragma unroll
            for (int bj = 0; bj < 2; ++bj)
#pragma unroll
                for (int n = 0; n < 2; ++n) acc[idx >> 2][bj][idx & 3][n] *= rs;
            if (seq_start(t)) upz |= 1u << idx;
            if (t + 1 >= MTOK || seq_start(t + 1)) dnz |= 1u << idx;
            if (rho >= 1 && rho <= 254 && t < MTOK) stm |= 1u << idx; }
        const bool anyb = __builtin_amdgcn_ballot_w64((upz | dnz) != 0u) != 0ull;
        f32x4 X[2][2];
        { LAS float* xw = xch + ((wr * 4 + wc) * 4 + fq) * 16; LAS const float* xr = xch + (((wr ^ 1) * 4 + wc) * 4 + fq) * 16;
          if (wr == 0) { if (fr == 15) {
#pragma unroll
              for (int bj = 0; bj < 2; ++bj)
#pragma unroll
                  for (int n = 0; n < 2; ++n) *(LAS f32x4*)(xw + (bj * 2 + n) * 4) = acc[1][bj][3][n]; } }
          else { if (fr == 0) {
#pragma unroll
              for (int bj = 0; bj < 2; ++bj)
#pragma unroll
                  for (int n = 0; n < 2; ++n) *(LAS f32x4*)(xw + (bj * 2 + n) * 4) = acc[0][bj][0][n]; } }
          asm volatile("s_waitcnt lgkmcnt(0)" ::: "memory"); __builtin_amdgcn_s_barrier(); asm volatile("" ::: "memory");
#pragma unroll
          for (int bj = 0; bj < 2; ++bj)
#pragma unroll
              for (int n = 0; n < 2; ++n) X[bj][n] = *(LAS const f32x4*)(xr + (bj * 2 + n) * 4); }
        const bool xup = (wr == 1) && (fr == 0), xdn = (wr == 0) && (fr == 15);
        f32x4 W[2][4];
#define LOADW(n_) _Pragma("unroll") for (int bj = 0; bj < 2; ++bj) { const int cc = bj * DFF + u.pn * 128 + wc * 32 + 8 * fq + 4 * (n_); \
            W[bj][0] = *(const f32x4*)(cw + cc); W[bj][1] = *(const f32x4*)(cw + NUP + cc); W[bj][2] = *(const f32x4*)(cw + 2 * NUP + cc); W[bj][3] = *(const f32x4*)(cb + cc); }
        LOADW(0)
#pragma unroll
        for (int n = 0; n < 2; ++n) {
            const int ch = u.pn * 128 + wc * 32 + 8 * fq + 4 * n;
            float ca[8][4]; unsigned pk[8][2];
#pragma unroll
            for (int bj = 0; bj < 2; ++bj) {
                const f32x4 w0 = W[bj][0], w1 = W[bj][1], w2 = W[bj][2], bb = W[bj][3];
#pragma unroll
                for (int j = 0; j < 4; ++j) {
                    float v[8];
#pragma unroll
                    for (int idx = 0; idx < 8; ++idx) v[idx] = acc[idx >> 2][bj][idx & 3][n][j];
                    float up0 = dpp_ror1(v[7]), dn7 = dpp_rol1(v[0]);
                    up0 = xup ? X[bj][n][j] : up0; dn7 = xdn ? X[bj][n][j] : dn7;
                    float cv[8];
#pragma unroll
                    for (int idx = 0; idx < 8; ++idx) { float up = idx ? v[idx > 0 ? idx - 1 : 0] : up0, dn = idx < 7 ? v[idx < 7 ? idx + 1 : 7] : dn7;
                        if (anyb) { up = ((upz >> idx) & 1u) ? 0.f : up; dn = ((dnz >> idx) & 1u) ? 0.f : dn; }
                        cv[idx] = w0[j] * up + w1[j] * v[idx] + w2[j] * dn + bb[j]; }
                    if (bj == 0) {
#pragma unroll
                        for (int idx = 0; idx < 8; ++idx) ca[idx][j] = cv[idx];
                    } else {
#pragma unroll
                        for (int idx = 0; idx < 8; ++idx) ca[idx][j] = ca[idx][j] * sigmoidf_(ca[idx][j]) * cv[idx];
                    } } }
#pragma unroll
            for (int idx = 0; idx < 8; ++idx) { pk[idx][0] = cvt_pk_bf16_asm(ca[idx][0], ca[idx][1]); pk[idx][1] = cvt_pk_bf16_asm(ca[idx][2], ca[idx][3]); }
            if (n == 0) { LOADW(1) }
#pragma unroll
            for (int idx = 0; idx < 8; ++idx) if ((stm >> idx) & 1u) { u32x2 w; w.x = pk[idx][0]; w.y = pk[idx][1]; *(u32x2*)(G + (size_t)(t0 + idx) * DFF + ch) = w; }
        }
#undef LOADW
    }
};
struct EpiFinal {
    static constexpr bool PERM = true; static constexpr int NVM = 32;
    float* out; const bf16_t* hn; const float* nfw; unsigned* xs; unsigned* cnt;
    DI bool keep(const Unit&) const { return false; }
    template <int Q> DI void ld(f32x4 (&B)[2][2][2], const Unit& u, int wr, int fr, int cb0) const {
#pragma unroll
        for (int mm = 0; mm < 2; ++mm) { const int t = u.pm * BM + (Q >> 1) * HALF + wr * 64 + (2 * (Q & 1) + mm) * 16 + fr; const bf16_t* br = hn + (size_t)t * DM;
#pragma unroll
            for (int bj = 0; bj < 2; ++bj) { const u32x4 w = *(const u32x4*)(br + cb0 + bj * HALF);
                B[mm][bj][0] = (f32x4){bflo(w.x), bfhi(w.x), bflo(w.y), bfhi(w.y)}; B[mm][bj][1] = (f32x4){bflo(w.z), bfhi(w.z), bflo(w.w), bfhi(w.w)}; } }
    }
    template <int Q> DI void add(const f32x4 (&B)[2][2][2], f32x4 (&acc)[2][2][4][2], const Unit& u, int wr, int wc, int fr, int fq) const {
#pragma unroll
        for (int mm = 0; mm < 2; ++mm) { const int m = 2 * (Q & 1) + mm, ai = Q >> 1; const int t = u.pm * BM + ai * HALF + wr * 64 + m * 16 + fr; float ssq = 0.f;
#pragma unroll
            for (int bj = 0; bj < 2; ++bj)
#pragma unroll
                for (int n = 0; n < 2; ++n) { const f32x4 hv = B[mm][bj][n] + acc[ai][bj][m][n]; acc[ai][bj][m][n] = hv; ssq += (hv[0] * hv[0] + hv[1] * hv[1]) + (hv[2] * hv[2] + hv[3] * hv[3]); }
            ssq += __shfl_xor(ssq, 16); ssq += __shfl_xor(ssq, 32);
            if (fq == 0) __hip_atomic_store(xs + (size_t)t * 16 + u.pn * 4 + wc, __float_as_uint(ssq), __ATOMIC_RELAXED, __HIP_MEMORY_SCOPE_AGENT); }
    }
    DI void operator()(f32x4 (&acc)[2][2][4][2], const Unit& u, int wr, int wc, int fr, int fq) const {
        const int lane = threadIdx.x & 63, cb0 = u.pn * BM + wc * 32 + 8 * fq;
        { f32x4 B0[2][2][2], B1[2][2][2];
          ld<0>(B0, u, wr, fr, cb0); ld<1>(B1, u, wr, fr, cb0);
          add<0>(B0, acc, u, wr, wc, fr, fq); ld<2>(B0, u, wr, fr, cb0);
          add<1>(B1, acc, u, wr, wc, fr, fq); ld<3>(B1, u, wr, fr, cb0);
          add<2>(B0, acc, u, wr, wc, fr, fq); add<3>(B1, acc, u, wr, wc, fr, fq); }
        asm volatile("s_waitcnt vmcnt(0)" ::: "memory");
        unsigned* cw_ = cnt + 64 * u.pm;
        if (lane == 0) __hip_atomic_fetch_add(cw_, 1u, __ATOMIC_RELAXED, __HIP_MEMORY_SCOPE_AGENT);
        f32x4 W4[2][2];
#pragma unroll
        for (int bj = 0; bj < 2; ++bj)
#pragma unroll
            for (int n = 0; n < 2; ++n) W4[bj][n] = *(const f32x4*)(nfw + cb0 + bj * HALF + 4 * n);
        while ((unsigned)__builtin_amdgcn_readfirstlane(__hip_atomic_load(cw_, __ATOMIC_RELAXED, __HIP_MEMORY_SCOPE_AGENT)) < 32u) __builtin_amdgcn_s_sleep(2);
        __builtin_amdgcn_fence(__ATOMIC_ACQUIRE, "agent");
        unsigned Pp[8][4];
#pragma unroll
        for (int idx = 0; idx < 8; ++idx) { const int t = u.pm * BM + (idx >> 2) * HALF + wr * 64 + (idx & 3) * 16 + fr; const unsigned* xp_ = xs + (size_t)t * 16 + 4 * fq;
#pragma unroll
            for (int q = 0; q < 4; ++q) Pp[idx][q] = __hip_atomic_load(xp_ + q, __ATOMIC_RELAXED, __HIP_MEMORY_SCOPE_AGENT); }
#pragma unroll
        for (int idx = 0; idx < 8; ++idx) { const int ai = idx >> 2, m = idx & 3; const int t = u.pm * BM + ai * HALF + wr * 64 + m * 16 + fr; float* orow = out + (size_t)t * DM;
            float s = (__uint_as_float(Pp[idx][0]) + __uint_as_float(Pp[idx][1])) + (__uint_as_float(Pp[idx][2]) + __uint_as_float(Pp[idx][3]));
            s += __shfl_xor(s, 16); s += __shfl_xor(s, 32);
            const float rs = 1.f / sqrtf(s * (1.f / DM) + EPS);
#pragma unroll
            for (int bj = 0; bj < 2; ++bj)
#pragma unroll
                for (int n = 0; n < 2; ++n) *(f32x4*)(orow + cb0 + bj * HALF + 4 * n) = acc[ai][bj][m][n] * rs * W4[bj][n]; }
    }
};
}

DI void transpose_item(const float* W, int ldw, int src_col0, int k0, bf16_t* WT, int K, int dst_row0, const float* kscale, float nscale, LAS float* scr, int lane) {
    float wv[32];
#pragma unroll
    for (int i = 0; i < 32; ++i) { const int kk = 2 * i + (lane >> 5); wv[i] = W[(size_t)(k0 + kk) * ldw + src_col0 + (lane & 31)]; }
#pragma unroll
    for (int i = 0; i < 32; ++i) { const int kk = 2 * i + (lane >> 5); const float s = kscale ? kscale[k0 + kk] * nscale : nscale;
        scr[kk * 33 + (lane & 31)] = wv[i] * s; }
    asm volatile("s_waitcnt lgkmcnt(0)" ::: "memory");
    const int c = lane & 7;
#pragma unroll
    for (int j = 0; j < 4; ++j) { const int n = (lane >> 3) + 8 * j; const LAS float* s = scr + (8 * c) * 33 + n;
        u32x4 o; o.x = pk2(s[0 * 33], s[1 * 33]); o.y = pk2(s[2 * 33], s[3 * 33]); o.z = pk2(s[4 * 33], s[5 * 33]); o.w = pk2(s[6 * 33], s[7 * 33]);
        *(u32x4*)(WT + (size_t)(dst_row0 + n) * K + k0 + 8 * c) = o; }
    asm volatile("s_waitcnt lgkmcnt(0)" ::: "memory");
}
DI float reduce16(const float (&p)[16], int lane) {
    const bool b5 = lane & 32, b4 = lane & 16, b3 = lane & 8, b2 = lane & 4;
    float q[8], r[4], s[2];
#pragma unroll
    for (int j = 0; j < 8; ++j) { const float send = b5 ? p[j] : p[j + 8], keep = b5 ? p[j + 8] : p[j]; q[j] = keep + __shfl_xor(send, 32); }
#pragma unroll
    for (int j = 0; j < 4; ++j) { const float send = b4 ? q[j] : q[j + 4], keep = b4 ? q[j + 4] : q[j]; r[j] = keep + __shfl_xor(send, 16); }
#pragma unroll
    for (int j = 0; j < 2; ++j) { const float send = b3 ? r[j] : r[j + 2], keep = b3 ? r[j + 2] : r[j]; s[j] = keep + __shfl_xor(send, 8); }
    const float send = b2 ? s[0] : s[1], keep = b2 ? s[1] : s[0]; float v = keep + __shfl_xor(send, 4);
    v += __shfl_xor(v, 2); v += __shfl_xor(v, 1); return v;
}

struct ChunkVec { float g0, g1, b0, b1, cm0, cm1, btot, gmax; int s0, s1; };
DI ChunkVec chunk_vectors(int d, const float* gates, int t0, int head, int lane) {
    ChunkVec r; const int e0 = 2 * lane, e1 = e0 + 1; r.s0 = d ? 127 - e0 : e0; r.s1 = d ? 127 - e1 : e1;
    const float* g0p = gates + (size_t)(t0 + r.s0) * 16 + d * 4 + head; const float* g1p = gates + (size_t)(t0 + r.s1) * 16 + d * 4 + head;
    const float i0 = g0p[0], f0 = g0p[8], i1 = g1p[0], f1 = g1p[8];
    const float lf0 = logsigmoid_(f0), lf1 = logsigmoid_(f1);
    float ps = lf0 + lf1;
#pragma unroll
    for (int o = 1; o < 64; o <<= 1) { const float t = __shfl_up(ps, o); if (lane >= o) ps += t; }
    const float excl = ps - (lf0 + lf1); r.b0 = excl + lf0; r.b1 = r.b0 + lf1;
    r.g0 = i0 - r.b0; r.g1 = i1 - r.b1;
    float cm = fmaxf(r.g0, r.g1);
#pragma unroll
    for (int o = 1; o < 64; o <<= 1) { const float t = __shfl_up(cm, o); if (lane >= o) cm = fmaxf(cm, t); }
    float ex = __shfl_up(cm, 1); if (lane == 0) ex = -INFINITY;
    r.cm0 = fmaxf(ex, r.g0); r.cm1 = fmaxf(r.cm0, r.g1);
    r.btot = __shfl(r.b1, 63); r.gmax = __shfl(r.cm1, 63);
    return r;
}

struct Ctx {
    const float* in[17]; float* out; unsigned char* ws;
};

DI void summary_unit(LAS unsigned char* lds, const Ctx& c, int chunk, int head, int tid, int lane, int wid) {
    asm volatile("" : "+v"(tid), "+v"(lane));
    const int t0 = chunk * 128, fr = lane & 15, fq = lane >> 4;
    LAS bf16_t* LVT = (LAS bf16_t*)lds; LAS bf16_t* LKF = (LAS bf16_t*)(lds + 34816); LAS bf16_t* LKB = (LAS bf16_t*)(lds + 69632); LAS float* vW = (LAS float*)(lds + 104448);
    const float* gates = (const float*)(c.ws + WS_GATES);
    const bf16_t* MK = (const bf16_t*)(c.ws + WS_MK); const bf16_t* MV = (const bf16_t*)(c.ws + WS_MV);
    u32x4 v8r[4], k8r[4];
#pragma unroll
    for (int i = 0; i < 4; ++i) { const int idx = tid + 512 * i, s = idx & 127, ch = idx >> 7; const size_t go = (size_t)(t0 + s) * 512 + head * 128 + ch * 8; v8r[i] = *(const u32x4*)(MV + go); k8r[i] = *(const u32x4*)(MK + go); }
    if (wid < 2) { const int d = wid; const ChunkVec v = chunk_vectors(d, gates, t0, head, lane);
        vW[d * 128 + v.s0] = __expf(v.g0 - v.gmax); vW[d * 128 + v.s1] = __expf(v.g1 - v.gmax);
        if (lane == 0) { float* sc = (float*)(c.ws + WS_CHSC) + ((size_t)(d * NCHUNK + chunk) * 4 + head) * 2; sc[0] = v.btot; sc[1] = v.btot + v.gmax; } }
    __syncthreads();
#pragma unroll
    for (int i = 0; i < 4; ++i) { const int idx = tid + 512 * i, s = idx & 127, ch = idx >> 7;
        const u32x4 v8 = v8r[i], k8 = k8r[i]; const float wf = vW[s], wb = vW[128 + s];
#pragma unroll
        for (int e = 0; e < 8; ++e) { const unsigned vw = v8[e >> 1], kw = k8[e >> 1]; const float kf = (e & 1) ? bfhi(kw) : bflo(kw);
            LVT[(8 * ch + e) * 136 + s] = (bf16_t)((e & 1) ? (vw >> 16) : (vw & 0xffffu));
            const unsigned fb = pk2(wf * kf, wb * kf); LKF[(8 * ch + e) * 136 + s] = (bf16_t)(fb & 0xffffu); LKB[(8 * ch + e) * 136 + s] = (bf16_t)(fb >> 16); } }
    __syncthreads();
    const int d = wid & 1, cgp = wid >> 1;
    LAS const unsigned char* LKD = (LAS const unsigned char*)(d ? LKB : LKF);
    bf16x8 Y[2][4];
#pragma unroll
    for (int ci = 0; ci < 2; ++ci)
#pragma unroll
        for (int ks = 0; ks < 4; ++ks) Y[ci][ks] = *(LAS const bf16x8*)(LKD + (16 * (2 * cgp + ci) + fr) * 272 + (32 * ks + 8 * fq) * 2);
    bf16_t* ST = (bf16_t*)(c.out) + ((size_t)(d * NCHUNK + chunk) * 4 + head) * ST_ELEMS;
#pragma unroll
    for (int rt = 0; rt < 9; ++rt) {
        bf16x8 X[4];
#pragma unroll
        for (int ks = 0; ks < 4; ++ks) {
            if (rt < 8) X[ks] = *(LAS const bf16x8*)((LAS const unsigned char*)LVT + (16 * rt + fr) * 272 + (32 * ks + 8 * fq) * 2);
            else { const short o = fr == 0 ? (short)0x3F80 : (short)0; X[ks] = (bf16x8){o, o, o, o, o, o, o, o}; } }
#pragma unroll
        for (int ci = 0; ci < 2; ++ci) { f32x4 a = (f32x4){0.f, 0.f, 0.f, 0.f};
#pragma unroll
            for (int ks = 0; ks < 4; ++ks) a = MFMA16(Y[ci][ks], X[ks], a);
            const int v = 16 * rt + fr, k = 16 * (2 * cgp + ci) + 4 * fq;
            if (rt < 8 || fr == 0) { u32x2 w; w.x = pk2(a[0], a[1]); w.y = pk2(a[2], a[3]); *(u32x2*)(ST + (size_t)v * 128 + k) = w; } }
    }
    __syncthreads();
}

DI void attn_unit(LAS unsigned char* lds, const Ctx& c, int qb2, int hk, int tid, int lane, int wid) {
    asm volatile("" : "+v"(tid), "+v"(lane));
    const int t0 = qb2 * 256, fr = lane & 15, fq = lane >> 4;
    const int nseq = qb2 < 64 ? qb2 : ((qb2 - 64) & 15), Nseq = qb2 < 64 ? 64 : 16, pos0 = nseq * 256;
    const bool bv0 = nseq >= 1, bv3 = nseq + 1 < Nseq;
    LAS unsigned char* LKB = lds; LAS bf16_t* LVT = (LAS bf16_t*)(lds + 73728);
    const bf16_t* AK = (const bf16_t*)(c.ws + WS_AK); const bf16_t* AV = (const bf16_t*)(c.ws + WS_AV); const bf16_t* AQ = (const bf16_t*)(c.ws + WS_AQ);
    const float* rope = (const float*)(c.ws + WS_ROPE);
    const int g = wid >> 2, rg = wid & 3, hq = 2 * hk + g, r0 = 64 * rg;
#define ATT_OK(j) ((((j) >> 7) == 0) ? bv0 : ((((j) >> 7) == 3) ? bv3 : true))
    u32x4 kb[6];
#pragma unroll
    for (int i = 0; i < 6; ++i) { const int idx = tid + 512 * i; const int j = idx / 6, ch = 2 + (idx - 6 * j); const bool ok = ATT_OK(j);
        const int tok = ok ? t0 - 128 + j : t0 + (j & 127); kb[i] = *(const u32x4*)((const char*)AK + (unsigned)((tok * 256 + hk * 64 + ch * 8) * 2)); }
    u32x4 kx1, kx2; f32x4 ktb[4];
    { const int j = tid; const bool ok = ATT_OK(j); const int tok = ok ? t0 - 128 + j : t0 + (j & 127);
      const unsigned ko = (unsigned)((tok * 256 + hk * 64) * 2); kx1 = *(const u32x4*)((const char*)AK + ko); kx2 = *(const u32x4*)((const char*)AK + ko + 16u);
      const unsigned to = (unsigned)((ok ? pos0 - 128 + j : 0) * 64);
#pragma unroll
      for (int q = 0; q < 4; ++q) ktb[q] = *(const f32x4*)((const char*)rope + to + 16u * q); }
    u32x4 vb[8];
#pragma unroll
    for (int i = 0; i < 8; ++i) { const int idx = tid + 512 * i, ch = idx >> 9, j = idx & 511; const bool ok = ATT_OK(j);
        const int tok = ok ? t0 - 128 + j : t0 + (j & 127); vb[i] = *(const u32x4*)((const char*)AV + (unsigned)((tok * 256 + hk * 64 + ch * 8) * 2)); }
#pragma unroll
    for (int i = 0; i < 6; ++i) { const int idx = tid + 512 * i; const int j = idx / 6, ch = 2 + (idx - 6 * j); const bool ok = ATT_OK(j);
        *(LAS u32x4*)(LKB + j * 144 + ch * 16) = ok ? kb[i] : (u32x4){0u, 0u, 0u, 0u}; }
    { const int j = tid; const bool ok = ATT_OK(j);
      float ra[8], rb[8];
#pragma unroll
      for (int e = 0; e < 8; ++e) { const float a = (e & 1) ? bfhi(kx1[e >> 1]) : bflo(kx1[e >> 1]), b = (e & 1) ? bfhi(kx2[e >> 1]) : bflo(kx2[e >> 1]); const float cs = ktb[e >> 2][e & 3], sn = ktb[2 + (e >> 2)][e & 3];
          ra[e] = a * cs - b * sn; rb[e] = b * cs + a * sn; }
      u32x4 o1, o2; o1.x = pk2(ra[0], ra[1]); o1.y = pk2(ra[2], ra[3]); o1.z = pk2(ra[4], ra[5]); o1.w = pk2(ra[6], ra[7]); o2.x = pk2(rb[0], rb[1]); o2.y = pk2(rb[2], rb[3]); o2.z = pk2(rb[4], rb[5]); o2.w = pk2(rb[6], rb[7]);
      if (!ok) { o1 = (u32x4){0u, 0u, 0u, 0u}; o2 = o1; }
      *(LAS u32x4*)(LKB + j * 144) = o1; *(LAS u32x4*)(LKB + j * 144 + 16) = o2; }
#pragma unroll
    for (int i = 0; i < 8; ++i) { const int idx = tid + 512 * i, ch = idx >> 9, j = idx & 511; const bool ok = ATT_OK(j);
        const u32x4 v8 = ok ? vb[i] : (u32x4){0u, 0u, 0u, 0u};
#pragma unroll
        for (int e = 0; e < 8; ++e) { const unsigned vw = v8[e >> 1]; LVT[(8 * ch + e) * 520 + j] = (bf16_t)((e & 1) ? (vw >> 16) : (vw & 0xffffu)); } }
    asm volatile("" ::: "memory");
    const float sink = c.in[7][hq] * 1.4426950408889634f;
    bf16x8 Xq[4][2];
#pragma unroll
    for (int mi = 0; mi < 4; ++mi) { const int rho = r0 + 16 * mi + fr; const unsigned qo = (unsigned)(((t0 + rho) * 512 + hq * 64 + 8 * fq) * 2);
#pragma unroll
        for (int ks = 0; ks < 2; ++ks) {
            u32x4 q = *(const u32x4*)((const char*)AQ + qo + 64u * ks);
            if (ks == 0) { u32x4 pr; pr.x = __shfl_xor(q.x, 16); pr.y = __shfl_xor(q.y, 16); pr.z = __shfl_xor(q.z, 16); pr.w = __shfl_xor(q.w, 16);
                if (fq < 2) { float r[8]; const float* tb = rope + (size_t)(pos0 + rho) * 16;
#pragma unroll
                    for (int e = 0; e < 8; ++e) { const float own = (e & 1) ? bfhi(q[e >> 1]) : bflo(q[e >> 1]), oth = (e & 1) ? bfhi(pr[e >> 1]) : bflo(pr[e >> 1]); const float cs = tb[e], sn = tb[8 + e];
                        r[e] = fq == 0 ? (own * cs - oth * sn) : (own * cs + oth * sn); }
                    q.x = pk2(r[0], r[1]); q.y = pk2(r[2], r[3]); q.z = pk2(r[4], r[5]); q.w = pk2(r[6], r[7]); } }
            Xq[mi][ks] = __builtin_bit_cast(bf16x8, q); } }
    __syncthreads();
    f32x4 O[4][4]; float mrow[4], lrow[4];
#pragma unroll
    for (int mi = 0; mi < 4; ++mi) { mrow[mi] = sink; lrow[mi] = fq == 0 ? 1.f : 0.f;
#pragma unroll
        for (int nd = 0; nd < 4; ++nd) O[mi][nd] = (f32x4){0.f, 0.f, 0.f, 0.f}; }
    for (int kt = 0; kt < 10; ++kt) {
        const int j0 = r0 + 32 * kt;
        if (!ATT_OK(j0)) continue;
#pragma unroll
        for (int mh = 0; mh < 2; ++mh) {
            const int ra0 = r0 + 32 * mh;
            if (j0 + 31 < ra0 || j0 > ra0 + 31 + 256) continue;
            f32x4 S[2][2];
#pragma unroll
            for (int m2 = 0; m2 < 2; ++m2)
#pragma unroll
                for (int ni = 0; ni < 2; ++ni) S[m2][ni] = (f32x4){0.f, 0.f, 0.f, 0.f};
#pragma unroll
            for (int ks = 0; ks < 2; ++ks)
#pragma unroll
                for (int ni = 0; ni < 2; ++ni) { const bf16x8 Yk = *(LAS const bf16x8*)(LKB + (j0 + 16 * ni + fr) * 144 + (32 * ks + 8 * fq) * 2);
#pragma unroll
                    for (int m2 = 0; m2 < 2; ++m2) S[m2][ni] = MFMA16(Yk, Xq[2 * mh + m2][ks], S[m2][ni]); }
            bf16x8 Xp[2];
#pragma unroll
            for (int m2 = 0; m2 < 2; ++m2) { const int mi = 2 * mh + m2; const int rhoa = r0 + 16 * mi, rho = rhoa + fr;
                const bool full = (j0 >= rhoa + 15) && (j0 + 31 <= rhoa + 256);
                float mx = -INFINITY;
                if (full) {
#pragma unroll
                    for (int ni = 0; ni < 2; ++ni)
#pragma unroll
                        for (int jj = 0; jj < 4; ++jj) mx = fmaxf(mx, S[m2][ni][jj]);
                } else {
#pragma unroll
                    for (int ni = 0; ni < 2; ++ni)
#pragma unroll
                        for (int jj = 0; jj < 4; ++jj) { const int j = j0 + 16 * ni + 4 * fq + jj; const bool ok = (j >= rho) && (j <= rho + 256);
                            const float sv = ok ? S[m2][ni][jj] : -INFINITY; S[m2][ni][jj] = sv; mx = fmaxf(mx, sv); }
                }
                if (__builtin_amdgcn_ballot_w64(mx > mrow[mi] + 6.0f) != 0ull) {
                    mx = fmaxf(mx, __shfl_xor(mx, 16)); mx = fmaxf(mx, __shfl_xor(mx, 32));
                    const float mnew = fmaxf(mrow[mi], mx), alpha = __builtin_amdgcn_exp2f(mrow[mi] - mnew); mrow[mi] = mnew; lrow[mi] *= alpha;
#pragma unroll
                    for (int nd = 0; nd < 4; ++nd) O[mi][nd] *= alpha; }
                const float mref = mrow[mi];
                float p[8], ps = 0.f;
#pragma unroll
                for (int e = 0; e < 8; ++e) { p[e] = __builtin_amdgcn_exp2f(S[m2][e >> 2][e & 3] - mref); ps += p[e]; }
                lrow[mi] += ps;
                Xp[m2] = pack8(p); }
#pragma unroll
            for (int nd = 0; nd < 4; ++nd) { const LAS bf16_t* vp = LVT + (16 * nd + fr) * 520 + j0 + 4 * fq;
                const s16x4 lo = *(LAS const s16x4*)vp, hi = *(LAS const s16x4*)(vp + 16);
                const bf16x8 Yv = (bf16x8){lo[0], lo[1], lo[2], lo[3], hi[0], hi[1], hi[2], hi[3]};
#pragma unroll
                for (int m2 = 0; m2 < 2; ++m2) O[2 * mh + m2][nd] = MFMA16(Yv, Xp[m2], O[2 * mh + m2][nd]); }
        }
    }
#pragma unroll
    for (int mi = 0; mi < 4; ++mi) { float l = lrow[mi]; l += __shfl_xor(l, 16); l += __shfl_xor(l, 32); const float inv = 1.f / l;
        bf16_t* op = (bf16_t*)(c.ws + WS_HMOA) + (size_t)(t0 + r0 + 16 * mi + fr) * 1024 + 512 + hq * 64 + 4 * fq;
#pragma unroll
        for (int nd = 0; nd < 4; ++nd) { const f32x4 o = O[mi][nd] * inv; u32x2 w; w.x = pk2(o[0], o[1]); w.y = pk2(o[2], o[3]); *(u32x2*)(op + 16 * nd) = w; } }
    __syncthreads();
#undef ATT_OK
}

DI void scan_item(const Ctx& c, int st, int slice, int lane) {
    const int seq = st >> 3, head = (st >> 1) & 3, d = st & 1;
    const int chunk0 = seq == 0 ? 0 : 128 + 32 * (seq - 1), nch = seq == 0 ? 128 : 32;
    const int e0 = slice * 512 + lane * 8; const bool act = e0 < ST_ELEMS;
    bf16_t* CST = (bf16_t*)c.out; const float* CHSC = (const float*)(c.ws + WS_CHSC); float* MP = (float*)(c.ws + WS_MPREV);
    float C[8];
#pragma unroll
    for (int e = 0; e < 8; ++e) C[e] = 0.f;
    float m = 0.f;
    for (int i0 = 0; i0 < nch; i0 += 8) {
        u32x4 ld[8]; float bt[8], ml[8];
#pragma unroll
        for (int u = 0; u < 8; ++u) { const int ch = d ? chunk0 + nch - 1 - (i0 + u) : chunk0 + i0 + u; const size_t ti = (size_t)(d * NCHUNK + ch) * 4 + head;
            ld[u] = act ? *(const u32x4*)(CST + ti * ST_ELEMS + e0) : (u32x4){0u, 0u, 0u, 0u}; bt[u] = CHSC[ti * 2]; ml[u] = CHSC[ti * 2 + 1]; }
#pragma unroll
        for (int u = 0; u < 8; ++u) { const int ch = d ? chunk0 + nch - 1 - (i0 + u) : chunk0 + i0 + u; const size_t ti = (size_t)(d * NCHUNK + ch) * 4 + head;
            if (slice == 0 && lane == 0) MP[ti] = m;
            u32x4 o; o.x = pk2(C[0], C[1]); o.y = pk2(C[2], C[3]); o.z = pk2(C[4], C[5]); o.w = pk2(C[6], C[7]);
            if (act) *(u32x4*)(CST + ti * ST_ELEMS + e0) = o;
            const float mn = fmaxf(bt[u] + m, ml[u]), sp = __expf(bt[u] + m - mn), sl = __expf(ml[u] - mn); m = mn;
#pragma unroll
            for (int e = 0; e < 8; ++e) { const unsigned w = ld[u][e >> 1]; const float cl = (e & 1) ? bfhi(w) : bflo(w); C[e] = sp * C[e] + sl * cl; } }
    }
}

template <int DIR> DI void dir_pass(const f32x4 (&S)[8], const bf16x8 (&Xq)[4], LAS const unsigned char* LS, LAS const unsigned char* LVTb, LAS const float* vec, int trow, int fr, int fq, f32x4 (&hs)[8]) {
    f32x4 acc[9];
#pragma unroll
    for (int nt = 0; nt < 9; ++nt) { acc[nt] = (f32x4){0.f, 0.f, 0.f, 0.f};
#pragma unroll
        for (int ks = 0; ks < 4; ++ks) { const bf16x8 Y = *(LAS const bf16x8*)(LS + (16 * nt + fr) * 272 + (32 * ks + 8 * fq) * 2); acc[nt] = MFMA16(Y, Xq[ks], acc[nt]); } asm volatile("" ::: "memory"); }
    const float Mt = vec[128 + trow], ex = vec[256 + trow], iw = vec[384 + trow];
#pragma unroll
    for (int nt = 0; nt < 9; ++nt) acc[nt] *= iw;
    bf16x8 Xp[4];
#pragma unroll
    for (int kp = 0; kp < 4; ++kp) { float p[8];
#pragma unroll
        for (int h2 = 0; h2 < 2; ++h2) { const int n = 2 * kp + h2; const f32x4 g4 = *(LAS const f32x4*)(vec + 16 * n + 4 * fq);
#pragma unroll
            for (int j = 0; j < 4; ++j) { const int s = 16 * n + 4 * fq + j; const bool ok = DIR == 0 ? (s <= trow) : (s >= trow);
                p[4 * h2 + j] = ok ? S[n][j] * __builtin_amdgcn_exp2f(g4[j] - Mt) : 0.f; } }
        Xp[kp] = pack8(p); }
#pragma unroll
    for (int nt = 0; nt < 8; ++nt)
#pragma unroll
        for (int kp = 0; kp < 4; ++kp) { LAS const unsigned char* vp = LVTb + (16 * nt + fr) * 272 + (32 * kp + 4 * fq) * 2;
            const s16x4 lo = *(LAS const s16x4*)vp, hi = *(LAS const s16x4*)(vp + 32);
            const bf16x8 Y = (bf16x8){lo[0], lo[1], lo[2], lo[3], hi[0], hi[1], hi[2], hi[3]};
            acc[nt] = MFMA16(Y, Xp[kp], acc[nt]); if (kp == 3) asm volatile("" ::: "memory"); }
    { const short o = fr == 0 ? (short)0x3F80 : (short)0; const bf16x8 ones = (bf16x8){o, o, o, o, o, o, o, o};
#pragma unroll
        for (int kp = 0; kp < 4; ++kp) acc[8] = MFMA16(ones, Xp[kp], acc[8]); }
    const float den = __shfl(acc[8][0], fr);
    const float inv = 1.f / fmaxf(fabsf(den), ex);
#pragma unroll
    for (int nt = 0; nt < 8; ++nt) { if (DIR == 0) hs[nt] = acc[nt] * inv; else hs[nt] += acc[nt] * inv; }
}
DI void mlstm_out_unit(LAS unsigned char* lds, const Ctx& c, int chunk, int head, int tid, int lane, int wid) {
    asm volatile("" : "+v"(tid), "+v"(lane));
    const int t0 = chunk * 128, fr = lane & 15, fq = lane >> 4;
    LAS unsigned char* LQ = lds; LAS unsigned char* LK = lds + 34816; LAS unsigned char* LVTb = lds + 73984; LAS unsigned char* LSB = lds + 108800; LAS float* vec = (LAS float*)(lds + 147968);
    LAS bf16_t* LVT = (LAS bf16_t*)LVTb;
    const bf16_t* MQ = (const bf16_t*)(c.ws + WS_MQ); const bf16_t* MK = (const bf16_t*)(c.ws + WS_MK); const bf16_t* MV = (const bf16_t*)(c.ws + WS_MV); bf16_t* MO = (bf16_t*)(c.ws + WS_MO);
    const bf16_t* CSTF = (const bf16_t*)c.out + ((size_t)(0 * NCHUNK + chunk) * 4 + head) * ST_ELEMS; const bf16_t* CSTB = (const bf16_t*)c.out + ((size_t)(1 * NCHUNK + chunk) * 4 + head) * ST_ELEMS;
    u32x4 qr[4], kr[4], vr[4], sbr[5], sfr[5];
#pragma unroll
    for (int i = 0; i < 4; ++i) { const int idx = tid + 512 * i, r = idx >> 4, ch = idx & 15; const size_t go = (size_t)(t0 + r) * 512 + head * 128 + ch * 8; qr[i] = *(const u32x4*)(MQ + go); kr[i] = *(const u32x4*)(MK + go); }
#pragma unroll
    for (int i = 0; i < 4; ++i) { const int idx = tid + 512 * i, s = idx & 127, ch = idx >> 7; vr[i] = *(const u32x4*)(MV + (size_t)(t0 + s) * 512 + head * 128 + ch * 8); }
#pragma unroll
    for (int i = 0; i < 5; ++i) { int idx = tid + 512 * i; idx = idx < 2304 ? idx : 2303; const int r = idx >> 4, ch = idx & 15, rc = r < 129 ? r : 128;
        sbr[i] = *(const u32x4*)(CSTB + rc * 128 + ch * 8); sfr[i] = *(const u32x4*)(CSTF + rc * 128 + ch * 8); }
#pragma unroll
    for (int i = 0; i < 4; ++i) { const int idx = tid + 512 * i, r = idx >> 4, ch = idx & 15; *(LAS u32x4*)(LQ + r * 272 + ch * 16) = qr[i]; *(LAS u32x4*)(LK + r * 272 + ch * 16) = kr[i]; }
#pragma unroll
    for (int i = 0; i < 4; ++i) { const int idx = tid + 512 * i, s = idx & 127, ch = idx >> 7; const u32x4 v8 = vr[i];
#pragma unroll
        for (int e = 0; e < 8; ++e) { const unsigned vw = v8[e >> 1]; LVT[(8 * ch + e) * 136 + s] = (bf16_t)((e & 1) ? (vw >> 16) : (vw & 0xffffu)); } }
#pragma unroll
    for (int i = 0; i < 5; ++i) { int idx = tid + 512 * i; idx = idx < 2304 ? idx : 2303; const int r = idx >> 4, ch = idx & 15;
        *(LAS u32x4*)(LSB + r * 272 + ch * 16) = r < 129 ? sbr[i] : (u32x4){0u, 0u, 0u, 0u}; }
    if (wid < 2) { const int d = wid; const ChunkVec v = chunk_vectors(d, (const float*)(c.ws + WS_GATES), t0, head, lane);
        const float mp = ((const float*)(c.ws + WS_MPREV))[(size_t)(d * NCHUNK + chunk) * 4 + head];
        LAS float* vd = vec + d * 512; const float M0 = fmaxf(mp, v.cm0), M1 = fmaxf(mp, v.cm1);
        constexpr float L2E = 1.4426950408889634f;
        vd[v.s0] = v.g0 * L2E; vd[128 + v.s0] = M0 * L2E; vd[256 + v.s0] = __expf(-(v.b0 + M0)); vd[384 + v.s0] = __expf(mp - M0);
        vd[v.s1] = v.g1 * L2E; vd[128 + v.s1] = M1 * L2E; vd[256 + v.s1] = __expf(-(v.b1 + M1)); vd[384 + v.s1] = __expf(mp - M1); }
    __syncthreads();
    const int trow = 16 * wid + fr;
    bf16x8 Xq[4];
#pragma unroll
    for (int ks = 0; ks < 4; ++ks) Xq[ks] = *(LAS const bf16x8*)(LQ + trow * 272 + (32 * ks + 8 * fq) * 2);
    f32x4 S[8];
#pragma unroll
    for (int n = 0; n < 8; ++n) { S[n] = (f32x4){0.f, 0.f, 0.f, 0.f};
#pragma unroll
        for (int ks = 0; ks < 4; ++ks) { const bf16x8 Yk = *(LAS const bf16x8*)(LK + (16 * n + fr) * 272 + (32 * ks + 8 * fq) * 2); S[n] = MFMA16(Yk, Xq[ks], S[n]); } }
    __syncthreads();
#pragma unroll
    for (int i = 0; i < 5; ++i) { int idx = tid + 512 * i; idx = idx < 2304 ? idx : 2303; const int r = idx >> 4, ch = idx & 15;
        *(LAS u32x4*)(LK + r * 272 + ch * 16) = r < 129 ? sfr[i] : (u32x4){0u, 0u, 0u, 0u}; }
    __syncthreads();
    f32x4 hs[8];
    dir_pass<0>(S, Xq, LK, LVTb, vec, trow, fr, fq, hs);
    dir_pass<1>(S, Xq, LSB, LVTb, vec + 512, trow, fr, fq, hs);
    float sum = 0.f;
#pragma unroll
    for (int nt = 0; nt < 8; ++nt) sum += (hs[nt][0] + hs[nt][1]) + (hs[nt][2] + hs[nt][3]);
    sum += __shfl_xor(sum, 16); sum += __shfl_xor(sum, 32);
    const float mean = sum * (1.f / 128.f); float var = 0.f;
#pragma unroll
    for (int nt = 0; nt < 8; ++nt) { hs[nt] -= mean; var += (hs[nt][0] * hs[nt][0] + hs[nt][1] * hs[nt][1]) + (hs[nt][2] * hs[nt][2] + hs[nt][3] * hs[nt][3]); }
    var += __shfl_xor(var, 16); var += __shfl_xor(var, 32);
    const float rstd = __builtin_amdgcn_rsqf(var * (1.f / 128.f) + EPS);
    const float* nw = c.in[6] + head * 128; bf16_t* mop = MO + (size_t)(t0 + trow) * 512 + head * 128;
#pragma unroll
    for (int nt = 0; nt < 8; ++nt) { const int v = 16 * nt + 4 * fq; const u32x2 mo4 = *(const u32x2*)(mop + v); const f32x4 w4 = *(const f32x4*)(nw + v);
        const float o0 = hs[nt][0] * rstd * w4[0] * sigmoidf_(bflo(mo4.x)), o1 = hs[nt][1] * rstd * w4[1] * sigmoidf_(bfhi(mo4.x));
        const float o2 = hs[nt][2] * rstd * w4[2] * sigmoidf_(bflo(mo4.y)), o3 = hs[nt][3] * rstd * w4[3] * sigmoidf_(bfhi(mo4.y));
        u32x2 w; w.x = pk2(o0, o1); w.y = pk2(o2, o3); *(u32x2*)((bf16_t*)(c.ws + WS_HMOA) + (size_t)(t0 + trow) * 1024 + head * 128 + v) = w; }
    __syncthreads();
}

struct Args { const float* in[17]; float* out; unsigned char* ws; int ph_lo, ph_hi; };
constexpr int NPHASE = 9;

__global__ void __launch_bounds__(512, 2) mega(Args args) {
    extern __shared__ __attribute__((aligned(16))) unsigned char lds_raw[];
    LAS unsigned char* lds = (LAS unsigned char*)lds_raw;
    cg::grid_group grid = cg::this_grid();
    const int tid = threadIdx.x, lane = tid & 63, wid = __builtin_amdgcn_readfirstlane(tid >> 6);
    const int G = gridDim.x, gw = blockIdx.x * 8 + wid, NGW = G * 8;
    Ctx c;
#pragma unroll
    for (int i = 0; i < 17; ++i) c.in[i] = args.in[i];
    c.out = args.out; c.ws = args.ws;
    unsigned char* ws = args.ws;
    const int lo = args.ph_lo, hi = args.ph_hi;
#ifndef PH_MASK
#define PH_MASK 0x3ff
#endif
#define IN(k) (((PH_MASK >> (k)) & 1) && lo <= (k) && (k) < hi)
#define REP(k) for (int rep_ = 0; rep_ < (((DUP_MASK >> (k)) & 1) ? 2 : 1); ++rep_)
#define SEAM(k) do { if (IN(k) && IN((k) + 1)) grid.sync(); } while (0)

    REP(0) if (IN(0)) {
        LAS float* scr = (LAS float*)(lds + wid * 16384);
        for (int i = blockIdx.x * 512 + tid; i < 320 * 64; i += G * 512) ((unsigned*)(ws + WS_CTL))[i] = 0u;
        constexpr int I_W1 = 160 * 16, I_PM = 32 * 8, I_PA = 32 * 8, I_WO = 32 * 16, I_UP = 176 * 16, I_WD = 32 * 44;
        constexpr int NITEMS = I_W1 + I_PM + I_PA + I_WO + I_UP + I_WD;
        for (int it = gw; it < NITEMS; it += NGW) {
            int r = it;
            if (r < I_W1) { const int nb = r >> 4, kb = r & 15, dr = 32 * nb, sc = dr < 2048 ? dr : dr + 16;
                const float ns = (dr >= 512 && dr < 1024) ? 0.08838834764831845f : ((dr >= 2048 && dr < 2560) ? 0.18033688011112042f   : 1.f);
                transpose_item(c.in[3], DIN, sc, 64 * kb, (bf16_t*)(ws + WS_W1), 1024, dr, c.in[2], ns, scr, lane); continue; } r -= I_W1;
            if (r < I_PM) { const int nb = r >> 3, kb = r & 7; transpose_item(c.in[8], 1024, 32 * nb, 64 * kb, (bf16_t*)(ws + WS_W1) + (size_t)5120 * 1024, 1024, 32 * nb, nullptr, 1.f, scr, lane); continue; } r -= I_PM;
            if (r < I_PA) { const int nb = r >> 3, kb = r & 7; transpose_item(c.in[9], 1024, 32 * nb, 64 * kb, (bf16_t*)(ws + WS_W1) + (size_t)5120 * 1024 + 512, 1024, 32 * nb, nullptr, 1.f, scr, lane); continue; } r -= I_PA;
            if (r < I_WO) { const int nb = r >> 4, kb = r & 15; transpose_item(c.in[10], 1024, 32 * nb, 64 * kb, (bf16_t*)(ws + WS_WO), 1024, 32 * nb, nullptr, 1.f, scr, lane); continue; } r -= I_WO;
            if (r < I_UP) { const int nb = r >> 4, kb = r & 15, sc = 32 * nb; const int half = sc >= DFF ? 1 : 0, ch = sc - half * DFF; const int dr = 256 * (ch >> 7) + 128 * half + (ch & 127);
                transpose_item(c.in[12], NUP, sc, 64 * kb, (bf16_t*)(ws + WS_WUP), 1024, dr, c.in[11], 1.f, scr, lane); continue; } r -= I_UP;
            { const int nb = r / 44, kb = r - nb * 44; transpose_item(c.in[15], 1024, 32 * nb, 64 * kb, (bf16_t*)(ws + WS_WD), DFF, 32 * nb, nullptr, 1.f, scr, lane); }
        }
        {
            float* rope = (float*)(ws + WS_ROPE);
            for (int i = blockIdx.x * 512 + tid; i < 16384 * 8; i += G * 512) { const int pos = i >> 3, d = i & 7;
                const float invf = d == 0 ? 1.0f : d == 1 ? 0.1939227432012558f : d == 2 ? 0.03760603070259094f : d == 3 ? 0.007292664609849453f : d == 4 ? 0.0014142135623842478f
                                 : d == 5 ? 0.00027424818836152554f : d == 6 ? 5.3182957344688475e-05f : 1.0313385246263351e-05f;
                const float ang = (float)pos * invf; const float k = rintf(ang * 0.15915494309189535f);
                float rr = fmaf(-k, 6.2831854820251465f, ang); rr = fmaf(-k, -1.7484556025237907e-07f, rr);
                rope[pos * 16 + d] = cosf(rr); rope[pos * 16 + 8 + d] = sinf(rr); }
        }
        __syncthreads();
        LAS float* wg = (LAS float*)lds;
        for (int i = tid; i < 16384; i += 512) { const int k = i >> 4, j = i & 15; wg[j * 1024 + k] = c.in[2][k] * c.in[3][(size_t)k * DIN + 2048 + j]; }
        __syncthreads();
        bf16_t* XN = (bf16_t*)(ws + WS_XN); float* gates = (float*)(ws + WS_GATES);
        const float bias = (lane >> 2) < 8 ? c.in[4][lane >> 2] : c.in[5][(lane >> 2) - 8];
        f32x4 va[4], vb[4];
        { const int r0 = gw * 2 < MTOK ? gw * 2 : 0; const f32x4* xa = (const f32x4*)xrow_ptr(c.in[0], c.in[1], r0) + lane; const f32x4* xb = (const f32x4*)xrow_ptr(c.in[0], c.in[1], r0 + 1) + lane;
#pragma unroll
          for (int j = 0; j < 4; ++j) { va[j] = xa[64 * j]; vb[j] = xb[64 * j]; } }
        for (int r0 = gw * 2; r0 < MTOK; r0 += NGW * 2) {
            f32x4 na[4], nb[4];
            { const int rn = r0 + NGW * 2 < MTOK ? r0 + NGW * 2 : r0; const f32x4* xa = (const f32x4*)xrow_ptr(c.in[0], c.in[1], rn) + lane; const f32x4* xb = (const f32x4*)xrow_ptr(c.in[0], c.in[1], rn + 1) + lane;
#pragma unroll
              for (int j = 0; j < 4; ++j) { na[j] = xa[64 * j]; nb[j] = xb[64 * j]; } }
            float sa = 0.f, sb = 0.f;
#pragma unroll
            for (int j = 0; j < 4; ++j) {
                sa += (va[j][0] * va[j][0] + va[j][1] * va[j][1]) + (va[j][2] * va[j][2] + va[j][3] * va[j][3]); sb += (vb[j][0] * vb[j][0] + vb[j][1] * vb[j][1]) + (vb[j][2] * vb[j][2] + vb[j][3] * vb[j][3]); }
            const float rsa = 1.f / sqrtf(wave_sum(sa) * (1.f / DM) + EPS), rsb = 1.f / sqrtf(wave_sum(sb) * (1.f / DM) + EPS);
            float pa[16], pb[16];
#pragma unroll
            for (int g = 0; g < 16; ++g) { float qa = 0.f, qb = 0.f;
#pragma unroll
                for (int j = 0; j < 4; ++j) { const f32x4 w = *(LAS const f32x4*)(wg + g * 1024 + 256 * j + 4 * lane);
                    qa += (va[j][0] * w[0] + va[j][1] * w[1]) + (va[j][2] * w[2] + va[j][3] * w[3]); qb += (vb[j][0] * w[0] + vb[j][1] * w[1]) + (vb[j][2] * w[2] + vb[j][3] * w[3]); }
                pa[g] = qa; pb[g] = qb; asm volatile("" ::: "memory"); }
            const float ga_ = reduce16(pa, lane), gb_ = reduce16(pb, lane);
            if ((lane & 3) == 0) { gates[(size_t)r0 * 16 + (lane >> 2)] = rsa * ga_ + bias; gates[(size_t)(r0 + 1) * 16 + (lane >> 2)] = rsb * gb_ + bias; }
            unsigned long long* oa = (unsigned long long*)(XN + (size_t)r0 * DM) + lane; unsigned long long* ob = (unsigned long long*)(XN + (size_t)(r0 + 1) * DM) + lane;
#pragma unroll
            for (int j = 0; j < 4; ++j) {
                oa[64 * j] = (unsigned long long)pk2(va[j][0] * rsa, va[j][1] * rsa) | ((unsigned long long)pk2(va[j][2] * rsa, va[j][3] * rsa) << 32);
                ob[64 * j] = (unsigned long long)pk2(vb[j][0] * rsb, vb[j][1] * rsb) | ((unsigned long long)pk2(vb[j][2] * rsb, vb[j][3] * rsb) << 32); }
#pragma unroll
            for (int j = 0; j < 4; ++j) { va[j] = na[j]; vb[j] = nb[j]; }
        }
        __syncthreads();
    }
    SEAM(0);

    if (IN(1)) {
        pg8::Gemm g{(const bf16_t*)(ws + WS_XN), (const bf16_t*)(ws + WS_W1), nullptr, nullptr, 1024};
        pg8::DupOrder S; S.s.init(MTOK / 256, 12, G, (int)blockIdx.x); S.dup = (DUP_MASK >> 1) & 1;
        pg8::EpiProj E{ws};
        pg8::gemm_phase<pg8::EpiProj, pg8::DupOrder, true, false>(lds, g, S, E);
    }
    SEAM(1);

    if (IN(2)) {
        constexpr int NSU = NCHUNK * 4, NAU = (NCHUNK / 2) * 4;
        for (int it0 = blockIdx.x; it0 < (((DUP_MASK >> 2) & 1) ? 2 : 1) * (NSU + NAU); it0 += G) { const int it = it0 >= NSU + NAU ? it0 - (NSU + NAU) : it0;
            if (it < NSU) summary_unit(lds, c, it >> 2, it & 3, tid, lane, wid);
            else { const int a = it - NSU; attn_unit(lds, c, a >> 2, a & 3, tid, lane, wid); }
        }
    }
    SEAM(2);

    REP(3) if (IN(3)) {
        constexpr int NPI = 8 * 33, NSI = 128 * 33;
        if (NGW > 2 * NPI) {
            if (gw < NPI) scan_item(c, gw / 33, gw % 33, lane);
            else { const int stride = NGW - NPI; for (int j = gw - NPI; j < NSI; j += stride) scan_item(c, 8 + j / 33, j % 33, lane); }
        } else {
            for (int j = gw; j < NPI + NSI; j += NGW) scan_item(c, j / 33, j % 33, lane);
        }
    }
    SEAM(3);

    REP(4) if (IN(4)) {
        for (int it = blockIdx.x; it < NCHUNK * 4; it += G) mlstm_out_unit(lds, c, it >> 2, it & 3, tid, lane, wid);
    }
    SEAM(4);

    if (IN(5)) {
        const bf16_t* W1t = (const bf16_t*)(ws + WS_W1);
        pg8::Gemm gg{(const bf16_t*)(ws + WS_XN), W1t + (size_t)3072 * 1024, (const bf16_t*)(ws + WS_XN), W1t + (size_t)4096 * 1024, 1024, 0};
        pg8::Gemm gx{(const bf16_t*)(ws + WS_HMOA), W1t + (size_t)5120 * 1024, (const bf16_t*)(ws + WS_HMOA) + 512, W1t + (size_t)5120 * 1024 + 512, 1024, 8};
        pg8::StaticOrder SO; SO.init(MTOK / 256, DM / 256, G, (int)blockIdx.x);
        pg8::EpiGate EG{ws + WS_QSCR}; pg8::EpiMix EM{(bf16_t*)(ws + WS_Y), ws + WS_QSCR};
        pg8::Unit tu;
        for (int k = 0; SO.next(k, tu); ++k) {
            pg8::TileOrder T{tu.pm, tu.pn};
            pg8::gemm_phase<pg8::EpiGate, pg8::TileOrder, true, false>(lds, gg, T, EG);
            pg8::gemm_phase<pg8::EpiMix, pg8::TileOrder, true, false>(lds, gx, T, EM);
        }
    }
    SEAM(5);

    if (IN(6)) {
        pg8::Gemm g{(const bf16_t*)(ws + WS_Y), (const bf16_t*)(ws + WS_WO), nullptr, nullptr, 1024};
        pg8::DupOrder S; S.s.init(MTOK / 256, DM / 256, G, (int)blockIdx.x); S.dup = (DUP_MASK >> 6) & 1;
        pg8::EpiRes<true> E{c.in[0], c.in[1], c.out, (bf16_t*)(ws + WS_HN), (float*)(ws + WS_SS)};
        pg8::gemm_phase<pg8::EpiRes<true>, pg8::DupOrder, true, false>(lds, g, S, E);
    }
    SEAM(6);

    if (IN(7)) {
        pg8::Gemm g{(const bf16_t*)(ws + WS_HN), (const bf16_t*)(ws + WS_WUP), nullptr, nullptr, 1024};
        pg8::DupOrder S; S.s.init(323, NUP / 256, G, (int)blockIdx.x); S.dup = (DUP_MASK >> 7) & 1;
        pg8::EpiConv E{(bf16_t*)(ws + WS_G), (const float*)(ws + WS_SS), c.in[13], c.in[14], (LAS float*)(lds + 131072)};
        pg8::gemm_phase<pg8::EpiConv, pg8::DupOrder, true, true>(lds, g, S, E);
    }
    SEAM(7);

    if (IN(8)) {
        pg8::Gemm g{(const bf16_t*)(ws + WS_G), (const bf16_t*)(ws + WS_WD), nullptr, nullptr, DFF};
        pg8::StaticOrder S; S.init(MTOK / 256, DM / 256, G, (int)blockIdx.x);
        pg8::EpiFinal E{c.out, (const bf16_t*)(ws + WS_HN), c.in[16], (unsigned*)(ws + WS_SS), (unsigned*)(ws + WS_CTL)};
        pg8::gemm_phase<pg8::EpiFinal, pg8::StaticOrder, true, false>(lds, g, S, E);
    }
#undef IN
#undef SEAM
}

extern "C" void kernel_launch(void* const* d_in, const int* in_sizes, int n_in, void* d_out, int out_size, void* d_ws, size_t ws_size, hipStream_t stream) {
    static int grid = 0;
    if (grid == 0) {
        if (n_in != 17 || out_size != MTOK * DM || ws_size < WS_END2) { fprintf(stderr, "kernel_launch: unexpected problem (n_in %d out %d ws %zu)\n", n_in, out_size, ws_size); grid = -1; return; }
        int dev = 0, cus = 0, per_cu = 0;
        if (hipGetDevice(&dev) != hipSuccess || hipDeviceGetAttribute(&cus, hipDeviceAttributeMultiprocessorCount, dev) != hipSuccess) { grid = -1; return; }
        if (hipFuncSetAttribute((const void*)mega, hipFuncAttributeMaxDynamicSharedMemorySize, LDS_BYTES) != hipSuccess) { fprintf(stderr, "kernel_launch: hipFuncSetAttribute failed\n"); grid = -1; return; }
        if (hipOccupancyMaxActiveBlocksPerMultiprocessor(&per_cu, (const void*)mega, 512, LDS_BYTES) != hipSuccess || per_cu < 1) { fprintf(stderr, "kernel_launch: occupancy query says %d\n", per_cu); per_cu = 1; }
        (void)hipGetLastError();
        grid = cus * per_cu;
    }
    if (grid < 0) return;
    Args a{};
    for (int i = 0; i < 17; ++i) a.in[i] = (const float*)d_in[i];
    a.out = (float*)d_out; a.ws = (unsigned char*)d_ws;
#if MK_SINGLE
    a.ph_lo = 0; a.ph_hi = NPHASE;
    void* kargs[] = {&a};
    hipError_t e = hipLaunchCooperativeKernel((const void*)mega, dim3(grid), dim3(512), kargs, LDS_BYTES, stream);
    if (e != hipSuccess) fprintf(stderr, "cooperative launch failed: %s (grid %d)\n", hipGetErrorString(e), grid);
#else
    for (int p = 0; p < NPHASE; ++p) { a.ph_lo = p; a.ph_hi = p + 1; hipLaunchKernelGGL(mega, dim3(grid), dim3(512), LDS_BYTES, stream, a); }
#endif
}
```

```cpp
#include <hip/hip_runtime.h>
#include <hip/hip_cooperative_groups.h>
#include <cstdio>
#include <cstdint>
namespace cg = cooperative_groups;

#ifndef DUP_MASK
#define DUP_MASK 0
#endif
#ifndef MK_SINGLE
#define MK_SINGLE 1
#endif

#define LAS __attribute__((address_space(3)))
#define DI __device__ __forceinline__
typedef unsigned short bf16_t;
typedef short bf16x8 __attribute__((ext_vector_type(8)));
typedef short s16x4 __attribute__((ext_vector_type(4)));
typedef float f32x4 __attribute__((ext_vector_type(4)));
typedef unsigned u32x4 __attribute__((ext_vector_type(4)));
typedef unsigned u32x2 __attribute__((ext_vector_type(2)));

constexpr int MTOK = 81920, DM = 1024, NPROJ = 5120, DIN = 5136, DFF = 2816, NUP = 5632;
constexpr int NCHUNK = 640, PROMPT = 16384;
constexpr float EPS = 1e-6f;
constexpr int ST_ELEMS = 129 * 128;
constexpr size_t ST_BYTES = (size_t)ST_ELEMS * 2;

constexpr size_t MiB = 1u << 20;
constexpr size_t WS_CTL = 0;
constexpr size_t WS_W1 = 2 * MiB, WS_WPM = 13 * MiB, WS_WPA = 14 * MiB, WS_WO = 15 * MiB, WS_WUP = 17 * MiB, WS_WD = 28 * MiB;
constexpr size_t WS_ROPE = 34 * MiB, WS_GATES = 35 * MiB, WS_SS = 40 * MiB, WS_CHSC = 46 * MiB, WS_MPREV = 47 * MiB;
constexpr size_t WS_MQ = 64 * MiB, WS_MK = 144 * MiB, WS_MV = 224 * MiB, WS_MO = 304 * MiB, WS_AQ = 384 * MiB, WS_AK = 464 * MiB, WS_AV = 504 * MiB,
                 WS_GM = 544 * MiB, WS_GA = 704 * MiB, WS_END = 864 * MiB;
constexpr size_t WS_Y = 64 * MiB, WS_HN = 224 * MiB, WS_G = 384 * MiB;
constexpr size_t WS_OA = 864 * MiB, WS_HM = 944 * MiB, WS_END2 = 1024 * MiB;
constexpr size_t OUT_CST = 0;
constexpr size_t WS_XN = WS_GM, WS_QSCR = WS_GA;
constexpr size_t WS_HMOA = 864 * MiB;
constexpr int LDS_BYTES = 152064;

typedef __bf16 bf16n2 __attribute__((ext_vector_type(2)));
typedef float f32n2 __attribute__((ext_vector_type(2)));
DI unsigned pk2(float lo, float hi) { const f32n2 v = {lo, hi}; return __builtin_bit_cast(unsigned, __builtin_convertvector(v, bf16n2)); }
DI unsigned f2bf(float f) { return pk2(f, f) & 0xffffu; }
DI float bflo(unsigned w) { return __uint_as_float(w << 16); }
DI float bfhi(unsigned w) { return __uint_as_float(w & 0xffff0000u); }
DI unsigned cvt_pk_bf16_asm(float lo, float hi) { unsigned r; asm volatile("v_cvt_pk_bf16_f32 %0, %1, %2" : "=v"(r) : "v"(lo), "v"(hi)); return r; }
DI unsigned cvt_pk_bf16(float lo, float hi) { return pk2(lo, hi); }
DI float wave_sum(float v) {
#pragma unroll
    for (int o = 1; o < 64; o <<= 1) v += __shfl_xor(v, o);
    return v;
}
DI float sigmoidf_(float x) { return __builtin_amdgcn_rcpf(1.f + __expf(-x)); }
DI float logsigmoid_(float x) { return x >= 0.f ? -log1pf(expf(-x)) : x - log1pf(expf(x)); }
#define MFMA16(a, b, c) __builtin_amdgcn_mfma_f32_16x16x32_bf16((a), (b), (c), 0, 0, 0)
DI bf16x8 pack8(const float (&p)[8]) {
    u32x4 w; w.x = pk2(p[0], p[1]); w.y = pk2(p[2], p[3]); w.z = pk2(p[4], p[5]); w.w = pk2(p[6], p[7]);
    return __builtin_bit_cast(bf16x8, w);
}
DI const float* xrow_ptr(const float* xp, const float* xs, int t) { return t < PROMPT ? xp + (size_t)t * DM : xs + (size_t)(t - PROMPT) * DM; }
DI bool seq_start(int t) { return t == 0 || (t >= PROMPT && (t & 4095) == 0); }

namespace pg8 {
constexpr int BM = 256, BK = 64, HALF = 128, HTB = HALF * BK * 2, STAGE_BYTES = 8 * HTB, NXCD = 8, WGM = 8;
DI int lds_byte(int r, int c) { const int st = (r >> 4) * 2 + (c >> 5), rr = r & 15, cc = c & 31, ob = rr * 64 + cc * 2; return st * 1024 + (ob ^ (((ob >> 9) & 1) << 5)); }
DI void stage_rc(int b, int& R, int& C) { const int st = b / 1024, sb = b % 1024, swz = sb ^ (((sb >> 9) & 1) << 5); R = (st >> 1) * 16 + swz / 64; C = (st & 1) * 32 + (swz % 64) / 2; }
DI int perm32(int rho) { const int n = rho >> 4, i = rho & 15; return 8 * (i >> 2) + 4 * n + (i & 3); }

struct Unit { int pm, pn, sel; };
struct Gemm { const bf16_t* A; const bf16_t* Bt; const bf16_t* A2; const bf16_t* Bt2; int K; int ntk = 0; };

struct StaticOrder {
    int nM, nN, nwg, G, c;
    DI void init(int nM_, int nN_, int G_, int c_) { nM = nM_; nN = nN_; nwg = nM * nN; G = G_; c = c_; }
    DI bool next(int i, Unit& u) const {
        const long L = (long)i * G + c; if (L >= nwg) return false;
        int wgid = (int)L; { const int q = nwg / NXCD, r = nwg % NXCD, xcd = wgid % NXCD, off = wgid / NXCD; wgid = (xcd < r ? xcd * (q + 1) : r * (q + 1) + (xcd - r) * q) + off; }
        const int nig = WGM * nN, gid = wgid / nig, fm = gid * WGM, gsz = (nM - fm) < WGM ? (nM - fm) : WGM;
        u.pm = fm + ((wgid % nig) % gsz); u.pn = (wgid % nig) / gsz; u.sel = 0; return true;
    }
};
struct DupOrder { StaticOrder s; int dup; DI bool next(int i, Unit& u) const { return s.next(dup ? (i >> 1) : i, u); } };
struct TileOrder { int pm, pn; DI bool next(int i, Unit& u) const { if (i >= 2) return false; u.pm = pm; u.pn = pn; u.sel = i; return true; } };
struct PairOrder {
    StaticOrder s;
    DI bool next(int i, Unit& u) const { if (!s.next(i >> 1, u)) return false; u.sel = i & 1; return true; }
};

template <class Epi, class Sched, bool ALIGN_EPI, bool CONVA>
DI void gemm_phase(LAS unsigned char* lds, const Gemm g, const Sched& S, const Epi& E) {
    const int tid = threadIdx.x, wid = __builtin_amdgcn_readfirstlane(tid >> 6), lane = tid & 63, wr = wid >> 2, wc = wid & 3, fr = lane & 15, fq = lane >> 4;
    const int K = g.K; const int nt = g.ntk ? g.ntk : K / BK;
    unsigned voffA[2], voffB[2];
#pragma unroll
    for (int i = 0; i < 2; ++i) { int R, C; stage_rc(tid * 16 + i * 8192, R, C); const int Rb = Epi::PERM ? ((R & ~31) + perm32(R & 31)) : R;
        const int Ra = CONVA ? (128 * (R >> 6) + 8 * (R & 15) + ((R >> 4) & 3)) : R;
        voffA[i] = (unsigned)(Ra * K + C) * 2u; voffB[i] = (unsigned)(Rb * K + C) * 2u; }
    const size_t kstep = (size_t)(BK * 2);
    const size_t hstepB = (size_t)HALF * K * 2, tstepB = 2 * hstepB;
    const size_t hstepA = CONVA ? (size_t)4 * K * 2 : hstepB, tstepA = CONVA ? (size_t)254 * K * 2 : tstepB;
    const long abias = CONVA ? -(long)K * 2 : 0;
    const unsigned ldsw = (unsigned)wid * 1024u;
    const int aoff = lds_byte(wr * 64 + fr, fq * 8), boff = lds_byte(wc * 32 + fr, fq * 8);
#define PG8_SA(b, h) (((b) * 2 + (h)) * HTB)
#define PG8_SB(b, h) ((4 + (b) * 2 + (h)) * HTB)
#define PG8_STAGE(bufoff, gbase, voff) do { _Pragma("unroll") for (int _i = 0; _i < 2; ++_i) \
        __builtin_amdgcn_global_load_lds((const unsigned*)((const char*)(gbase) + (voff)[_i]), (LAS unsigned*)(lds + (bufoff) + ldsw + _i * 8192), 16, 0, 0); } while (0)
#define PG8_LDA(dst, b, h) do { _Pragma("unroll") for (int m = 0; m < 4; ++m) _Pragma("unroll") for (int k = 0; k < 2; ++k) dst[m][k] = *(const LAS bf16x8*)(lds + PG8_SA(b, h) + aoff + m * 2048 + k * 1024); } while (0)
#define PG8_LDB(dst, b, h) do { _Pragma("unroll") for (int n = 0; n < 2; ++n) _Pragma("unroll") for (int k = 0; k < 2; ++k) dst[n][k] = *(const LAS bf16x8*)(lds + PG8_SB(b, h) + boff + n * 2048 + k * 1024); } while (0)
#define PG8_MMA(ai, bj, At, Bt) do { __builtin_amdgcn_s_setprio(1); _Pragma("unroll") for (int m = 0; m < 4; ++m) _Pragma("unroll") for (int n = 0; n < 2; ++n) _Pragma("unroll") for (int k = 0; k < 2; ++k) \
        acc[ai][bj][m][n] = __builtin_amdgcn_mfma_f32_16x16x32_bf16(Bt[n][k], At[m][k], acc[ai][bj][m][n], 0, 0, 0); __builtin_amdgcn_s_setprio(0); } while (0)
#define PG8_WAIT_V(n) asm volatile("s_waitcnt vmcnt(" #n ")" ::: "memory")
#define PG8_WAIT_L(n) asm volatile("s_waitcnt lgkmcnt(" #n ")" ::: "memory")
#define PG8_WAIT_VN(n) asm volatile("s_waitcnt vmcnt(%0)" :: "n"(n) : "memory")
#define PG8_BAR __builtin_amdgcn_s_barrier()
#define PG8_SCHED __builtin_amdgcn_sched_barrier(0)
    Unit cur, nxt; int ui = 0;
    if (!S.next(0, cur)) return;
    f32x4 acc[2][2][4][2];
#pragma unroll
    for (int a = 0; a < 2; ++a)
#pragma unroll
        for (int b = 0; b < 2; ++b)
#pragma unroll
            for (int m = 0; m < 4; ++m)
#pragma unroll
                for (int n = 0; n < 2; ++n) acc[a][b][m][n] = (f32x4){0.f, 0.f, 0.f, 0.f};
    bf16x8 At[4][2], B0[2][2], B1[2][2];
    const char* cA = (const char*)(cur.sel ? g.A2 : g.A) + (size_t)cur.pm * tstepA + abias; const char* cB = (const char*)(cur.sel ? g.Bt2 : g.Bt) + (size_t)cur.pn * tstepB;
    PG8_STAGE(PG8_SB(0, 0), cB, voffB); PG8_STAGE(PG8_SB(0, 1), cB + hstepB, voffB); PG8_STAGE(PG8_SA(0, 0), cA, voffA); PG8_STAGE(PG8_SA(0, 1), cA + hstepA, voffA);
    if (wr == 1) PG8_BAR;
    PG8_WAIT_V(2); PG8_BAR;
    PG8_STAGE(PG8_SB(1, 0), cB + kstep, voffB); PG8_STAGE(PG8_SA(1, 0), cA + kstep, voffA); PG8_STAGE(PG8_SB(1, 1), cB + hstepB + kstep, voffB);
    PG8_WAIT_V(6); PG8_BAR;
    for (;;) {
        const bool has_next = S.next(ui + 1, nxt);
        const char* nA = has_next ? (const char*)(nxt.sel ? g.A2 : g.A) + (size_t)nxt.pm * tstepA + abias : cA;
        const char* nB = has_next ? (const char*)(nxt.sel ? g.Bt2 : g.Bt) + (size_t)nxt.pn * tstepB : cB;
#define PG8_KBODY(W12) do { \
            PG8_LDB(B0, 0, 0); PG8_LDB(B1, 0, 1); PG8_SCHED; PG8_LDA(At, 0, 0); PG8_STAGE(PG8_SA(1, 1), a1 + hstepA, voffA); \
            W12; PG8_WAIT_L(0); PG8_BAR; PG8_MMA(0, 0, At, B0); PG8_MMA(0, 1, At, B1); PG8_BAR; PG8_SCHED; \
            PG8_LDA(At, 0, 1); PG8_STAGE(PG8_SB(0, 0), b2, voffB); PG8_STAGE(PG8_SB(0, 1), b2 + hstepB, voffB); PG8_STAGE(PG8_SA(0, 0), a2, voffA); \
            W12; PG8_WAIT_L(0); PG8_BAR; PG8_MMA(1, 0, At, B0); PG8_MMA(1, 1, At, B1); PG8_BAR; PG8_SCHED; \
            PG8_LDB(B0, 1, 0); PG8_LDB(B1, 1, 1); PG8_SCHED; PG8_LDA(At, 1, 0); PG8_STAGE(PG8_SA(0, 1), a2 + hstepA, voffA); \
            PG8_WAIT_V(8); PG8_WAIT_L(0); PG8_BAR; PG8_MMA(0, 0, At, B0); PG8_MMA(0, 1, At, B1); PG8_BAR; PG8_SCHED; \
            PG8_LDA(At, 1, 1); PG8_STAGE(PG8_SB(1, 0), b3, voffB); PG8_STAGE(PG8_SB(1, 1), b3 + hstepB, voffB); PG8_STAGE(PG8_SA(1, 0), a3, voffA); \
            PG8_WAIT_V(8); PG8_WAIT_L(0); PG8_BAR; PG8_MMA(1, 0, At, B0); PG8_MMA(1, 1, At, B1); PG8_BAR; PG8_SCHED; } while (0)
        for (int t = 0; t < nt; t += 2) {
            const bool last = (t == nt - 2);
            const char* a1 = cA + (size_t)(t + 1) * kstep;
            const char* a2 = last ? nA : cA + (size_t)(t + 2) * kstep; const char* b2 = last ? nB : cB + (size_t)(t + 2) * kstep;
            const char* a3 = a2 + kstep; const char* b3 = b2 + kstep;
            PG8_KBODY(PG8_WAIT_V(8));
        }
#undef PG8_KBODY
        if constexpr (ALIGN_EPI) { if (wr == 0) PG8_BAR; }
        E(acc, cur, wr, wc, fr, fq);
        if (!has_next) break;
        if (!E.keep(cur)) {
#pragma unroll
            for (int a = 0; a < 2; ++a)
#pragma unroll
                for (int b = 0; b < 2; ++b)
#pragma unroll
                    for (int m = 0; m < 4; ++m)
#pragma unroll
                        for (int n = 0; n < 2; ++n) acc[a][b][m][n] = (f32x4){0.f, 0.f, 0.f, 0.f};
        }
        cur = nxt; cA = nA; cB = nB; ++ui;
        if constexpr (ALIGN_EPI) { if (wr == 1) PG8_BAR; }
    }
    PG8_WAIT_V(0);
    if constexpr (!ALIGN_EPI) { if (wr == 0) PG8_BAR; }
    PG8_BAR;
#undef PG8_SA
#undef PG8_SB
#undef PG8_STAGE
#undef PG8_LDA
#undef PG8_LDB
#undef PG8_MMA
#undef PG8_WAIT_V
#undef PG8_WAIT_L
#undef PG8_WAIT_VN
#undef PG8_BAR
#undef PG8_SCHED
}

struct EpiProj {
    static constexpr bool PERM = true; static constexpr int NVM = 16;
    unsigned char* ws;
    DI bool keep(const Unit&) const { return false; }
    DI void operator()(f32x4 (&acc)[2][2][4][2], const Unit& u, int wr, int wc, int fr, int fq) const {
        const int ct = u.pn; bf16_t* base; int ldc, colt;
        if (ct < 8) { base = (bf16_t*)(ws + WS_MQ + (size_t)(ct >> 1) * (80 * MiB)); ldc = 512; colt = (ct & 1) * 256; }
        else if (ct < 10) { base = (bf16_t*)(ws + WS_AQ); ldc = 512; colt = (ct - 8) * 256; }
        else if (ct == 10) { base = (bf16_t*)(ws + WS_AK); ldc = 256; colt = 0; }
        else if (ct == 11) { base = (bf16_t*)(ws + WS_AV); ldc = 256; colt = 0; }
        else if (ct < 16) { base = (bf16_t*)(ws + WS_GM); ldc = 1024; colt = (ct - 12) * 256; }
        else { base = (bf16_t*)(ws + WS_GA); ldc = 1024; colt = (ct - 16) * 256; }
        const int row0 = u.pm * BM + wr * 64 + fr, col0 = colt + wc * 32 + 8 * fq;
#pragma unroll
        for (int ai = 0; ai < 2; ++ai)
#pragma unroll
            for (int m = 0; m < 4; ++m) { bf16_t* rowp = base + (size_t)(row0 + ai * HALF + m * 16) * ldc + col0;
#pragma unroll
                for (int bj = 0; bj < 2; ++bj) { const f32x4 v0 = acc[ai][bj][m][0], v1 = acc[ai][bj][m][1];
                    u32x4 w; w.x = cvt_pk_bf16(v0[0], v0[1]); w.y = cvt_pk_bf16(v0[2], v0[3]); w.z = cvt_pk_bf16(v1[0], v1[1]); w.w = cvt_pk_bf16(v1[2], v1[3]);
                    *(u32x4*)(rowp + bj * HALF) = w; } }
    }
};
#define PG8_SCR_SETUP const unsigned lo16 = (threadIdx.x & 63u) * 16u; const int wid_ = __builtin_amdgcn_readfirstlane(threadIdx.x >> 6); \
        unsigned char* sa_u = scr + ((size_t)(blockIdx.x * 2 + 0) * 8 + wid_) * 16384; unsigned char* sb_u = scr + ((size_t)(blockIdx.x * 2 + 1) * 8 + wid_) * 16384;
#define sa(k) (sa_u + (k) * 1024 + lo16)
#define sb(k) (sb_u + (k) * 1024 + lo16)
struct EpiGate {
    static constexpr bool PERM = true; static constexpr int NVM = 16;
    unsigned char* scr;
    DI bool keep(const Unit&) const { return false; }
    DI void operator()(f32x4 (&acc)[2][2][4][2], const Unit& u, int wr, int wc, int fr, int fq) const {
        PG8_SCR_SETUP
        if (u.sel == 0) {
#pragma unroll
            for (int ai = 0; ai < 2; ++ai)
#pragma unroll
                for (int m = 0; m < 4; ++m)
#pragma unroll
                    for (int bj = 0; bj < 2; ++bj) { float v[8];
#pragma unroll
                        for (int e = 0; e < 8; ++e) v[e] = sigmoidf_(acc[ai][bj][m][e >> 2][e & 3]);
                        u32x4 w; w.x = pk2(v[0], v[1]); w.y = pk2(v[2], v[3]); w.z = pk2(v[4], v[5]); w.w = pk2(v[6], v[7]);
                        *(u32x4*)sa(ai * 8 + m * 2 + bj) = w; }
        } else {
#pragma unroll
            for (int ai = 0; ai < 2; ++ai) {
                u32x4 A8[4][2];
#pragma unroll
                for (int m = 0; m < 4; ++m)
#pragma unroll
                    for (int bj = 0; bj < 2; ++bj) A8[m][bj] = *(const u32x4*)sa(ai * 8 + m * 2 + bj);
#pragma unroll
                for (int m = 0; m < 4; ++m)
#pragma unroll
                    for (int bj = 0; bj < 2; ++bj) { float r[8], b[8];
#pragma unroll
                        for (int e = 0; e < 8; ++e) { const float av = (e & 1) ? bfhi(A8[m][bj][e >> 1]) : bflo(A8[m][bj][e >> 1]); const float den = 1.f + __expf(-acc[ai][bj][m][e >> 2][e & 3]);
                            b[e] = __builtin_amdgcn_rcpf(den); r[e] = av * den; }
                        u32x4 wr_, wb_; wr_.x = pk2(r[0], r[1]); wr_.y = pk2(r[2], r[3]); wr_.z = pk2(r[4], r[5]); wr_.w = pk2(r[6], r[7]);
                        wb_.x = pk2(b[0], b[1]); wb_.y = pk2(b[2], b[3]); wb_.z = pk2(b[4], b[5]); wb_.w = pk2(b[6], b[7]);
                        *(u32x4*)sa(ai * 8 + m * 2 + bj) = wr_; *(u32x4*)sb(ai * 8 + m * 2 + bj) = wb_; }
            }
        }
    }
};
struct EpiMix {
    static constexpr bool PERM = true; static constexpr int NVM = 16;
    bf16_t* Y; unsigned char* scr;
    DI bool keep(const Unit& u) const { return u.sel == 0; }
    DI void operator()(f32x4 (&acc)[2][2][4][2], const Unit& u, int wr, int wc, int fr, int fq) const {
        PG8_SCR_SETUP
        if (u.sel == 0) {
#pragma unroll
            for (int ai = 0; ai < 2; ++ai) {
                u32x4 A8[4][2];
#pragma unroll
                for (int m = 0; m < 4; ++m)
#pragma unroll
                    for (int bj = 0; bj < 2; ++bj) A8[m][bj] = *(const u32x4*)sa(ai * 8 + m * 2 + bj);
#pragma unroll
                for (int m = 0; m < 4; ++m)
#pragma unroll
                    for (int bj = 0; bj < 2; ++bj)
#pragma unroll
                        for (int e = 0; e < 8; ++e) { const float rv = (e & 1) ? bfhi(A8[m][bj][e >> 1]) : bflo(A8[m][bj][e >> 1]); acc[ai][bj][m][e >> 2][e & 3] *= rv; }
            }
        } else {
            const int row0 = u.pm * BM + wr * 64 + fr, col0 = u.pn * BM + wc * 32 + 8 * fq;
#pragma unroll
            for (int ai = 0; ai < 2; ++ai) {
                u32x4 B8[4][2];
#pragma unroll
                for (int m = 0; m < 4; ++m)
#pragma unroll
                    for (int bj = 0; bj < 2; ++bj) B8[m][bj] = *(const u32x4*)sb(ai * 8 + m * 2 + bj);
#pragma unroll
                for (int m = 0; m < 4; ++m)
#pragma unroll
                    for (int bj = 0; bj < 2; ++bj) { float v[8];
#pragma unroll
                        for (int e = 0; e < 8; ++e) { const float bv = (e & 1) ? bfhi(B8[m][bj][e >> 1]) : bflo(B8[m][bj][e >> 1]); v[e] = acc[ai][bj][m][e >> 2][e & 3] * bv; }
                        u32x4 w; w.x = pk2(v[0], v[1]); w.y = pk2(v[2], v[3]); w.z = pk2(v[4], v[5]); w.w = pk2(v[6], v[7]);
                        *(u32x4*)(Y + (size_t)(row0 + ai * HALF + m * 16) * DM + col0 + bj * HALF) = w; }
            }
        }
    }
};
#undef PG8_SCR_SETUP
#undef sa
#undef sb
template <bool WITH_HN> struct EpiRes {
    static constexpr bool PERM = true; static constexpr int NVM = 16;
    const float* xp; const float* xs; float* out; bf16_t* hn; float* ss;
    DI bool keep(const Unit&) const { return false; }
    template <int Q> DI void ld(f32x4 (&B)[2][2][2], const Unit& u, int wr, int fr, int cb0) const {
#pragma unroll
        for (int mm = 0; mm < 2; ++mm) { const int t = u.pm * BM + (Q >> 1) * HALF + wr * 64 + (2 * (Q & 1) + mm) * 16 + fr; const float* br = xrow_ptr(xp, xs, t);
#pragma unroll
            for (int bj = 0; bj < 2; ++bj)
#pragma unroll
                for (int n = 0; n < 2; ++n) B[mm][bj][n] = *(const f32x4*)(br + cb0 + bj * HALF + 4 * n); }
    }
    template <int Q> DI void st(const f32x4 (&B)[2][2][2], const f32x4 (&acc)[2][2][4][2], const Unit& u, int wr, int wc, int fr, int fq, int cb0) const {
#pragma unroll
        for (int mm = 0; mm < 2; ++mm) { const int m = 2 * (Q & 1) + mm, ai = Q >> 1; const int t = u.pm * BM + ai * HALF + wr * 64 + m * 16 + fr; float ssq = 0.f;
#pragma unroll
            for (int bj = 0; bj < 2; ++bj) { const int c = cb0 + bj * HALF;
                const f32x4 h0 = B[mm][bj][0] + acc[ai][bj][m][0], h1 = B[mm][bj][1] + acc[ai][bj][m][1];
                ssq += ((h0[0] * h0[0] + h0[1] * h0[1]) + (h0[2] * h0[2] + h0[3] * h0[3])) + ((h1[0] * h1[0] + h1[1] * h1[1]) + (h1[2] * h1[2] + h1[3] * h1[3]));
                u32x4 w; w.x = cvt_pk_bf16(h0[0], h0[1]); w.y = cvt_pk_bf16(h0[2], h0[3]); w.z = cvt_pk_bf16(h1[0], h1[1]); w.w = cvt_pk_bf16(h1[2], h1[3]); *(u32x4*)(hn + (size_t)t * DM + c) = w; }
            ssq += __shfl_xor(ssq, 16); ssq += __shfl_xor(ssq, 32); if (fq == 0) ss[(size_t)t * 16 + u.pn * 4 + wc] = ssq; }
    }
    DI void operator()(f32x4 (&acc)[2][2][4][2], const Unit& u, int wr, int wc, int fr, int fq) const {
        const int cb0 = u.pn * BM + wc * 32 + 8 * fq;
        f32x4 B0[2][2][2], B1[2][2][2];
        ld<0>(B0, u, wr, fr, cb0); ld<1>(B1, u, wr, fr, cb0);
        st<0>(B0, acc, u, wr, wc, fr, fq, cb0); ld<2>(B0, u, wr, fr, cb0);
        st<1>(B1, acc, u, wr, wc, fr, fq, cb0); ld<3>(B1, u, wr, fr, cb0);
        st<2>(B0, acc, u, wr, wc, fr, fq, cb0); st<3>(B1, acc, u, wr, wc, fr, fq, cb0);
    }
};
DI float dpp_ror1(float x) { return __builtin_bit_cast(float, __builtin_amdgcn_update_dpp(0, __builtin_bit_cast(int, x), 0x121, 0xf, 0xf, false)); }
DI float dpp_rol1(float x) { return __builtin_bit_cast(float, __builtin_amdgcn_update_dpp(0, __builtin_bit_cast(int, x), 0x12F, 0xf, 0xf, false)); }
struct EpiConv {
    static constexpr bool PERM = true; static constexpr int NVM = 0;
    bf16_t* G; const float* ss; const float* cw; const float* cb; LAS float* xch;
    DI bool keep(const Unit&) const { return false; }
    DI void operator()(f32x4 (&acc)[2][2][4][2], const Unit& u, int wr, int wc, int fr, int fq) const {
        const int t0 = 254 * u.pm - 1 + 128 * wr + 8 * fr;
        unsigned upz = 0, dnz = 0, stm = 0;
        f32x4 P8[8];
#pragma unroll
        for (int idx = 0; idx < 8; ++idx) { const int t = t0 + idx; const int tc = t < 0 ? 0 : (t >= MTOK ? MTOK - 1 : t); P8[idx] = *(const f32x4*)(ss + (size_t)tc * 16 + 4 * fq); }
#pragma unroll
        for (int idx = 0; idx < 8; ++idx) { const int rho = 128 * wr + 8 * fr + idx, t = t0 + idx;
            const f32x4 p = P8[idx]; float s = (p[0] + p[1]) + (p[2] + p[3]); s += __shfl_xor(s, 16); s += __shfl_xor(s, 32);
            const float rs = __builtin_amdgcn_rsqf(s * (1.f / DM) + EPS);
#pragma unroll
            for (int bj = 0; bj < 2; ++bj)
#pragma unroll
                for (int n = 0; n < 2; ++n) acc[idx >> 2][bj][idx & 3][n] *= rs;
            if (seq_start(t)) upz |= 1u << idx;
            if (t + 1 >= MTOK || seq_start(t + 1)) dnz |= 1u << idx;
            if (rho >= 1 && rho <= 254 && t < MTOK) stm |= 1u << idx; }
        const bool anyb = __builtin_amdgcn_ballot_w64((upz | dnz) != 0u) != 0ull;
        f32x4 X[2][2];
        { LAS float* xw = xch + ((wr * 4 + wc) * 4 + fq) * 16; LAS const float* xr = xch + (((wr ^ 1) * 4 + wc) * 4 + fq) * 16;
          if (wr == 0) { if (fr == 15) {
#pragma unroll
              for (int bj = 0; bj < 2; ++bj)
#pragma unroll
                  for (int n = 0; n < 2; ++n) *(LAS f32x4*)(xw + (bj * 2 + n) * 4) = acc[1][bj][3][n]; } }
          else { if (fr == 0) {
#pragma unroll
              for (int bj = 0; bj < 2; ++bj)
#pragma unroll
                  for (int n = 0; n < 2; ++n) *(LAS f32x4*)(xw + (bj * 2 + n) * 4) = acc[0][bj][0][n]; } }
          asm volatile("s_waitcnt lgkmcnt(0)" ::: "memory"); __builtin_amdgcn_s_barrier(); asm volatile("" ::: "memory");
#pragma unroll
          for (int bj = 0; bj < 2; ++bj)
#pragma unroll
              for (int n = 0; n < 2; ++n) X[bj][n] = *(LAS const f32x4*)(xr + (bj * 2 + n) * 4); }
        const bool xup = (wr == 1) && (fr == 0), xdn = (wr == 0) && (fr == 15);
        f32x4 W[2][4];
#define LOADW(n_) _Pragma("unroll") for (int bj = 0; bj < 2; ++bj) { const int cc = bj * DFF + u.pn * 128 + wc * 32 + 8 * fq + 4 * (n_); \
            W[bj][0] = *(const f32x4*)(cw + cc); W[bj][1] = *(const f32x4*)(cw + NUP + cc); W[bj][2] = *(const f32x4*)(cw + 2 * NUP + cc); W[bj][3] = *(const f32x4*)(cb + cc); }
        LOADW(0)
#pragma unroll
        for (int n = 0; n < 2; ++n) {
            const int ch = u.pn * 128 + wc * 32 + 8 * fq + 4 * n;
            float ca[8][4]; unsigned pk[8][2];
#pragma unroll
            for (int bj = 0; bj < 2; ++bj) {
                const f32x4 w0 = W[bj][0], w1 = W[bj][1], w2 = W[bj][2], bb = W[bj][3];
#pragma unroll
                for (int j = 0; j < 4; ++j) {
                    float v[8];
#pragma unroll
                    for (int idx = 0; idx < 8; ++idx) v[idx] = acc[idx >> 2][bj][idx & 3][n][j];
                    float up0 = dpp_ror1(v[7]), dn7 = dpp_rol1(v[0]);
                    up0 = xup ? X[bj][n][j] : up0; dn7 = xdn ? X[bj][n][j] : dn7;
                    float cv[8];
#pragma unroll
                    for (int idx = 0; idx < 8; ++idx) { float up = idx ? v[idx > 0 ? idx - 1 : 0] : up0, dn = idx < 7 ? v[idx < 7 ? idx + 1 : 7] : dn7;
                        if (anyb) { up = ((upz >> idx) & 1u) ? 0.f : up; dn = ((dnz >> idx) & 1u) ? 0.f : dn; }
                        cv[idx] = w0[j] * up + w1[j] * v[idx] + w2[j] * dn + bb[j]; }
                    if (bj == 0) {
#pragma unroll
                        for (int idx = 0; idx < 8; ++idx) ca[idx][j] = cv[idx];
                    } else {
#pragma unroll
                        for (int idx = 0; idx < 8; ++idx) ca[idx][j] = ca[idx][j] * sigmoidf_(ca[idx][j]) * cv[idx];
                    } } }
#pragma unroll
            for (int idx = 0; idx < 8; ++idx) { pk[idx][0] = cvt_pk_bf16_asm(ca[idx][0], ca[idx][1]); pk[idx][1] = cvt_pk_bf16_asm(ca[idx][2], ca[idx][3]); }
            if (n == 0) { LOADW(1) }
#pragma unroll
            for (int idx = 0; idx < 8; ++idx) if ((stm >> idx) & 1u) { u32x2 w; w.x = pk[idx][0]; w.y = pk[idx][1]; *(u32x2*)(G + (size_t)(t0 + idx) * DFF + ch) = w; }
        }
#undef LOADW
    }
};
struct EpiFinal {
    static constexpr bool PERM = true; static constexpr int NVM = 32;
    float* out; const bf16_t* hn; const float* nfw; unsigned* xs; unsigned* cnt;
    DI bool keep(const Unit&) const { return false; }
    template <int Q> DI void ld(f32x4 (&B)[2][2][2], const Unit& u, int wr, int fr, int cb0) const {
#pragma unroll
        for (int mm = 0; mm < 2; ++mm) { const int t = u.pm * BM + (Q >> 1) * HALF + wr * 64 + (2 * (Q & 1) + mm) * 16 + fr; const bf16_t* br = hn + (size_t)t * DM;
#pragma unroll
            for (int bj = 0; bj < 2; ++bj) { const u32x4 w = *(const u32x4*)(br + cb0 + bj * HALF);
                B[mm][bj][0] = (f32x4){bflo(w.x), bfhi(w.x), bflo(w.y), bfhi(w.y)}; B[mm][bj][1] = (f32x4){bflo(w.z), bfhi(w.z), bflo(w.w), bfhi(w.w)}; } }
    }
    template <int Q> DI void add(const f32x4 (&B)[2][2][2], f32x4 (&acc)[2][2][4][2], const Unit& u, int wr, int wc, int fr, int fq) const {
#pragma unroll
        for (int mm = 0; mm < 2; ++mm) { const int m = 2 * (Q & 1) + mm, ai = Q >> 1; const int t = u.pm * BM + ai * HALF + wr * 64 + m * 16 + fr; float ssq = 0.f;
#pragma unroll
            for (int bj = 0; bj < 2; ++bj)
#pragma unroll
                for (int n = 0; n < 2; ++n) { const f32x4 hv = B[mm][bj][n] + acc[ai][bj][m][n]; acc[ai][bj][m][n] = hv; ssq += (hv[0] * hv[0] + hv[1] * hv[1]) + (hv[2] * hv[2] + hv[3] * hv[3]); }
            ssq += __shfl_xor(ssq, 16); ssq += __shfl_xor(ssq, 32);
            if (fq == 0) __hip_atomic_store(xs + (size_t)t * 16 + u.pn * 4 + wc, __float_as_uint(ssq), __ATOMIC_RELAXED, __HIP_MEMORY_SCOPE_AGENT); }
    }
    DI void operator()(f32x4 (&acc)[2][2][4][2], const Unit& u, int wr, int wc, int fr, int fq) const {
        const int lane = threadIdx.x & 63, cb0 = u.pn * BM + wc * 32 + 8 * fq;
        { f32x4 B0[2][2][2], B1[2][2][2];
          ld<0>(B0, u, wr, fr, cb0); ld<1>(B1, u, wr, fr, cb0);
          add<0>(B0, acc, u, wr, wc, fr, fq); ld<2>(B0, u, wr, fr, cb0);
          add<1>(B1, acc, u, wr, wc, fr, fq); ld<3>(B1, u, wr, fr, cb0);
          add<2>(B0, acc, u, wr, wc, fr, fq); add<3>(B1, acc, u, wr, wc, fr, fq); }
        asm volatile("s_waitcnt vmcnt(0)" ::: "memory");
        unsigned* cw_ = cnt + 64 * u.pm;
        if (lane == 0) __hip_atomic_fetch_add(cw_, 1u, __ATOMIC_RELAXED, __HIP_MEMORY_SCOPE_AGENT);
        f32x4 W4[2][2];
#pragma unroll
        for (int bj = 0; bj < 2; ++bj)
#pragma unroll
            for (int n = 0; n < 2; ++n) W4[bj][n] = *(const f32x4*)(nfw + cb0 + bj * HALF + 4 * n);
        while ((unsigned)__builtin_amdgcn_readfirstlane(__hip_atomic_load(cw_, __ATOMIC_RELAXED, __HIP_MEMORY_SCOPE_AGENT)) < 32u) __builtin_amdgcn_s_sleep(2);
        asm volatile("" ::: "memory");
        unsigned Pp[8][4];
#pragma unroll
        for (int idx = 0; idx < 8; ++idx) { const int t = u.pm * BM + (idx >> 2) * HALF + wr * 64 + (idx & 3) * 16 + fr; const unsigned* xp_ = xs + (size_t)t * 16 + 4 * fq;
#pragma unroll
            for (int q = 0; q < 4; ++q) Pp[idx][q] = __hip_atomic_load(xp_ + q, __ATOMIC_RELAXED, __HIP_MEMORY_SCOPE_AGENT); }
#pragma unroll
        for (int idx = 0; idx < 8; ++idx) { const int ai = idx >> 2, m = idx & 3; const int t = u.pm * BM + ai * HALF + wr * 64 + m * 16 + fr; float* orow = out + (size_t)t * DM;
            float s = (__uint_as_float(Pp[idx][0]) + __uint_as_float(Pp[idx][1])) + (__uint_as_float(Pp[idx][2]) + __uint_as_float(Pp[idx][3]));
            s += __shfl_xor(s, 16); s += __shfl_xor(s, 32);
            const float rs = 1.f / sqrtf(s * (1.f / DM) + EPS);
#pragma unroll
            for (int bj = 0; bj < 2; ++bj)
#pragma unroll
                for (int n = 0; n < 2; ++n) *(f32x4*)(orow + cb0 + bj * HALF + 4 * n) = acc[ai][bj][m][n] * rs * W4[bj][n]; }
    }
};
}

DI void transpose_item(const float* W, int ldw, int src_col0, int k0, bf16_t* WT, int K, int dst_row0, const float* kscale, float nscale, LAS float* scr, int lane) {
    float wv[32];
#pragma unroll
    for (int i = 0; i < 32; ++i) { const int kk = 2 * i + (lane >> 5); wv[i] = W[(size_t)(k0 + kk) * ldw + src_col0 + (lane & 31)]; }
#pragma unroll
    for (int i = 0; i < 32; ++i) { const int kk = 2 * i + (lane >> 5); const float s = kscale ? kscale[k0 + kk] * nscale : nscale;
        scr[kk * 33 + (lane & 31)] = wv[i] * s; }
    asm volatile("s_waitcnt lgkmcnt(0)" ::: "memory");
    const int c = lane & 7;
#pragma unroll
    for (int j = 0; j < 4; ++j) { const int n = (lane >> 3) + 8 * j; const LAS float* s = scr + (8 * c) * 33 + n;
        u32x4 o; o.x = pk2(s[0 * 33], s[1 * 33]); o.y = pk2(s[2 * 33], s[3 * 33]); o.z = pk2(s[4 * 33], s[5 * 33]); o.w = pk2(s[6 * 33], s[7 * 33]);
        *(u32x4*)(WT + (size_t)(dst_row0 + n) * K + k0 + 8 * c) = o; }
    asm volatile("s_waitcnt lgkmcnt(0)" ::: "memory");
}
DI float reduce16(const float (&p)[16], int lane) {
    const bool b5 = lane & 32, b4 = lane & 16, b3 = lane & 8, b2 = lane & 4;
    float q[8], r[4], s[2];
#pragma unroll
    for (int j = 0; j < 8; ++j) { const float send = b5 ? p[j] : p[j + 8], keep = b5 ? p[j + 8] : p[j]; q[j] = keep + __shfl_xor(send, 32); }
#pragma unroll
    for (int j = 0; j < 4; ++j) { const float send = b4 ? q[j] : q[j + 4], keep = b4 ? q[j + 4] : q[j]; r[j] = keep + __shfl_xor(send, 16); }
#pragma unroll
    for (int j = 0; j < 2; ++j) { const float send = b3 ? r[j] : r[j + 2], keep = b3 ? r[j + 2] : r[j]; s[j] = keep + __shfl_xor(send, 8); }
    const float send = b2 ? s[0] : s[1], keep = b2 ? s[1] : s[0]; float v = keep + __shfl_xor(send, 4);
    v += __shfl_xor(v, 2); v += __shfl_xor(v, 1); return v;
}

struct ChunkVec { float g0, g1, b0, b1, cm0, cm1, btot, gmax; int s0, s1; };
DI ChunkVec chunk_vectors(int d, const float* gates, int t0, int head, int lane) {
    ChunkVec r; const int e0 = 2 * lane, e1 = e0 + 1; r.s0 = d ? 127 - e0 : e0; r.s1 = d ? 127 - e1 : e1;
    const float* g0p = gates + (size_t)(t0 + r.s0) * 16 + d * 4 + head; const float* g1p = gates + (size_t)(t0 + r.s1) * 16 + d * 4 + head;
    const float i0 = g0p[0], f0 = g0p[8], i1 = g1p[0], f1 = g1p[8];
    const float lf0 = logsigmoid_(f0), lf1 = logsigmoid_(f1);
    float ps = lf0 + lf1;
#pragma unroll
    for (int o = 1; o < 64; o <<= 1) { const float t = __shfl_up(ps, o); if (lane >= o) ps += t; }
    const float excl = ps - (lf0 + lf1); r.b0 = excl + lf0; r.b1 = r.b0 + lf1;
    r.g0 = i0 - r.b0; r.g1 = i1 - r.b1;
    float cm = fmaxf(r.g0, r.g1);
#pragma unroll
    for (int o = 1; o < 64; o <<= 1) { const float t = __shfl_up(cm, o); if (lane >= o) cm = fmaxf(cm, t); }
    float ex = __shfl_up(cm, 1); if (lane == 0) ex = -INFINITY;
    r.cm0 = fmaxf(ex, r.g0); r.cm1 = fmaxf(r.cm0, r.g1);
    r.btot = __shfl(r.b1, 63); r.gmax = __shfl(r.cm1, 63);
    return r;
}

struct Ctx {
    const float* in[17]; float* out; unsigned char* ws;
};

DI void summary_unit(LAS unsigned char* lds, const Ctx& c, int chunk, int head, int tid, int lane, int wid) {
    asm volatile("" : "+v"(tid), "+v"(lane));
    const int t0 = chunk * 128, fr = lane & 15, fq = lane >> 4;
    LAS bf16_t* LVT = (LAS bf16_t*)lds; LAS bf16_t* LKF = (LAS bf16_t*)(lds + 34816); LAS bf16_t* LKB = (LAS bf16_t*)(lds + 69632); LAS float* vW = (LAS float*)(lds + 104448);
    const float* gates = (const float*)(c.ws + WS_GATES);
    const bf16_t* MK = (const bf16_t*)(c.ws + WS_MK); const bf16_t* MV = (const bf16_t*)(c.ws + WS_MV);
    u32x4 v8r[4], k8r[4];
#pragma unroll
    for (int i = 0; i < 4; ++i) { const int idx = tid + 512 * i, s = idx & 127, ch = idx >> 7; const size_t go = (size_t)(t0 + s) * 512 + head * 128 + ch * 8; v8r[i] = *(const u32x4*)(MV + go); k8r[i] = *(const u32x4*)(MK + go); }
    if (wid < 2) { const int d = wid; const ChunkVec v = chunk_vectors(d, gates, t0, head, lane);
        vW[d * 128 + v.s0] = __expf(v.g0 - v.gmax); vW[d * 128 + v.s1] = __expf(v.g1 - v.gmax);
        if (lane == 0) { float* sc = (float*)(c.ws + WS_CHSC) + ((size_t)(d * NCHUNK + chunk) * 4 + head) * 2; sc[0] = v.btot; sc[1] = v.btot + v.gmax; } }
    __syncthreads();
#pragma unroll
    for (int i = 0; i < 4; ++i) { const int idx = tid + 512 * i, s = idx & 127, ch = idx >> 7;
        const u32x4 v8 = v8r[i], k8 = k8r[i]; const float wf = vW[s], wb = vW[128 + s];
#pragma unroll
        for (int e = 0; e < 8; ++e) { const unsigned vw = v8[e >> 1], kw = k8[e >> 1]; const float kf = (e & 1) ? bfhi(kw) : bflo(kw);
            LVT[(8 * ch + e) * 136 + s] = (bf16_t)((e & 1) ? (vw >> 16) : (vw & 0xffffu));
            const unsigned fb = pk2(wf * kf, wb * kf); LKF[(8 * ch + e) * 136 + s] = (bf16_t)(fb & 0xffffu); LKB[(8 * ch + e) * 136 + s] = (bf16_t)(fb >> 16); } }
    __syncthreads();
    const int d = wid & 1, cgp = wid >> 1;
    LAS const unsigned char* LKD = (LAS const unsigned char*)(d ? LKB : LKF);
    bf16x8 Y[2][4];
#pragma unroll
    for (int ci = 0; ci < 2; ++ci)
#pragma unroll
        for (int ks = 0; ks < 4; ++ks) Y[ci][ks] = *(LAS const bf16x8*)(LKD + (16 * (2 * cgp + ci) + fr) * 272 + (32 * ks + 8 * fq) * 2);
    bf16_t* ST = (bf16_t*)(c.out) + ((size_t)(d * NCHUNK + chunk) * 4 + head) * ST_ELEMS;
#pragma unroll
    for (int rt = 0; rt < 9; ++rt) {
        bf16x8 X[4];
#pragma unroll
        for (int ks = 0; ks < 4; ++ks) {
            if (rt < 8) X[ks] = *(LAS const bf16x8*)((LAS const unsigned char*)LVT + (16 * rt + fr) * 272 + (32 * ks + 8 * fq) * 2);
            else { const short o = fr == 0 ? (short)0x3F80 : (short)0; X[ks] = (bf16x8){o, o, o, o, o, o, o, o}; } }
#pragma unroll
        for (int ci = 0; ci < 2; ++ci) { f32x4 a = (f32x4){0.f, 0.f, 0.f, 0.f};
#pragma unroll
            for (int ks = 0; ks < 4; ++ks) a = MFMA16(Y[ci][ks], X[ks], a);
            const int v = 16 * rt + fr, k = 16 * (2 * cgp + ci) + 4 * fq;
            if (rt < 8 || fr == 0) { u32x2 w; w.x = pk2(a[0], a[1]); w.y = pk2(a[2], a[3]); *(u32x2*)(ST + (size_t)v * 128 + k) = w; } }
    }
    __syncthreads();
}

DI void attn_unit(LAS unsigned char* lds, const Ctx& c, int qb2, int hk, int tid, int lane, int wid) {
    asm volatile("" : "+v"(tid), "+v"(lane));
    const int t0 = qb2 * 256, fr = lane & 15, fq = lane >> 4;
    const int nseq = qb2 < 64 ? qb2 : ((qb2 - 64) & 15), Nseq = qb2 < 64 ? 64 : 16, pos0 = nseq * 256;
    const bool bv0 = nseq >= 1, bv3 = nseq + 1 < Nseq;
    LAS unsigned char* LKB = lds; LAS bf16_t* LVT = (LAS bf16_t*)(lds + 73728);
    const bf16_t* AK = (const bf16_t*)(c.ws + WS_AK); const bf16_t* AV = (const bf16_t*)(c.ws + WS_AV); const bf16_t* AQ = (const bf16_t*)(c.ws + WS_AQ);
    const float* rope = (const float*)(c.ws + WS_ROPE);
    const int g = wid >> 2, rg = wid & 3, hq = 2 * hk + g, r0 = 64 * rg;
#define ATT_OK(j) ((((j) >> 7) == 0) ? bv0 : ((((j) >> 7) == 3) ? bv3 : true))
    u32x4 kb[6];
#pragma unroll
    for (int i = 0; i < 6; ++i) { const int idx = tid + 512 * i; const int j = idx / 6, ch = 2 + (idx - 6 * j); const bool ok = ATT_OK(j);
        const int tok = ok ? t0 - 128 + j : t0 + (j & 127); kb[i] = *(const u32x4*)((const char*)AK + (unsigned)((tok * 256 + hk * 64 + ch * 8) * 2)); }
    u32x4 kx1, kx2; f32x4 ktb[4];
    { const int j = tid; const bool ok = ATT_OK(j); const int tok = ok ? t0 - 128 + j : t0 + (j & 127);
      const unsigned ko = (unsigned)((tok * 256 + hk * 64) * 2); kx1 = *(const u32x4*)((const char*)AK + ko); kx2 = *(const u32x4*)((const char*)AK + ko + 16u);
      const unsigned to = (unsigned)((ok ? pos0 - 128 + j : 0) * 64);
#pragma unroll
      for (int q = 0; q < 4; ++q) ktb[q] = *(const f32x4*)((const char*)rope + to + 16u * q); }
    u32x4 vb[8];
#pragma unroll
    for (int i = 0; i < 8; ++i) { const int idx = tid + 512 * i, ch = idx >> 9, j = idx & 511; const bool ok = ATT_OK(j);
        const int tok = ok ? t0 - 128 + j : t0 + (j & 127); vb[i] = *(const u32x4*)((const char*)AV + (unsigned)((tok * 256 + hk * 64 + ch * 8) * 2)); }
#pragma unroll
    for (int i = 0; i < 6; ++i) { const int idx = tid + 512 * i; const int j = idx / 6, ch = 2 + (idx - 6 * j); const bool ok = ATT_OK(j);
        *(LAS u32x4*)(LKB + j * 144 + ch * 16) = ok ? kb[i] : (u32x4){0u, 0u, 0u, 0u}; }
    { const int j = tid; const bool ok = ATT_OK(j);
      float ra[8], rb[8];
#pragma unroll
      for (int e = 0; e < 8; ++e) { const float a = (e & 1) ? bfhi(kx1[e >> 1]) : bflo(kx1[e >> 1]), b = (e & 1) ? bfhi(kx2[e >> 1]) : bflo(kx2[e >> 1]); const float cs = ktb[e >> 2][e & 3], sn = ktb[2 + (e >> 2)][e & 3];
          ra[e] = a * cs - b * sn; rb[e] = b * cs + a * sn; }
      u32x4 o1, o2; o1.x = pk2(ra[0], ra[1]); o1.y = pk2(ra[2], ra[3]); o1.z = pk2(ra[4], ra[5]); o1.w = pk2(ra[6], ra[7]); o2.x = pk2(rb[0], rb[1]); o2.y = pk2(rb[2], rb[3]); o2.z = pk2(rb[4], rb[5]); o2.w = pk2(rb[6], rb[7]);
      if (!ok) { o1 = (u32x4){0u, 0u, 0u, 0u}; o2 = o1; }
      *(LAS u32x4*)(LKB + j * 144) = o1; *(LAS u32x4*)(LKB + j * 144 + 16) = o2; }
#pragma unroll
    for (int i = 0; i < 8; ++i) { const int idx = tid + 512 * i, ch = idx >> 9, j = idx & 511; const bool ok = ATT_OK(j);
        const u32x4 v8 = ok ? vb[i] : (u32x4){0u, 0u, 0u, 0u};
#pragma unroll
        for (int e = 0; e < 8; ++e) { const unsigned vw = v8[e >> 1]; LVT[(8 * ch + e) * 520 + j] = (bf16_t)((e & 1) ? (vw >> 16) : (vw & 0xffffu)); } }
    asm volatile("" ::: "memory");
    const float sink = c.in[7][hq] * 1.4426950408889634f;
    bf16x8 Xq[4][2];
#pragma unroll
    for (int mi = 0; mi < 4; ++mi) { const int rho = r0 + 16 * mi + fr; const unsigned qo = (unsigned)(((t0 + rho) * 512 + hq * 64 + 8 * fq) * 2);
#pragma unroll
        for (int ks = 0; ks < 2; ++ks) {
            u32x4 q = *(const u32x4*)((const char*)AQ + qo + 64u * ks);
            if (ks == 0) { u32x4 pr; pr.x = __shfl_xor(q.x, 16); pr.y = __shfl_xor(q.y, 16); pr.z = __shfl_xor(q.z, 16); pr.w = __shfl_xor(q.w, 16);
                if (fq < 2) { float r[8]; const float* tb = rope + (size_t)(pos0 + rho) * 16;
#pragma unroll
                    for (int e = 0; e < 8; ++e) { const float own = (e & 1) ? bfhi(q[e >> 1]) : bflo(q[e >> 1]), oth = (e & 1) ? bfhi(pr[e >> 1]) : bflo(pr[e >> 1]); const float cs = tb[e], sn = tb[8 + e];
                        r[e] = fq == 0 ? (own * cs - oth * sn) : (own * cs + oth * sn); }
                    q.x = pk2(r[0], r[1]); q.y = pk2(r[2], r[3]); q.z = pk2(r[4], r[5]); q.w = pk2(r[6], r[7]); } }
            Xq[mi][ks] = __builtin_bit_cast(bf16x8, q); } }
    __syncthreads();
    f32x4 O[4][4]; float mrow[4], lrow[4];
#pragma unroll
    for (int mi = 0; mi < 4; ++mi) { mrow[mi] = sink; lrow[mi] = fq == 0 ? 1.f : 0.f;
#pragma unroll
        for (int nd = 0; nd < 4; ++nd) O[mi][nd] = (f32x4){0.f, 0.f, 0.f, 0.f}; }
    for (int kt = 0; kt < 10; ++kt) {
        const int j0 = r0 + 32 * kt;
        if (!ATT_OK(j0)) continue;
#pragma unroll
        for (int mh = 0; mh < 2; ++mh) {
            const int ra0 = r0 + 32 * mh;
            if (j0 + 31 < ra0 || j0 > ra0 + 31 + 256) continue;
            f32x4 S[2][2];
#pragma unroll
            for (int m2 = 0; m2 < 2; ++m2)
#pragma unroll
                for (int ni = 0; ni < 2; ++ni) S[m2][ni] = (f32x4){0.f, 0.f, 0.f, 0.f};
#pragma unroll
            for (int ks = 0; ks < 2; ++ks)
#pragma unroll
                for (int ni = 0; ni < 2; ++ni) { const bf16x8 Yk = *(LAS const bf16x8*)(LKB + (j0 + 16 * ni + fr) * 144 + (32 * ks + 8 * fq) * 2);
#pragma unroll
                    for (int m2 = 0; m2 < 2; ++m2) S[m2][ni] = MFMA16(Yk, Xq[2 * mh + m2][ks], S[m2][ni]); }
            bf16x8 Xp[2];
#pragma unroll
            for (int m2 = 0; m2 < 2; ++m2) { const int mi = 2 * mh + m2; const int rhoa = r0 + 16 * mi, rho = rhoa + fr;
                const bool full = (j0 >= rhoa + 15) && (j0 + 31 <= rhoa + 256);
                float mx = -INFINITY;
                if (full) {
#pragma unroll
                    for (int ni = 0; ni < 2; ++ni)
#pragma unroll
                        for (int jj = 0; jj < 4; ++jj) mx = fmaxf(mx, S[m2][ni][jj]);
                } else {
#pragma unroll
                    for (int ni = 0; ni < 2; ++ni)
#pragma unroll
                        for (int jj = 0; jj < 4; ++jj) { const int j = j0 + 16 * ni + 4 * fq + jj; const bool ok = (j >= rho) && (j <= rho + 256);
                            const float sv = ok ? S[m2][ni][jj] : -INFINITY; S[m2][ni][jj] = sv; mx = fmaxf(mx, sv); }
                }
                mx = fmaxf(mx, __shfl_xor(mx, 16)); mx = fmaxf(mx, __shfl_xor(mx, 32));
                const float mnew = fmaxf(mrow[mi], mx);
                float p[8], ps = 0.f;
#pragma unroll
                for (int e = 0; e < 8; ++e) { p[e] = __builtin_amdgcn_exp2f(S[m2][e >> 2][e & 3] - mnew); ps += p[e]; }
                if (__builtin_amdgcn_ballot_w64(mnew != mrow[mi]) != 0ull) { const float alpha = __builtin_amdgcn_exp2f(mrow[mi] - mnew); mrow[mi] = mnew; lrow[mi] *= alpha;
#pragma unroll
                    for (int nd = 0; nd < 4; ++nd) O[mi][nd] *= alpha; }
                lrow[mi] += ps;
                Xp[m2] = pack8(p); }
#pragma unroll
            for (int nd = 0; nd < 4; ++nd) { const LAS bf16_t* vp = LVT + (16 * nd + fr) * 520 + j0 + 4 * fq;
                const s16x4 lo = *(LAS const s16x4*)vp, hi = *(LAS const s16x4*)(vp + 16);
                const bf16x8 Yv = (bf16x8){lo[0], lo[1], lo[2], lo[3], hi[0], hi[1], hi[2], hi[3]};
#pragma unroll
                for (int m2 = 0; m2 < 2; ++m2) O[2 * mh + m2][nd] = MFMA16(Yv, Xp[m2], O[2 * mh + m2][nd]); }
        }
    }
#pragma unroll
    for (int mi = 0; mi < 4; ++mi) { float l = lrow[mi]; l += __shfl_xor(l, 16); l += __shfl_xor(l, 32); const float inv = 1.f / l;
        bf16_t* op = (bf16_t*)(c.ws + WS_HMOA) + (size_t)(t0 + r0 + 16 * mi + fr) * 1024 + 512 + hq * 64 + 4 * fq;
#pragma unroll
        for (int nd = 0; nd < 4; ++nd) { const f32x4 o = O[mi][nd] * inv; u32x2 w; w.x = pk2(o[0], o[1]); w.y = pk2(o[2], o[3]); *(u32x2*)(op + 16 * nd) = w; } }
    __syncthreads();
#undef ATT_OK
}

DI void scan_item(const Ctx& c, int st, int slice, int lane) {
    const int seq = st >> 3, head = (st >> 1) & 3, d = st & 1;
    const int chunk0 = seq == 0 ? 0 : 128 + 32 * (seq - 1), nch = seq == 0 ? 128 : 32;
    const int e0 = slice * 512 + lane * 8; const bool act = e0 < ST_ELEMS;
    bf16_t* CST = (bf16_t*)c.out; const float* CHSC = (const float*)(c.ws + WS_CHSC); float* MP = (float*)(c.ws + WS_MPREV);
    float C[8];
#pragma unroll
    for (int e = 0; e < 8; ++e) C[e] = 0.f;
    float m = 0.f;
    for (int i0 = 0; i0 < nch; i0 += 8) {
        u32x4 ld[8]; float bt[8], ml[8];
#pragma unroll
        for (int u = 0; u < 8; ++u) { const int ch = d ? chunk0 + nch - 1 - (i0 + u) : chunk0 + i0 + u; const size_t ti = (size_t)(d * NCHUNK + ch) * 4 + head;
            ld[u] = act ? *(const u32x4*)(CST + ti * ST_ELEMS + e0) : (u32x4){0u, 0u, 0u, 0u}; bt[u] = CHSC[ti * 2]; ml[u] = CHSC[ti * 2 + 1]; }
#pragma unroll
        for (int u = 0; u < 8; ++u) { const int ch = d ? chunk0 + nch - 1 - (i0 + u) : chunk0 + i0 + u; const size_t ti = (size_t)(d * NCHUNK + ch) * 4 + head;
            if (slice == 0 && lane == 0) MP[ti] = m;
            u32x4 o; o.x = pk2(C[0], C[1]); o.y = pk2(C[2], C[3]); o.z = pk2(C[4], C[5]); o.w = pk2(C[6], C[7]);
            if (act) *(u32x4*)(CST + ti * ST_ELEMS + e0) = o;
            const float mn = fmaxf(bt[u] + m, ml[u]), sp = __expf(bt[u] + m - mn), sl = __expf(ml[u] - mn); m = mn;
#pragma unroll
            for (int e = 0; e < 8; ++e) { const unsigned w = ld[u][e >> 1]; const float cl = (e & 1) ? bfhi(w) : bflo(w); C[e] = sp * C[e] + sl * cl; } }
    }
}

template <int DIR> DI void dir_pass(const f32x4 (&S)[8], const bf16x8 (&Xq)[4], LAS const unsigned char* LS, LAS const unsigned char* LVTb, LAS const float* vec, int trow, int fr, int fq, f32x4 (&hs)[8]) {
    f32x4 acc[9];
#pragma unroll
    for (int nt = 0; nt < 9; ++nt) { acc[nt] = (f32x4){0.f, 0.f, 0.f, 0.f};
#pragma unroll
        for (int ks = 0; ks < 4; ++ks) { const bf16x8 Y = *(LAS const bf16x8*)(LS + (16 * nt + fr) * 272 + (32 * ks + 8 * fq) * 2); acc[nt] = MFMA16(Y, Xq[ks], acc[nt]); } asm volatile("" ::: "memory"); }
    const float Mt = vec[128 + trow], ex = vec[256 + trow], iw = vec[384 + trow];
#pragma unroll
    for (int nt = 0; nt < 9; ++nt) acc[nt] *= iw;
    bf16x8 Xp[4];
#pragma unroll
    for (int kp = 0; kp < 4; ++kp) { float p[8];
#pragma unroll
        for (int h2 = 0; h2 < 2; ++h2) { const int n = 2 * kp + h2; const f32x4 g4 = *(LAS const f32x4*)(vec + 16 * n + 4 * fq);
#pragma unroll
            for (int j = 0; j < 4; ++j) { const int s = 16 * n + 4 * fq + j; const bool ok = DIR == 0 ? (s <= trow) : (s >= trow);
                p[4 * h2 + j] = ok ? S[n][j] * __builtin_amdgcn_exp2f(g4[j] - Mt) : 0.f; } }
        Xp[kp] = pack8(p); }
#pragma unroll
    for (int nt = 0; nt < 8; ++nt)
#pragma unroll
        for (int kp = 0; kp < 4; ++kp) { LAS const unsigned char* vp = LVTb + (16 * nt + fr) * 272 + (32 * kp + 4 * fq) * 2;
            const s16x4 lo = *(LAS const s16x4*)vp, hi = *(LAS const s16x4*)(vp + 32);
            const bf16x8 Y = (bf16x8){lo[0], lo[1], lo[2], lo[3], hi[0], hi[1], hi[2], hi[3]};
            acc[nt] = MFMA16(Y, Xp[kp], acc[nt]); if (kp == 3) asm volatile("" ::: "memory"); }
    { const short o = fr == 0 ? (short)0x3F80 : (short)0; const bf16x8 ones = (bf16x8){o, o, o, o, o, o, o, o};
#pragma unroll
        for (int kp = 0; kp < 4; ++kp) acc[8] = MFMA16(ones, Xp[kp], acc[8]); }
    const float den = __shfl(acc[8][0], fr);
    const float inv = 1.f / fmaxf(fabsf(den), ex);
#pragma unroll
    for (int nt = 0; nt < 8; ++nt) { if (DIR == 0) hs[nt] = acc[nt] * inv; else hs[nt] += acc[nt] * inv; }
}
DI void mlstm_out_unit(LAS unsigned char* lds, const Ctx& c, int chunk, int head, int tid, int lane, int wid) {
    asm volatile("" : "+v"(tid), "+v"(lane));
    const int t0 = chunk * 128, fr = lane & 15, fq = lane >> 4;
    LAS unsigned char* LQ = lds; LAS unsigned char* LK = lds + 34816; LAS unsigned char* LVTb = lds + 73984; LAS unsigned char* LSB = lds + 108800; LAS float* vec = (LAS float*)(lds + 147968);
    LAS bf16_t* LVT = (LAS bf16_t*)LVTb;
    const bf16_t* MQ = (const bf16_t*)(c.ws + WS_MQ); const bf16_t* MK = (const bf16_t*)(c.ws + WS_MK); const bf16_t* MV = (const bf16_t*)(c.ws + WS_MV); bf16_t* MO = (bf16_t*)(c.ws + WS_MO);
    const bf16_t* CSTF = (const bf16_t*)c.out + ((size_t)(0 * NCHUNK + chunk) * 4 + head) * ST_ELEMS; const bf16_t* CSTB = (const bf16_t*)c.out + ((size_t)(1 * NCHUNK + chunk) * 4 + head) * ST_ELEMS;
    u32x4 qr[4], kr[4], vr[4], sbr[5], sfr[5];
#pragma unroll
    for (int i = 0; i < 4; ++i) { const int idx = tid + 512 * i, r = idx >> 4, ch = idx & 15; const size_t go = (size_t)(t0 + r) * 512 + head * 128 + ch * 8; qr[i] = *(const u32x4*)(MQ + go); kr[i] = *(const u32x4*)(MK + go); }
#pragma unroll
    for (int i = 0; i < 4; ++i) { const int idx = tid + 512 * i, s = idx & 127, ch = idx >> 7; vr[i] = *(const u32x4*)(MV + (size_t)(t0 + s) * 512 + head * 128 + ch * 8); }
#pragma unroll
    for (int i = 0; i < 5; ++i) { int idx = tid + 512 * i; idx = idx < 2304 ? idx : 2303; const int r = idx >> 4, ch = idx & 15, rc = r < 129 ? r : 128;
        sbr[i] = *(const u32x4*)(CSTB + rc * 128 + ch * 8); sfr[i] = *(const u32x4*)(CSTF + rc * 128 + ch * 8); }
#pragma unroll
    for (int i = 0; i < 4; ++i) { const int idx = tid + 512 * i, r = idx >> 4, ch = idx & 15; *(LAS u32x4*)(LQ + r * 272 + ch * 16) = qr[i]; *(LAS u32x4*)(LK + r * 272 + ch * 16) = kr[i]; }
#pragma unroll
    for (int i = 0; i < 4; ++i) { const int idx = tid + 512 * i, s = idx & 127, ch = idx >> 7; const u32x4 v8 = vr[i];
#pragma unroll
        for (int e = 0; e < 8; ++e) { const unsigned vw = v8[e >> 1]; LVT[(8 * ch + e) * 136 + s] = (bf16_t)((e & 1) ? (vw >> 16) : (vw & 0xffffu)); } }
#pragma unroll
    for (int i = 0; i < 5; ++i) { int idx = tid + 512 * i; idx = idx < 2304 ? idx : 2303; const int r = idx >> 4, ch = idx & 15;
        *(LAS u32x4*)(LSB + r * 272 + ch * 16) = r < 129 ? sbr[i] : (u32x4){0u, 0u, 0u, 0u}; }
    if (wid < 2) { const int d = wid; const ChunkVec v = chunk_vectors(d, (const float*)(c.ws + WS_GATES), t0, head, lane);
        const float mp = ((const float*)(c.ws + WS_MPREV))[(size_t)(d * NCHUNK + chunk) * 4 + head];
        LAS float* vd = vec + d * 512; const float M0 = fmaxf(mp, v.cm0), M1 = fmaxf(mp, v.cm1);
        constexpr float L2E = 1.4426950408889634f;
        vd[v.s0] = v.g0 * L2E; vd[128 + v.s0] = M0 * L2E; vd[256 + v.s0] = __expf(-(v.b0 + M0)); vd[384 + v.s0] = __expf(mp - M0);
        vd[v.s1] = v.g1 * L2E; vd[128 + v.s1] = M1 * L2E; vd[256 + v.s1] = __expf(-(v.b1 + M1)); vd[384 + v.s1] = __expf(mp - M1); }
    __syncthreads();
    const int trow = 16 * wid + fr;
    bf16x8 Xq[4];
#pragma unroll
    for (int ks = 0; ks < 4; ++ks) Xq[ks] = *(LAS const bf16x8*)(LQ + trow * 272 + (32 * ks + 8 * fq) * 2);
    f32x4 S[8];
#pragma unroll
    for (int n = 0; n < 8; ++n) { S[n] = (f32x4){0.f, 0.f, 0.f, 0.f};
#pragma unroll
        for (int ks = 0; ks < 4; ++ks) { const bf16x8 Yk = *(LAS const bf16x8*)(LK + (16 * n + fr) * 272 + (32 * ks + 8 * fq) * 2); S[n] = MFMA16(Yk, Xq[ks], S[n]); } }
    __syncthreads();
#pragma unroll
    for (int i = 0; i < 5; ++i) { int idx = tid + 512 * i; idx = idx < 2304 ? idx : 2303; const int r = idx >> 4, ch = idx & 15;
        *(LAS u32x4*)(LK + r * 272 + ch * 16) = r < 129 ? sfr[i] : (u32x4){0u, 0u, 0u, 0u}; }
    __syncthreads();
    f32x4 hs[8];
    dir_pass<0>(S, Xq, LK, LVTb, vec, trow, fr, fq, hs);
    dir_pass<1>(S, Xq, LSB, LVTb, vec + 512, trow, fr, fq, hs);
    float sum = 0.f;
#pragma unroll
    for (int nt = 0; nt < 8; ++nt) sum += (hs[nt][0] + hs[nt][1]) + (hs[nt][2] + hs[nt][3]);
    sum += __shfl_xor(sum, 16); sum += __shfl_xor(sum, 32);
    const float mean = sum * (1.f / 128.f); float var = 0.f;
#pragma unroll
    for (int nt = 0; nt < 8; ++nt) { hs[nt] -= mean; var += (hs[nt][0] * hs[nt][0] + hs[nt][1] * hs[nt][1]) + (hs[nt][2] * hs[nt][2] + hs[nt][3] * hs[nt][3]); }
    var += __shfl_xor(var, 16); var += __shfl_xor(var, 32);
    const float rstd = __builtin_amdgcn_rsqf(var * (1.f / 128.f) + EPS);
    const float* nw = c.in[6] + head * 128; bf16_t* mop = MO + (size_t)(t0 + trow) * 512 + head * 128;
#pragma unroll
    for (int nt = 0; nt < 8; ++nt) { const int v = 16 * nt + 4 * fq; const u32x2 mo4 = *(const u32x2*)(mop + v); const f32x4 w4 = *(const f32x4*)(nw + v);
        const float o0 = hs[nt][0] * rstd * w4[0] * sigmoidf_(bflo(mo4.x)), o1 = hs[nt][1] * rstd * w4[1] * sigmoidf_(bfhi(mo4.x));
        const float o2 = hs[nt][2] * rstd * w4[2] * sigmoidf_(bflo(mo4.y)), o3 = hs[nt][3] * rstd * w4[3] * sigmoidf_(bfhi(mo4.y));
        u32x2 w; w.x = pk2(o0, o1); w.y = pk2(o2, o3); *(u32x2*)((bf16_t*)(c.ws + WS_HMOA) + (size_t)(t0 + trow) * 1024 + head * 128 + v) = w; }
    __syncthreads();
}

struct Args { const float* in[17]; float* out; unsigned char* ws; int ph_lo, ph_hi; };
constexpr int NPHASE = 9;

__global__ void __launch_bounds__(512, 2) mega(Args args) {
    extern __shared__ __attribute__((aligned(16))) unsigned char lds_raw[];
    LAS unsigned char* lds = (LAS unsigned char*)lds_raw;
    cg::grid_group grid = cg::this_grid();
    const int tid = threadIdx.x, lane = tid & 63, wid = __builtin_amdgcn_readfirstlane(tid >> 6);
    const int G = gridDim.x, gw = blockIdx.x * 8 + wid, NGW = G * 8;
    Ctx c;
#pragma unroll
    for (int i = 0; i < 17; ++i) c.in[i] = args.in[i];
    c.out = args.out; c.ws = args.ws;
    unsigned char* ws = args.ws;
    const int lo = args.ph_lo, hi = args.ph_hi;
#ifndef PH_MASK
#define PH_MASK 0x3ff
#endif
#define IN(k) (((PH_MASK >> (k)) & 1) && lo <= (k) && (k) < hi)
#define REP(k) for (int rep_ = 0; rep_ < (((DUP_MASK >> (k)) & 1) ? 2 : 1); ++rep_)
#define SEAM(k) do { if (IN(k) && IN((k) + 1)) grid.sync(); } while (0)

    REP(0) if (IN(0)) {
        LAS float* scr = (LAS float*)(lds + wid * 16384);
        for (int i = blockIdx.x * 512 + tid; i < 320 * 64; i += G * 512) ((unsigned*)(ws + WS_CTL))[i] = 0u;
        constexpr int I_W1 = 160 * 16, I_PM = 32 * 8, I_PA = 32 * 8, I_WO = 32 * 16, I_UP = 176 * 16, I_WD = 32 * 44;
        constexpr int NITEMS = I_W1 + I_PM + I_PA + I_WO + I_UP + I_WD;
        for (int it = gw; it < NITEMS; it += NGW) {
            int r = it;
            if (r < I_W1) { const int nb = r >> 4, kb = r & 15, dr = 32 * nb, sc = dr < 2048 ? dr : dr + 16;
                const float ns = (dr >= 512 && dr < 1024) ? 0.08838834764831845f : ((dr >= 2048 && dr < 2560) ? 0.18033688011112042f   : 1.f);
                transpose_item(c.in[3], DIN, sc, 64 * kb, (bf16_t*)(ws + WS_W1), 1024, dr, c.in[2], ns, scr, lane); continue; } r -= I_W1;
            if (r < I_PM) { const int nb = r >> 3, kb = r & 7; transpose_item(c.in[8], 1024, 32 * nb, 64 * kb, (bf16_t*)(ws + WS_W1) + (size_t)5120 * 1024, 1024, 32 * nb, nullptr, 1.f, scr, lane); continue; } r -= I_PM;
            if (r < I_PA) { const int nb = r >> 3, kb = r & 7; transpose_item(c.in[9], 1024, 32 * nb, 64 * kb, (bf16_t*)(ws + WS_W1) + (size_t)5120 * 1024 + 512, 1024, 32 * nb, nullptr, 1.f, scr, lane); continue; } r -= I_PA;
            if (r < I_WO) { const int nb = r >> 4, kb = r & 15; transpose_item(c.in[10], 1024, 32 * nb, 64 * kb, (bf16_t*)(ws + WS_WO), 1024, 32 * nb, nullptr, 1.f, scr, lane); continue; } r -= I_WO;
            if (r < I_UP) { const int nb = r >> 4, kb = r & 15, sc = 32 * nb; const int half = sc >= DFF ? 1 : 0, ch = sc - half * DFF; const int dr = 256 * (ch >> 7) + 128 * half + (ch & 127);
                transpose_item(c.in[12], NUP, sc, 64 * kb, (bf16_t*)(ws + WS_WUP), 1024, dr, c.in[11], 1.f, scr, lane); continue; } r -= I_UP;
            { const int nb = r / 44, kb = r - nb * 44; transpose_item(c.in[15], 1024, 32 * nb, 64 * kb, (bf16_t*)(ws + WS_WD), DFF, 32 * nb, nullptr, 1.f, scr, lane); }
        }
        {
            float* rope = (float*)(ws + WS_ROPE);
            for (int i = blockIdx.x * 512 + tid; i < 16384 * 8; i += G * 512) { const int pos = i >> 3, d = i & 7;
                const float invf = d == 0 ? 1.0f : d == 1 ? 0.1939227432012558f : d == 2 ? 0.03760603070259094f : d == 3 ? 0.007292664609849453f : d == 4 ? 0.0014142135623842478f
                                 : d == 5 ? 0.00027424818836152554f : d == 6 ? 5.3182957344688475e-05f : 1.0313385246263351e-05f;
                const float ang = (float)pos * invf; const float k = rintf(ang * 0.15915494309189535f);
                float rr = fmaf(-k, 6.2831854820251465f, ang); rr = fmaf(-k, -1.7484556025237907e-07f, rr);
                rope[pos * 16 + d] = cosf(rr); rope[pos * 16 + 8 + d] = sinf(rr); }
        }
        __syncthreads();
        LAS float* wg = (LAS float*)lds;
        for (int i = tid; i < 16384; i += 512) { const int k = i >> 4, j = i & 15; wg[j * 1024 + k] = c.in[2][k] * c.in[3][(size_t)k * DIN + 2048 + j]; }
        __syncthreads();
        bf16_t* XN = (bf16_t*)(ws + WS_XN); float* gates = (float*)(ws + WS_GATES);
        const float bias = (lane >> 2) < 8 ? c.in[4][lane >> 2] : c.in[5][(lane >> 2) - 8];
        f32x4 va[4], vb[4];
        { const int r0 = gw * 2 < MTOK ? gw * 2 : 0; const f32x4* xa = (const f32x4*)xrow_ptr(c.in[0], c.in[1], r0) + lane; const f32x4* xb = (const f32x4*)xrow_ptr(c.in[0], c.in[1], r0 + 1) + lane;
#pragma unroll
          for (int j = 0; j < 4; ++j) { va[j] = xa[64 * j]; vb[j] = xb[64 * j]; } }
        for (int r0 = gw * 2; r0 < MTOK; r0 += NGW * 2) {
            f32x4 na[4], nb[4];
            { const int rn = r0 + NGW * 2 < MTOK ? r0 + NGW * 2 : r0; const f32x4* xa = (const f32x4*)xrow_ptr(c.in[0], c.in[1], rn) + lane; const f32x4* xb = (const f32x4*)xrow_ptr(c.in[0], c.in[1], rn + 1) + lane;
#pragma unroll
              for (int j = 0; j < 4; ++j) { na[j] = xa[64 * j]; nb[j] = xb[64 * j]; } }
            float sa = 0.f, sb = 0.f;
#pragma unroll
            for (int j = 0; j < 4; ++j) {
                sa += (va[j][0] * va[j][0] + va[j][1] * va[j][1]) + (va[j][2] * va[j][2] + va[j][3] * va[j][3]); sb += (vb[j][0] * vb[j][0] + vb[j][1] * vb[j][1]) + (vb[j][2] * vb[j][2] + vb[j][3] * vb[j][3]); }
            const float rsa = 1.f / sqrtf(wave_sum(sa) * (1.f / DM) + EPS), rsb = 1.f / sqrtf(wave_sum(sb) * (1.f / DM) + EPS);
            float pa[16], pb[16];
#pragma unroll
            for (int g = 0; g < 16; ++g) { float qa = 0.f, qb = 0.f;
#pragma unroll
                for (int j = 0; j < 4; ++j) { const f32x4 w = *(LAS const f32x4*)(wg + g * 1024 + 256 * j + 4 * lane);
                    qa += (va[j][0] * w[0] + va[j][1] * w[1]) + (va[j][2] * w[2] + va[j][3] * w[3]); qb += (vb[j][0] * w[0] + vb[j][1] * w[1]) + (vb[j][2] * w[2] + vb[j][3] * w[3]); }
                pa[g] = qa; pb[g] = qb; asm volatile("" ::: "memory"); }
            const float ga_ = reduce16(pa, lane), gb_ = reduce16(pb, lane);
            if ((lane & 3) == 0) { gates[(size_t)r0 * 16 + (lane >> 2)] = rsa * ga_ + bias; gates[(size_t)(r0 + 1) * 16 + (lane >> 2)] = rsb * gb_ + bias; }
            unsigned long long* oa = (unsigned long long*)(XN + (size_t)r0 * DM) + lane; unsigned long long* ob = (unsigned long long*)(XN + (size_t)(r0 + 1) * DM) + lane;
#pragma unroll
            for (int j = 0; j < 4; ++j) {
                oa[64 * j] = (unsigned long long)pk2(va[j][0] * rsa, va[j][1] * rsa) | ((unsigned long long)pk2(va[j][2] * rsa, va[j][3] * rsa) << 32);
                ob[64 * j] = (unsigned long long)pk2(vb[j][0] * rsb, vb[j][1] * rsb) | ((unsigned long long)pk2(vb[j][2] * rsb, vb[j][3] * rsb) << 32); }
#pragma unroll
            for (int j = 0; j < 4; ++j) { va[j] = na[j]; vb[j] = nb[j]; }
        }
        __syncthreads();
    }
    SEAM(0);

    if (IN(1)) {
        pg8::Gemm g{(const bf16_t*)(ws + WS_XN), (const bf16_t*)(ws + WS_W1), nullptr, nullptr, 1024};
        pg8::DupOrder S; S.s.init(MTOK / 256, 12, G, (int)blockIdx.x); S.dup = (DUP_MASK >> 1) & 1;
        pg8::EpiProj E{ws};
        pg8::gemm_phase<pg8::EpiProj, pg8::DupOrder, true, false>(lds, g, S, E);
    }
    SEAM(1);

    if (IN(2)) {
        constexpr int NSU = NCHUNK * 4, NAU = (NCHUNK / 2) * 4;
        for (int it0 = blockIdx.x; it0 < (((DUP_MASK >> 2) & 1) ? 2 : 1) * (NSU + NAU); it0 += G) { const int it = it0 >= NSU + NAU ? it0 - (NSU + NAU) : it0;
            if (it < NSU) summary_unit(lds, c, it >> 2, it & 3, tid, lane, wid);
            else { const int a = it - NSU; attn_unit(lds, c, a >> 2, a & 3, tid, lane, wid); }
        }
    }
    SEAM(2);

    REP(3) if (IN(3)) {
        constexpr int NPI = 8 * 33, NSI = 128 * 33;
        if (NGW > 2 * NPI) {
            if (gw < NPI) scan_item(c, gw / 33, gw % 33, lane);
            else { const int stride = NGW - NPI; for (int j = gw - NPI; j < NSI; j += stride) scan_item(c, 8 + j / 33, j % 33, lane); }
        } else {
            for (int j = gw; j < NPI + NSI; j += NGW) scan_item(c, j / 33, j % 33, lane);
        }
    }
    SEAM(3);

    REP(4) if (IN(4)) {
        for (int it = blockIdx.x; it < NCHUNK * 4; it += G) mlstm_out_unit(lds, c, it >> 2, it & 3, tid, lane, wid);
    }
    SEAM(4);

    if (IN(5)) {
        const bf16_t* W1t = (const bf16_t*)(ws + WS_W1);
        pg8::Gemm gg{(const bf16_t*)(ws + WS_XN), W1t + (size_t)3072 * 1024, (const bf16_t*)(ws + WS_XN), W1t + (size_t)4096 * 1024, 1024, 0};
        pg8::Gemm gx{(const bf16_t*)(ws + WS_HMOA), W1t + (size_t)5120 * 1024, (const bf16_t*)(ws + WS_HMOA) + 512, W1t + (size_t)5120 * 1024 + 512, 1024, 8};
        pg8::StaticOrder SO; SO.init(MTOK / 256, DM / 256, G, (int)blockIdx.x);
        pg8::EpiGate EG{ws + WS_QSCR}; pg8::EpiMix EM{(bf16_t*)(ws + WS_Y), ws + WS_QSCR};
        pg8::Unit tu;
        for (int k = 0; SO.next(k, tu); ++k) {
            pg8::TileOrder T{tu.pm, tu.pn};
            pg8::gemm_phase<pg8::EpiGate, pg8::TileOrder, true, false>(lds, gg, T, EG);
            pg8::gemm_phase<pg8::EpiMix, pg8::TileOrder, true, false>(lds, gx, T, EM);
        }
    }
    SEAM(5);

    if (IN(6)) {
        pg8::Gemm g{(const bf16_t*)(ws + WS_Y), (const bf16_t*)(ws + WS_WO), nullptr, nullptr, 1024};
        pg8::DupOrder S; S.s.init(MTOK / 256, DM / 256, G, (int)blockIdx.x); S.dup = (DUP_MASK >> 6) & 1;
        pg8::EpiRes<true> E{c.in[0], c.in[1], c.out, (bf16_t*)(ws + WS_HN), (float*)(ws + WS_SS)};
        pg8::gemm_phase<pg8::EpiRes<true>, pg8::DupOrder, true, false>(lds, g, S, E);
    }
    SEAM(6);

    if (IN(7)) {
        pg8::Gemm g{(const bf16_t*)(ws + WS_HN), (const bf16_t*)(ws + WS_WUP), nullptr, nullptr, 1024};
        pg8::DupOrder S; S.s.init(323, NUP / 256, G, (int)blockIdx.x); S.dup = (DUP_MASK >> 7) & 1;
        pg8::EpiConv E{(bf16_t*)(ws + WS_G), (const float*)(ws + WS_SS), c.in[13], c.in[14], (LAS float*)(lds + 131072)};
        pg8::gemm_phase<pg8::EpiConv, pg8::DupOrder, true, true>(lds, g, S, E);
    }
    SEAM(7);

    if (IN(8)) {
        pg8::Gemm g{(const bf16_t*)(ws + WS_G), (const bf16_t*)(ws + WS_WD), nullptr, nullptr, DFF};
        pg8::StaticOrder S; S.init(MTOK / 256, DM / 256, G, (int)blockIdx.x);
        pg8::EpiFinal E{c.out, (const bf16_t*)(ws + WS_HN), c.in[16], (unsigned*)(ws + WS_SS), (unsigned*)(ws + WS_CTL)};
        pg8::gemm_phase<pg8::EpiFinal, pg8::StaticOrder, true, false>(lds, g, S, E);
    }
#undef IN
#undef SEAM
}

extern "C" void kernel_launch(void* const* d_in, const int* in_sizes, int n_in, void* d_out, int out_size, void* d_ws, size_t ws_size, hipStream_t stream) {
    static int grid = 0;
    if (grid == 0) {
        if (n_in != 17 || out_size != MTOK * DM || ws_size < WS_END2) { fprintf(stderr, "kernel_launch: unexpected problem (n_in %d out %d ws %zu)\n", n_in, out_size, ws_size); grid = -1; return; }
        int dev = 0, cus = 0, per_cu = 0;
        if (hipGetDevice(&dev) != hipSuccess || hipDeviceGetAttribute(&cus, hipDeviceAttributeMultiprocessorCount, dev) != hipSuccess) { grid = -1; return; }
        if (hipFuncSetAttribute((const void*)mega, hipFuncAttributeMaxDynamicSharedMemorySize, LDS_BYTES) != hipSuccess) { fprintf(stderr, "kernel_launch: hipFuncSetAttribute failed\n"); grid = -1; return; }
        if (hipOccupancyMaxActiveBlocksPerMultiprocessor(&per_cu, (const void*)mega, 512, LDS_BYTES) != hipSuccess || per_cu < 1) { fprintf(stderr, "kernel_launch: occupancy query says %d\n", per_cu); per_cu = 1; }
        (void)hipGetLastError();
        grid = cus * per_cu;
    }
    if (grid < 0) return;
    Args a{};
    for (int i = 0; i < 17; ++i) a.in[i] = (const float*)d_in[i];
    a.out = (float*)d_out; a.ws = (unsigned char*)d_ws;
#if MK_SINGLE
    a.ph_lo = 0; a.ph_hi = NPHASE;
    void* kargs[] = {&a};
    hipError_t e = hipLaunchCooperativeKernel((const void*)mega, dim3(grid), dim3(512), kargs, LDS_BYTES, stream);
    if (e != hipSuccess) fprintf(stderr, "cooperative launch failed: %s (grid %d)\n", hipGetErrorString(e), grid);
#else
    for (int p = 0; p < NPHASE; ++p) { a.ph_lo = p; a.ph_hi = p + 1; hipLaunchKernelGGL(mega, dim3(grid), dim3(512), LDS_BYTES, stream, a); }
#endif
}
```

```cpp
#include <hip/hip_runtime.h>
#include <hip/hip_cooperative_groups.h>
#include <cstdio>
#include <cstdint>
namespace cg = cooperative_groups;

#ifndef DUP_MASK
#define DUP_MASK 0
#endif
#ifndef MK_SINGLE
#define MK_SINGLE 1
#endif

#define LAS __attribute__((address_space(3)))
#define DI __device__ __forceinline__
typedef unsigned short bf16_t;
typedef short bf16x8 __attribute__((ext_vector_type(8)));
typedef short s16x4 __attribute__((ext_vector_type(4)));
typedef float f32x4 __attribute__((ext_vector_type(4)));
typedef unsigned u32x4 __attribute__((ext_vector_type(4)));
typedef unsigned u32x2 __attribute__((ext_vector_type(2)));

constexpr int MTOK = 81920, DM = 1024, NPROJ = 5120, DIN = 5136, DFF = 2816, NUP = 5632;
constexpr int NCHUNK = 640, PROMPT = 16384;
constexpr float EPS = 1e-6f;
constexpr int ST_ELEMS = 129 * 128;
constexpr size_t ST_BYTES = (size_t)ST_ELEMS * 2;

constexpr size_t MiB = 1u << 20;
constexpr size_t WS_CTL = 0;
constexpr size_t WS_W1 = 2 * MiB, WS_WPM = 13 * MiB, WS_WPA = 14 * MiB, WS_WO = 15 * MiB, WS_WUP = 17 * MiB, WS_WD = 28 * MiB;
constexpr size_t WS_ROPE = 34 * MiB, WS_GATES = 35 * MiB, WS_SS = 40 * MiB, WS_CHSC = 46 * MiB, WS_MPREV = 47 * MiB;
constexpr size_t WS_MQ = 64 * MiB, WS_MK = 144 * MiB, WS_MV = 224 * MiB, WS_MO = 304 * MiB, WS_AQ = 384 * MiB, WS_AK = 464 * MiB, WS_AV = 504 * MiB,
                 WS_GM = 544 * MiB, WS_GA = 704 * MiB, WS_END = 864 * MiB;
constexpr size_t WS_Y = 64 * MiB, WS_HN = 224 * MiB, WS_G = 384 * MiB;
constexpr size_t WS_OA = 864 * MiB, WS_HM = 944 * MiB, WS_END2 = 1024 * MiB;
constexpr size_t OUT_CST = 0;
constexpr size_t WS_XN = WS_GM, WS_QSCR = WS_GA;
constexpr size_t WS_HMOA = 864 * MiB;
constexpr int LDS_BYTES = 152064;

typedef __bf16 bf16n2 __attribute__((ext_vector_type(2)));
typedef float f32n2 __attribute__((ext_vector_type(2)));
DI unsigned pk2(float lo, float hi) { const f32n2 v = {lo, hi}; return __builtin_bit_cast(unsigned, __builtin_convertvector(v, bf16n2)); }
DI unsigned f2bf(float f) { return pk2(f, f) & 0xffffu; }
DI float bflo(unsigned w) { return __uint_as_float(w << 16); }
DI float bfhi(unsigned w) { return __uint_as_float(w & 0xffff0000u); }
DI unsigned cvt_pk_bf16_asm(float lo, float hi) { unsigned r; asm volatile("v_cvt_pk_bf16_f32 %0, %1, %2" : "=v"(r) : "v"(lo), "v"(hi)); return r; }
DI unsigned cvt_pk_bf16(float lo, float hi) { return pk2(lo, hi); }
DI float wave_sum(float v) {
#pragma unroll
    for (int o = 1; o < 64; o <<= 1) v += __shfl_xor(v, o);
    return v;
}
DI float sigmoidf_(float x) { return __builtin_amdgcn_rcpf(1.f + __expf(-x)); }
DI float logsigmoid_(float x) { return x >= 0.f ? -log1pf(expf(-x)) : x - log1pf(expf(x)); }
#define MFMA16(a, b, c) __builtin_amdgcn_mfma_f32_16x16x32_bf16((a), (b), (c), 0, 0, 0)
DI bf16x8 pack8(const float (&p)[8]) {
    u32x4 w; w.x = pk2(p[0], p[1]); w.y = pk2(p[2], p[3]); w.z = pk2(p[4], p[5]); w.w = pk2(p[6], p[7]);
    return __builtin_bit_cast(bf16x8, w);
}
DI const float* xrow_ptr(const float* xp, const float* xs, int t) { return t < PROMPT ? xp + (size_t)t * DM : xs + (size_t)(t - PROMPT) * DM; }
DI bool seq_start(int t) { return t == 0 || (t >= PROMPT && (t & 4095) == 0); }

namespace pg8 {
constexpr int BM = 256, BK = 64, HALF = 128, HTB = HALF * BK * 2, STAGE_BYTES = 8 * HTB, NXCD = 8, WGM = 8;
DI int lds_byte(int r, int c) { const int st = (r >> 4) * 2 + (c >> 5), rr = r & 15, cc = c & 31, ob = rr * 64 + cc * 2; return st * 1024 + (ob ^ (((ob >> 9) & 1) << 5)); }
DI void stage_rc(int b, int& R, int& C) { const int st = b / 1024, sb = b % 1024, swz = sb ^ (((sb >> 9) & 1) << 5); R = (st >> 1) * 16 + swz / 64; C = (st & 1) * 32 + (swz % 64) / 2; }
DI int perm32(int rho) { const int n = rho >> 4, i = rho & 15; return 8 * (i >> 2) + 4 * n + (i & 3); }

struct Unit { int pm, pn, sel; };
struct Gemm { const bf16_t* A; const bf16_t* Bt; const bf16_t* A2; const bf16_t* Bt2; int K; int ntk = 0; };

struct StaticOrder {
    int nM, nN, nwg, G, c;
    DI void init(int nM_, int nN_, int G_, int c_) { nM = nM_; nN = nN_; nwg = nM * nN; G = G_; c = c_; }
    DI bool next(int i, Unit& u) const {
        const long L = (long)i * G + c; if (L >= nwg) return false;
        int wgid = (int)L; { const int q = nwg / NXCD, r = nwg % NXCD, xcd = wgid % NXCD, off = wgid / NXCD; wgid = (xcd < r ? xcd * (q + 1) : r * (q + 1) + (xcd - r) * q) + off; }
        const int nig = WGM * nN, gid = wgid / nig, fm = gid * WGM, gsz = (nM - fm) < WGM ? (nM - fm) : WGM;
        u.pm = fm + ((wgid % nig) % gsz); u.pn = (wgid % nig) / gsz; u.sel = 0; return true;
    }
};
struct DupOrder { StaticOrder s; int dup; DI bool next(int i, Unit& u) const { return s.next(dup ? (i >> 1) : i, u); } };
struct TileOrder { int pm, pn; DI bool next(int i, Unit& u) const { if (i >= 2) return false; u.pm = pm; u.pn = pn; u.sel = i; return true; } };
struct PairOrder {
    StaticOrder s;
    DI bool next(int i, Unit& u) const { if (!s.next(i >> 1, u)) return false; u.sel = i & 1; return true; }
};

template <class Epi, class Sched, bool ALIGN_EPI, bool CONVA>
DI void gemm_phase(LAS unsigned char* lds, const Gemm g, const Sched& S, const Epi& E) {
    const int tid = threadIdx.x, wid = __builtin_amdgcn_readfirstlane(tid >> 6), lane = tid & 63, wr = wid >> 2, wc = wid & 3, fr = lane & 15, fq = lane >> 4;
    const int K = g.K; const int nt = g.ntk ? g.ntk : K / BK;
    unsigned voffA[2], voffB[2];
#pragma unroll
    for (int i = 0; i < 2; ++i) { int R, C; stage_rc(tid * 16 + i * 8192, R, C); const int Rb = Epi::PERM ? ((R & ~31) + perm32(R & 31)) : R;
        const int Ra = CONVA ? (128 * (R >> 6) + 8 * (R & 15) + ((R >> 4) & 3)) : R;
        voffA[i] = (unsigned)(Ra * K + C) * 2u; voffB[i] = (unsigned)(Rb * K + C) * 2u; }
    const size_t kstep = (size_t)(BK * 2);
    const size_t hstepB = (size_t)HALF * K * 2, tstepB = 2 * hstepB;
    const size_t hstepA = CONVA ? (size_t)4 * K * 2 : hstepB, tstepA = CONVA ? (size_t)254 * K * 2 : tstepB;
    const long abias = CONVA ? -(long)K * 2 : 0;
    const unsigned ldsw = (unsigned)wid * 1024u;
    const int aoff = lds_byte(wr * 64 + fr, fq * 8), boff = lds_byte(wc * 32 + fr, fq * 8);
#define PG8_SA(b, h) (((b) * 2 + (h)) * HTB)
#define PG8_SB(b, h) ((4 + (b) * 2 + (h)) * HTB)
#define PG8_STAGE(bufoff, gbase, voff) do { _Pragma("unroll") for (int _i = 0; _i < 2; ++_i) \
        __builtin_amdgcn_global_load_lds((const unsigned*)((const char*)(gbase) + (voff)[_i]), (LAS unsigned*)(lds + (bufoff) + ldsw + _i * 8192), 16, 0, 0); } while (0)
#define PG8_LDA(dst, b, h) do { _Pragma("unroll") for (int m = 0; m < 4; ++m) _Pragma("unroll") for (int k = 0; k < 2; ++k) dst[m][k] = *(const LAS bf16x8*)(lds + PG8_SA(b, h) + aoff + m * 2048 + k * 1024); } while (0)
#define PG8_LDB(dst, b, h) do { _Pragma("unroll") for (int n = 0; n < 2; ++n) _Pragma("unroll") for (int k = 0; k < 2; ++k) dst[n][k] = *(const LAS bf16x8*)(lds + PG8_SB(b, h) + boff + n * 2048 + k * 1024); } while (0)
#define PG8_MMA(ai, bj, At, Bt) do { __builtin_amdgcn_s_setprio(1); _Pragma("unroll") for (int m = 0; m < 4; ++m) _Pragma("unroll") for (int n = 0; n < 2; ++n) _Pragma("unroll") for (int k = 0; k < 2; ++k) \
        acc[ai][bj][m][n] = __builtin_amdgcn_mfma_f32_16x16x32_bf16(Bt[n][k], At[m][k], acc[ai][bj][m][n], 0, 0, 0); __builtin_amdgcn_s_setprio(0); } while (0)
#define PG8_WAIT_V(n) asm volatile("s_waitcnt vmcnt(" #n ")" ::: "memory")
#define PG8_WAIT_L(n) asm volatile("s_waitcnt lgkmcnt(" #n ")" ::: "memory")
#define PG8_WAIT_VN(n) asm volatile("s_waitcnt vmcnt(%0)" :: "n"(n) : "memory")
#define PG8_BAR __builtin_amdgcn_s_barrier()
#define PG8_SCHED __builtin_amdgcn_sched_barrier(0)
    Unit cur, nxt; int ui = 0;
    if (!S.next(0, cur)) return;
    f32x4 acc[2][2][4][2];
#pragma unroll
    for (int a = 0; a < 2; ++a)
#pragma unroll
        for (int b = 0; b < 2; ++b)
#pragma unroll
            for (int m = 0; m < 4; ++m)
#pragma unroll
                for (int n = 0; n < 2; ++n) acc[a][b][m][n] = (f32x4){0.f, 0.f, 0.f, 0.f};
    bf16x8 At[4][2], B0[2][2], B1[2][2];
    const char* cA = (const char*)(cur.sel ? g.A2 : g.A) + (size_t)cur.pm * tstepA + abias; const char* cB = (const char*)(cur.sel ? g.Bt2 : g.Bt) + (size_t)cur.pn * tstepB;
    PG8_STAGE(PG8_SB(0, 0), cB, voffB); PG8_STAGE(PG8_SB(0, 1), cB + hstepB, voffB); PG8_STAGE(PG8_SA(0, 0), cA, voffA); PG8_STAGE(PG8_SA(0, 1), cA + hstepA, voffA);
    if (wr == 1) PG8_BAR;
    PG8_WAIT_V(2); PG8_BAR;
    PG8_STAGE(PG8_SB(1, 0), cB + kstep, voffB); PG8_STAGE(PG8_SA(1, 0), cA + kstep, voffA); PG8_STAGE(PG8_SB(1, 1), cB + hstepB + kstep, voffB);
    PG8_WAIT_V(6); PG8_BAR;
    for (;;) {
        const bool has_next = S.next(ui + 1, nxt);
        const char* nA = has_next ? (const char*)(nxt.sel ? g.A2 : g.A) + (size_t)nxt.pm * tstepA + abias : cA;
        const char* nB = has_next ? (const char*)(nxt.sel ? g.Bt2 : g.Bt) + (size_t)nxt.pn * tstepB : cB;
#define PG8_KBODY(W12) do { \
            PG8_LDB(B0, 0, 0); PG8_LDB(B1, 0, 1); PG8_SCHED; PG8_LDA(At, 0, 0); PG8_STAGE(PG8_SA(1, 1), a1 + hstepA, voffA); \
            W12; PG8_WAIT_L(0); PG8_BAR; PG8_MMA(0, 0, At, B0); PG8_MMA(0, 1, At, B1); PG8_BAR; PG8_SCHED; \
            PG8_LDA(At, 0, 1); PG8_STAGE(PG8_SB(0, 0), b2, voffB); PG8_STAGE(PG8_SB(0, 1), b2 + hstepB, voffB); PG8_STAGE(PG8_SA(0, 0), a2, voffA); \
            W12; PG8_WAIT_L(0); PG8_BAR; PG8_MMA(1, 0, At, B0); PG8_MMA(1, 1, At, B1); PG8_BAR; PG8_SCHED; \
            PG8_LDB(B0, 1, 0); PG8_LDB(B1, 1, 1); PG8_SCHED; PG8_LDA(At, 1, 0); PG8_STAGE(PG8_SA(0, 1), a2 + hstepA, voffA); \
            PG8_WAIT_V(8); PG8_WAIT_L(0); PG8_BAR; PG8_MMA(0, 0, At, B0); PG8_MMA(0, 1, At, B1); PG8_BAR; PG8_SCHED; \
            PG8_LDA(At, 1, 1); PG8_STAGE(PG8_SB(1, 0), b3, voffB); PG8_STAGE(PG8_SB(1, 1), b3 + hstepB, voffB); PG8_STAGE(PG8_SA(1, 0), a3, voffA); \
            PG8_WAIT_V(8); PG8_WAIT_L(0); PG8_BAR; PG8_MMA(1, 0, At, B0); PG8_MMA(1, 1, At, B1); PG8_BAR; PG8_SCHED; } while (0)
        for (int t = 0; t < nt; t += 2) {
            const bool last = (t == nt - 2);
            const char* a1 = cA + (size_t)(t + 1) * kstep;
            const char* a2 = last ? nA : cA + (size_t)(t + 2) * kstep; const char* b2 = last ? nB : cB + (size_t)(t + 2) * kstep;
            const char* a3 = a2 + kstep; const char* b3 = b2 + kstep;
            PG8_KBODY(PG8_WAIT_V(8));
        }
#undef PG8_KBODY
        if constexpr (ALIGN_EPI) { if (wr == 0) PG8_BAR; }
        E(acc, cur, wr, wc, fr, fq);
        if (!has_next) break;
        if (!E.keep(cur)) {
#pragma unroll
            for (int a = 0; a < 2; ++a)
#pragma unroll
                for (int b = 0; b < 2; ++b)
#pragma unroll
                    for (int m = 0; m < 4; ++m)
#pragma unroll
                        for (int n = 0; n < 2; ++n) acc[a][b][m][n] = (f32x4){0.f, 0.f, 0.f, 0.f};
        }
        cur = nxt; cA = nA; cB = nB; ++ui;
        if constexpr (ALIGN_EPI) { if (wr == 1) PG8_BAR; }
    }
    PG8_WAIT_V(0);
    if constexpr (!ALIGN_EPI) { if (wr == 0) PG8_BAR; }
    PG8_BAR;
#undef PG8_SA
#undef PG8_SB
#undef PG8_STAGE
#undef PG8_LDA
#undef PG8_LDB
#undef PG8_MMA
#undef PG8_WAIT_V
#undef PG8_WAIT_L
#undef PG8_WAIT_VN
#undef PG8_BAR
#undef PG8_SCHED
}

struct EpiProj {
    static constexpr bool PERM = true; static constexpr int NVM = 16;
    unsigned char* ws;
    DI bool keep(const Unit&) const { return false; }
    DI void operator()(f32x4 (&acc)[2][2][4][2], const Unit& u, int wr, int wc, int fr, int fq) const {
        const int ct = u.pn; bf16_t* base; int ldc, colt;
        if (ct < 8) { base = (bf16_t*)(ws + WS_MQ + (size_t)(ct >> 1) * (80 * MiB)); ldc = 512; colt = (ct & 1) * 256; }
        else if (ct < 10) { base = (bf16_t*)(ws + WS_AQ); ldc = 512; colt = (ct - 8) * 256; }
        else if (ct == 10) { base = (bf16_t*)(ws + WS_AK); ldc = 256; colt = 0; }
        else if (ct == 11) { base = (bf16_t*)(ws + WS_AV); ldc = 256; colt = 0; }
        else if (ct < 16) { base = (bf16_t*)(ws + WS_GM); ldc = 1024; colt = (ct - 12) * 256; }
        else { base = (bf16_t*)(ws + WS_GA); ldc = 1024; colt = (ct - 16) * 256; }
        const int row0 = u.pm * BM + wr * 64 + fr, col0 = colt + wc * 32 + 8 * fq;
#pragma unroll
        for (int ai = 0; ai < 2; ++ai)
#pragma unroll
            for (int m = 0; m < 4; ++m) { bf16_t* rowp = base + (size_t)(row0 + ai * HALF + m * 16) * ldc + col0;
#pragma unroll
                for (int bj = 0; bj < 2; ++bj) { const f32x4 v0 = acc[ai][bj][m][0], v1 = acc[ai][bj][m][1];
                    u32x4 w; w.x = cvt_pk_bf16(v0[0], v0[1]); w.y = cvt_pk_bf16(v0[2], v0[3]); w.z = cvt_pk_bf16(v1[0], v1[1]); w.w = cvt_pk_bf16(v1[2], v1[3]);
                    *(u32x4*)(rowp + bj * HALF) = w; } }
    }
};
#define PG8_SCR_SETUP const unsigned lo16 = (threadIdx.x & 63u) * 16u; const int wid_ = __builtin_amdgcn_readfirstlane(threadIdx.x >> 6); \
        unsigned char* sa_u = scr + ((size_t)(blockIdx.x * 2 + 0) * 8 + wid_) * 16384; unsigned char* sb_u = scr + ((size_t)(blockIdx.x * 2 + 1) * 8 + wid_) * 16384;
#define sa(k) (sa_u + (k) * 1024 + lo16)
#define sb(k) (sb_u + (k) * 1024 + lo16)
struct EpiGate {
    static constexpr bool PERM = true; static constexpr int NVM = 16;
    unsigned char* scr;
    DI bool keep(const Unit&) const { return false; }
    DI void operator()(f32x4 (&acc)[2][2][4][2], const Unit& u, int wr, int wc, int fr, int fq) const {
        PG8_SCR_SETUP
        if (u.sel == 0) {
#pragma unroll
            for (int ai = 0; ai < 2; ++ai)
#pragma unroll
                for (int m = 0; m < 4; ++m)
#pragma unroll
                    for (int bj = 0; bj < 2; ++bj) { float v[8];
#pragma unroll
                        for (int e = 0; e < 8; ++e) v[e] = sigmoidf_(acc[ai][bj][m][e >> 2][e & 3]);
                        u32x4 w; w.x = pk2(v[0], v[1]); w.y = pk2(v[2], v[3]); w.z = pk2(v[4], v[5]); w.w = pk2(v[6], v[7]);
                        *(u32x4*)sa(ai * 8 + m * 2 + bj) = w; }
        } else {
#pragma unroll
            for (int ai = 0; ai < 2; ++ai) {
                u32x4 A8[4][2];
#pragma unroll
                for (int m = 0; m < 4; ++m)
#pragma unroll
                    for (int bj = 0; bj < 2; ++bj) A8[m][bj] = *(const u32x4*)sa(ai * 8 + m * 2 + bj);
#pragma unroll
                for (int m = 0; m < 4; ++m)
#pragma unroll
                    for (int bj = 0; bj < 2; ++bj) { float r[8], b[8];
#pragma unroll
                        for (int e = 0; e < 8; ++e) { const float av = (e & 1) ? bfhi(A8[m][bj][e >> 1]) : bflo(A8[m][bj][e >> 1]); const float den = 1.f + __expf(-acc[ai][bj][m][e >> 2][e & 3]);
                            b[e] = __builtin_amdgcn_rcpf(den); r[e] = av * den; }
                        u32x4 wr_, wb_; wr_.x = pk2(r[0], r[1]); wr_.y = pk2(r[2], r[3]); wr_.z = pk2(r[4], r[5]); wr_.w = pk2(r[6], r[7]);
                        wb_.x = pk2(b[0], b[1]); wb_.y = pk2(b[2], b[3]); wb_.z = pk2(b[4], b[5]); wb_.w = pk2(b[6], b[7]);
                        *(u32x4*)sa(ai * 8 + m * 2 + bj) = wr_; *(u32x4*)sb(ai * 8 + m * 2 + bj) = wb_; }
            }
        }
    }
};
struct EpiMix {
    static constexpr bool PERM = true; static constexpr int NVM = 16;
    bf16_t* Y; unsigned char* scr;
    DI bool keep(const Unit& u) const { return u.sel == 0; }
    DI void operator()(f32x4 (&acc)[2][2][4][2], const Unit& u, int wr, int wc, int fr, int fq) const {
        PG8_SCR_SETUP
        if (u.sel == 0) {
#pragma unroll
            for (int ai = 0; ai < 2; ++ai) {
                u32x4 A8[4][2];
#pragma unroll
                for (int m = 0; m < 4; ++m)
#pragma unroll
                    for (int bj = 0; bj < 2; ++bj) A8[m][bj] = *(const u32x4*)sa(ai * 8 + m * 2 + bj);
#pragma unroll
                for (int m = 0; m < 4; ++m)
#pragma unroll
                    for (int bj = 0; bj < 2; ++bj)
#pragma unroll
                        for (int e = 0; e < 8; ++e) { const float rv = (e & 1) ? bfhi(A8[m][bj][e >> 1]) : bflo(A8[m][bj][e >> 1]); acc[ai][bj][m][e >> 2][e & 3] *= rv; }
            }
        } else {
            const int row0 = u.pm * BM + wr * 64 + fr, col0 = u.pn * BM + wc * 32 + 8 * fq;
#pragma unroll
            for (int ai = 0; ai < 2; ++ai) {
                u32x4 B8[4][2];
#pragma unroll
                for (int m = 0; m < 4; ++m)
#pragma unroll
                    for (int bj = 0; bj < 2; ++bj) B8[m][bj] = *(const u32x4*)sb(ai * 8 + m * 2 + bj);
#pragma unroll
                for (int m = 0; m < 4; ++m)
#pragma unroll
                    for (int bj = 0; bj < 2; ++bj) { float v[8];
#pragma unroll
                        for (int e = 0; e < 8; ++e) { const float bv = (e & 1) ? bfhi(B8[m][bj][e >> 1]) : bflo(B8[m][bj][e >> 1]); v[e] = acc[ai][bj][m][e >> 2][e & 3] * bv; }
                        u32x4 w; w.x = pk2(v[0], v[1]); w.y = pk2(v[2], v[3]); w.z = pk2(v[4], v[5]); w.w = pk2(v[6], v[7]);
                        *(u32x4*)(Y + (size_t)(row0 + ai * HALF + m * 16) * DM + col0 + bj * HALF) = w; }
            }
        }
    }
};
#undef PG8_SCR_SETUP
#undef sa
#undef sb
template <bool WITH_HN> struct EpiRes {
    static constexpr bool PERM = true; static constexpr int NVM = 16;
    const float* xp; const float* xs; float* out; bf16_t* hn; float* ss;
    DI bool keep(const Unit&) const { return false; }
    template <int Q> DI void ld(f32x4 (&B)[2][2][2], const Unit& u, int wr, int fr, int cb0) const {
#pragma unroll
        for (int mm = 0; mm < 2; ++mm) { const int t = u.pm * BM + (Q >> 1) * HALF + wr * 64 + (2 * (Q & 1) + mm) * 16 + fr; const float* br = xrow_ptr(xp, xs, t);
#pragma unroll
            for (int bj = 0; bj < 2; ++bj)
#pragma unroll
                for (int n = 0; n < 2; ++n) B[mm][bj][n] = *(const f32x4*)(br + cb0 + bj * HALF + 4 * n); }
    }
    template <int Q> DI void st(const f32x4 (&B)[2][2][2], const f32x4 (&acc)[2][2][4][2], const Unit& u, int wr, int wc, int fr, int fq, int cb0) const {
#pragma unroll
        for (int mm = 0; mm < 2; ++mm) { const int m = 2 * (Q & 1) + mm, ai = Q >> 1; const int t = u.pm * BM + ai * HALF + wr * 64 + m * 16 + fr; float ssq = 0.f;
#pragma unroll
            for (int bj = 0; bj < 2; ++bj) { const int c = cb0 + bj * HALF;
                const f32x4 h0 = B[mm][bj][0] + acc[ai][bj][m][0], h1 = B[mm][bj][1] + acc[ai][bj][m][1];
                ssq += ((h0[0] * h0[0] + h0[1] * h0[1]) + (h0[2] * h0[2] + h0[3] * h0[3])) + ((h1[0] * h1[0] + h1[1] * h1[1]) + (h1[2] * h1[2] + h1[3] * h1[3]));
                u32x4 w; w.x = cvt_pk_bf16(h0[0], h0[1]); w.y = cvt_pk_bf16(h0[2], h0[3]); w.z = cvt_pk_bf16(h1[0], h1[1]); w.w = cvt_pk_bf16(h1[2], h1[3]); *(u32x4*)(hn + (size_t)t * DM + c) = w; }
            ssq += __shfl_xor(ssq, 16); ssq += __shfl_xor(ssq, 32); if (fq == 0) ss[(size_t)t * 16 + u.pn * 4 + wc] = ssq; }
    }
    DI void operator()(f32x4 (&acc)[2][2][4][2], const Unit& u, int wr, int wc, int fr, int fq) const {
        const int cb0 = u.pn * BM + wc * 32 + 8 * fq;
        f32x4 B0[2][2][2], B1[2][2][2];
        ld<0>(B0, u, wr, fr, cb0); ld<1>(B1, u, wr, fr, cb0);
        st<0>(B0, acc, u, wr, wc, fr, fq, cb0); ld<2>(B0, u, wr, fr, cb0);
        st<1>(B1, acc, u, wr, wc, fr, fq, cb0); ld<3>(B1, u, wr, fr, cb0);
        st<2>(B0, acc, u, wr, wc, fr, fq, cb0); st<3>(B1, acc, u, wr, wc, fr, fq, cb0);
    }
};
DI float dpp_ror1(float x) { return __builtin_bit_cast(float, __builtin_amdgcn_update_dpp(0, __builtin_bit_cast(int, x), 0x121, 0xf, 0xf, false)); }
DI float dpp_rol1(float x) { return __builtin_bit_cast(float, __builtin_amdgcn_update_dpp(0, __builtin_bit_cast(int, x), 0x12F, 0xf, 0xf, false)); }
struct EpiConv {
    static constexpr bool PERM = true; static constexpr int NVM = 0;
    bf16_t* G; const float* ss; const float* cw; const float* cb; LAS float* xch;
    DI bool keep(const Unit&) const { return false; }
    DI void operator()(f32x4 (&acc)[2][2][4][2], const Unit& u, int wr, int wc, int fr, int fq) const {
        const int t0 = 254 * u.pm - 1 + 128 * wr + 8 * fr;
        unsigned upz = 0, dnz = 0, stm = 0;
        f32x4 P8[8];
#pragma unroll
        for (int idx = 0; idx < 8; ++idx) { const int t = t0 + idx; const int tc = t < 0 ? 0 : (t >= MTOK ? MTOK - 1 : t); P8[idx] = *(const f32x4*)(ss + (size_t)tc * 16 + 4 * fq); }
#pragma unroll
        for (int idx = 0; idx < 8; ++idx) { const int rho = 128 * wr + 8 * fr + idx, t = t0 + idx;
            const f32x4 p = P8[idx]; float s = (p[0] + p[1]) + (p[2] + p[3]); s += __shfl_xor(s, 16); s += __shfl_xor(s, 32);
            const float rs = __builtin_amdgcn_rsqf(s * (1.f / DM) + EPS);
#pragma unroll
            for (int bj = 0; bj < 2; ++bj)
#pragma unroll
                for (int n = 0; n < 2; ++n) acc[idx >> 2][bj][idx & 3][n] *= rs;
            if (seq_start(t)) upz |= 1u << idx;
            if (t + 1 >= MTOK || seq_start(t + 1)) dnz |= 1u << idx;
            if (rho >= 1 && rho <= 254 && t < MTOK) stm |= 1u << idx; }
        const bool anyb = __builtin_amdgcn_ballot_w64((upz | dnz) != 0u) != 0ull;
        f32x4 X[2][2];
        { LAS float* xw = xch + ((wr * 4 + wc) * 4 + fq) * 16; LAS const float* xr = xch + (((wr ^ 1) * 4 + wc) * 4 + fq) * 16;
          if (wr == 0) { if (fr == 15) {
#pragma unroll
              for (int bj = 0; bj < 2; ++bj)
#pragma unroll
                  for (int n = 0; n < 2; ++n) *(LAS f32x4*)(xw + (bj * 2 + n) * 4) = acc[1][bj][3][n]; } }
          else { if (fr == 0) {
#pragma unroll
              for (int bj = 0; bj < 2; ++bj)
#pragma unroll
                  for (int n = 0; n < 2; ++n) *(LAS f32x4*)(xw + (bj * 2 + n) * 4) = acc[0][bj][0][n]; } }
          asm volatile("s_waitcnt lgkmcnt(0)" ::: "memory"); __builtin_amdgcn_s_barrier(); asm volatile("" ::: "memory");
#pragma unroll
          for (int bj = 0; bj < 2; ++bj)
#pragma unroll
              for (int n = 0; n < 2; ++n) X[bj][n] = *(LAS const f32x4*)(xr + (bj * 2 + n) * 4); }
        const bool xup = (wr == 1) && (fr == 0), xdn = (wr == 0) && (fr == 15);
        f32x4 W[2][4];
#define LOADW(n_) _Pragma("unroll") for (int bj = 0; bj < 2; ++bj) { const int cc = bj * DFF + u.pn * 128 + wc * 32 + 8 * fq + 4 * (n_); \
            W[bj][0] = *(const f32x4*)(cw + cc); W[bj][1] = *(const f32x4*)(cw + NUP + cc); W[bj][2] = *(const f32x4*)(cw + 2 * NUP + cc); W[bj][3] = *(const f32x4*)(cb + cc); }
        LOADW(0)
#pragma unroll
        for (int n = 0; n < 2; ++n) {
            const int ch = u.pn * 128 + wc * 32 + 8 * fq + 4 * n;
            float ca[8][4]; unsigned pk[8][2];
#pragma unroll
            for (int bj = 0; bj < 2; ++bj) {
                const f32x4 w0 = W[bj][0], w1 = W[bj][1], w2 = W[bj][2], bb = W[bj][3];
#pragma unroll
                for (int jp = 0; jp < 2; ++jp) {
                    const f32n2 w0p = {w0[2 * jp], w0[2 * jp + 1]}, w1p = {w1[2 * jp], w1[2 * jp + 1]}, w2p = {w2[2 * jp], w2[2 * jp + 1]}, bbp = {bb[2 * jp], bb[2 * jp + 1]};
                    f32n2 v[8];
#pragma unroll
                    for (int idx = 0; idx < 8; ++idx) v[idx] = (f32n2){acc[idx >> 2][bj][idx & 3][n][2 * jp], acc[idx >> 2][bj][idx & 3][n][2 * jp + 1]};
                    f32n2 up0 = {dpp_ror1(v[7].x), dpp_ror1(v[7].y)}, dn7 = {dpp_rol1(v[0].x), dpp_rol1(v[0].y)};
                    if (xup) up0 = (f32n2){X[bj][n][2 * jp], X[bj][n][2 * jp + 1]};
                    if (xdn) dn7 = (f32n2){X[bj][n][2 * jp], X[bj][n][2 * jp + 1]};
                    f32n2 cv[8];
#pragma unroll
                    for (int idx = 0; idx < 8; ++idx) { f32n2 up = idx ? v[idx > 0 ? idx - 1 : 0] : up0, dn = idx < 7 ? v[idx < 7 ? idx + 1 : 7] : dn7;
                        if (anyb) { if ((upz >> idx) & 1u) up = (f32n2){0.f, 0.f}; if ((dnz >> idx) & 1u) dn = (f32n2){0.f, 0.f}; }
                        cv[idx] = w0p * up + (w1p * v[idx] + (w2p * dn + bbp)); }
                    if (bj == 0) {
#pragma unroll
                        for (int idx = 0; idx < 8; ++idx) { ca[idx][2 * jp] = cv[idx].x; ca[idx][2 * jp + 1] = cv[idx].y; }
                    } else {
#pragma unroll
                        for (int idx = 0; idx < 8; ++idx) { const f32n2 a2 = {ca[idx][2 * jp], ca[idx][2 * jp + 1]}; const f32n2 sg = {sigmoidf_(a2.x), sigmoidf_(a2.y)};
                            const f32n2 r2 = (a2 * sg) * cv[idx]; ca[idx][2 * jp] = r2.x; ca[idx][2 * jp + 1] = r2.y; }
                    } } }
#pragma unroll
            for (int idx = 0; idx < 8; ++idx) { pk[idx][0] = cvt_pk_bf16_asm(ca[idx][0], ca[idx][1]); pk[idx][1] = cvt_pk_bf16_asm(ca[idx][2], ca[idx][3]); }
            if (n == 0) { LOADW(1) }
#pragma unroll
            for (int idx = 0; idx < 8; ++idx) if ((stm >> idx) & 1u) { u32x2 w; w.x = pk[idx][0]; w.y = pk[idx][1]; *(u32x2*)(G + (size_t)(t0 + idx) * DFF + ch) = w; }
        }
#undef LOADW
    }
};
struct EpiFinal {
    static constexpr bool PERM = true; static constexpr int NVM = 32;
    float* out; const bf16_t* hn; const float* nfw; unsigned* xs; unsigned* cnt;
    DI bool keep(const Unit&) const { return false; }
    template <int Q> DI void ld(f32x4 (&B)[2][2][2], const Unit& u, int wr, int fr, int cb0) const {
#pragma unroll
        for (int mm = 0; mm < 2; ++mm) { const int t = u.pm * BM + (Q >> 1) * HALF + wr * 64 + (2 * (Q & 1) + mm) * 16 + fr; const bf16_t* br = hn + (size_t)t * DM;
#pragma unroll
            for (int bj = 0; bj < 2; ++bj) { const u32x4 w = *(const u32x4*)(br + cb0 + bj * HALF);
                B[mm][bj][0] = (f32x4){bflo(w.x), bfhi(w.x), bflo(w.y), bfhi(w.y)}; B[mm][bj][1] = (f32x4){bflo(w.z), bfhi(w.z), bflo(w.w), bfhi(w.w)}; } }
    }
    template <int Q> DI void add(const f32x4 (&B)[2][2][2], f32x4 (&acc)[2][2][4][2], const Unit& u, int wr, int wc, int fr, int fq) const {
#pragma unroll
        for (int mm = 0; mm < 2; ++mm) { const int m = 2 * (Q & 1) + mm, ai = Q >> 1; const int t = u.pm * BM + ai * HALF + wr * 64 + m * 16 + fr; float ssq = 0.f;
#pragma unroll
            for (int bj = 0; bj < 2; ++bj)
#pragma unroll
                for (int n = 0; n < 2; ++n) { const f32x4 hv = B[mm][bj][n] + acc[ai][bj][m][n]; acc[ai][bj][m][n] = hv; ssq += (hv[0] * hv[0] + hv[1] * hv[1]) + (hv[2] * hv[2] + hv[3] * hv[3]); }
            ssq += __shfl_xor(ssq, 16); ssq += __shfl_xor(ssq, 32);
            if (fq == 0) __hip_atomic_store(xs + (size_t)t * 16 + u.pn * 4 + wc, __float_as_uint(ssq), __ATOMIC_RELAXED, __HIP_MEMORY_SCOPE_AGENT); }
    }
    DI void operator()(f32x4 (&acc)[2][2][4][2], const Unit& u, int wr, int wc, int fr, int fq) const {
        const int lane = threadIdx.x & 63, cb0 = u.pn * BM + wc * 32 + 8 * fq;
        { f32x4 B0[2][2][2], B1[2][2][2];
          ld<0>(B0, u, wr, fr, cb0); ld<1>(B1, u, wr, fr, cb0);
          add<0>(B0, acc, u, wr, wc, fr, fq); ld<2>(B0, u, wr, fr, cb0);
          add<1>(B1, acc, u, wr, wc, fr, fq); ld<3>(B1, u, wr, fr, cb0);
          add<2>(B0, acc, u, wr, wc, fr, fq); add<3>(B1, acc, u, wr, wc, fr, fq); }
        asm volatile("s_waitcnt vmcnt(0)" ::: "memory");
        unsigned* cw_ = cnt + 64 * u.pm;
        if (lane == 0) __hip_atomic_fetch_add(cw_, 1u, __ATOMIC_RELAXED, __HIP_MEMORY_SCOPE_AGENT);
        f32x4 W4[2][2];
#pragma unroll
        for (int bj = 0; bj < 2; ++bj)
#pragma unroll
            for (int n = 0; n < 2; ++n) W4[bj][n] = *(const f32x4*)(nfw + cb0 + bj * HALF + 4 * n);
        while ((unsigned)__builtin_amdgcn_readfirstlane(__hip_atomic_load(cw_, __ATOMIC_RELAXED, __HIP_MEMORY_SCOPE_AGENT)) < 32u) __builtin_amdgcn_s_sleep(2);
        asm volatile("" ::: "memory");
        unsigned Pp[8][4];
#pragma unroll
        for (int idx = 0; idx < 8; ++idx) { const int t = u.pm * BM + (idx >> 2) * HALF + wr * 64 + (idx & 3) * 16 + fr; const unsigned* xp_ = xs + (size_t)t * 16 + 4 * fq;
#pragma unroll
            for (int q = 0; q < 4; ++q) Pp[idx][q] = __hip_atomic_load(xp_ + q, __ATOMIC_RELAXED, __HIP_MEMORY_SCOPE_AGENT); }
#pragma unroll
        for (int idx = 0; idx < 8; ++idx) { const int ai = idx >> 2, m = idx & 3; const int t = u.pm * BM + ai * HALF + wr * 64 + m * 16 + fr; float* orow = out + (size_t)t * DM;
            float s = (__uint_as_float(Pp[idx][0]) + __uint_as_float(Pp[idx][1])) + (__uint_as_float(Pp[idx][2]) + __uint_as_float(Pp[idx][3]));
            s += __shfl_xor(s, 16); s += __shfl_xor(s, 32);
            const float rs = 1.f / sqrtf(s * (1.f / DM) + EPS);
#pragma unroll
            for (int bj = 0; bj < 2; ++bj)
#pragma unroll
                for (int n = 0; n < 2; ++n) *(f32x4*)(orow + cb0 + bj * HALF + 4 * n) = acc[ai][bj][m][n] * rs * W4[bj][n]; }
    }
};
}

DI void transpose_item(const float* W, int ldw, int src_col0, int k0, bf16_t* WT, int K, int dst_row0, const float* kscale, float nscale, LAS float* scr, int lane) {
    float wv[32];
#pragma unroll
    for (int i = 0; i < 32; ++i) { const int kk = 2 * i + (lane >> 5); wv[i] = W[(size_t)(k0 + kk) * ldw + src_col0 + (lane & 31)]; }
#pragma unroll
    for (int i = 0; i < 32; ++i) { const int kk = 2 * i + (lane >> 5); const float s = kscale ? kscale[k0 + kk] * nscale : nscale;
        scr[kk * 33 + (lane & 31)] = wv[i] * s; }
    asm volatile("s_waitcnt lgkmcnt(0)" ::: "memory");
    const int c = lane & 7;
#pragma unroll
    for (int j = 0; j < 4; ++j) { const int n = (lane >> 3) + 8 * j; const LAS float* s = scr + (8 * c) * 33 + n;
        u32x4 o; o.x = pk2(s[0 * 33], s[1 * 33]); o.y = pk2(s[2 * 33], s[3 * 33]); o.z = pk2(s[4 * 33], s[5 * 33]); o.w = pk2(s[6 * 33], s[7 * 33]);
        *(u32x4*)(WT + (size_t)(dst_row0 + n) * K + k0 + 8 * c) = o; }
    asm volatile("s_waitcnt lgkmcnt(0)" ::: "memory");
}
DI float reduce16(const float (&p)[16], int lane) {
    const bool b5 = lane & 32, b4 = lane & 16, b3 = lane & 8, b2 = lane & 4;
    float q[8], r[4], s[2];
#pragma unroll
    for (int j = 0; j < 8; ++j) { const float send = b5 ? p[j] : p[j + 8], keep = b5 ? p[j + 8] : p[j]; q[j] = keep + __shfl_xor(send, 32); }
#pragma unroll
    for (int j = 0; j < 4; ++j) { const float send = b4 ? q[j] : q[j + 4], keep = b4 ? q[j + 4] : q[j]; r[j] = keep + __shfl_xor(send, 16); }
#pragma unroll
    for (int j = 0; j < 2; ++j) { const float send = b3 ? r[j] : r[j + 2], keep = b3 ? r[j + 2] : r[j]; s[j] = keep + __shfl_xor(send, 8); }
    const float send = b2 ? s[0] : s[1], keep = b2 ? s[1] : s[0]; float v = keep + __shfl_xor(send, 4);
    v += __shfl_xor(v, 2); v += __shfl_xor(v, 1); return v;
}

struct ChunkVec { float g0, g1, b0, b1, cm0, cm1, btot, gmax; int s0, s1; };
struct ChunkGates { float i0, f0, i1, f1; int s0, s1; };
DI ChunkGates chunk_gates_load(int d, const float* gates, int t0, int head, int lane) {
    ChunkGates q; const int e0 = 2 * lane, e1 = e0 + 1; q.s0 = d ? 127 - e0 : e0; q.s1 = d ? 127 - e1 : e1;
    const float* g0p = gates + (size_t)(t0 + q.s0) * 16 + d * 4 + head; const float* g1p = gates + (size_t)(t0 + q.s1) * 16 + d * 4 + head;
    q.i0 = g0p[0]; q.f0 = g0p[8]; q.i1 = g1p[0]; q.f1 = g1p[8]; return q;
}
DI ChunkVec chunk_vectors_from(const ChunkGates& q, int lane) {
    ChunkVec r; r.s0 = q.s0; r.s1 = q.s1;
    const float i0 = q.i0, f0 = q.f0, i1 = q.i1, f1 = q.f1;
    const float lf0 = logsigmoid_(f0), lf1 = logsigmoid_(f1);
    float ps = lf0 + lf1;
#pragma unroll
    for (int o = 1; o < 64; o <<= 1) { const float t = __shfl_up(ps, o); if (lane >= o) ps += t; }
    const float excl = ps - (lf0 + lf1); r.b0 = excl + lf0; r.b1 = r.b0 + lf1;
    r.g0 = i0 - r.b0; r.g1 = i1 - r.b1;
    float cm = fmaxf(r.g0, r.g1);
#pragma unroll
    for (int o = 1; o < 64; o <<= 1) { const float t = __shfl_up(cm, o); if (lane >= o) cm = fmaxf(cm, t); }
    float ex = __shfl_up(cm, 1); if (lane == 0) ex = -INFINITY;
    r.cm0 = fmaxf(ex, r.g0); r.cm1 = fmaxf(r.cm0, r.g1);
    r.btot = __shfl(r.b1, 63); r.gmax = __shfl(r.cm1, 63);
    return r;
}
DI ChunkVec chunk_vectors(int d, const float* gates, int t0, int head, int lane) { return chunk_vectors_from(chunk_gates_load(d, gates, t0, head, lane), lane); }

struct Ctx {
    const float* in[17]; float* out; unsigned char* ws;
};

DI void summary_unit(LAS unsigned char* lds, const Ctx& c, int chunk, int head, int tid, int lane, int wid) {
    asm volatile("" : "+v"(tid), "+v"(lane));
    const int t0 = chunk * 128, fr = lane & 15, fq = lane >> 4;
    LAS bf16_t* LVT = (LAS bf16_t*)lds; LAS bf16_t* LKF = (LAS bf16_t*)(lds + 34816); LAS bf16_t* LKB = (LAS bf16_t*)(lds + 69632); LAS float* vW = (LAS float*)(lds + 104448);
    const float* gates = (const float*)(c.ws + WS_GATES);
    const bf16_t* MK = (const bf16_t*)(c.ws + WS_MK); const bf16_t* MV = (const bf16_t*)(c.ws + WS_MV);
    u32x4 v8r[4], k8r[4];
#pragma unroll
    for (int i = 0; i < 4; ++i) { const int idx = tid + 512 * i, s = idx & 127, ch = idx >> 7; const size_t go = (size_t)(t0 + s) * 512 + head * 128 + ch * 8; v8r[i] = *(const u32x4*)(MV + go); k8r[i] = *(const u32x4*)(MK + go); }
    if (wid < 2) { const int d = wid; const ChunkVec v = chunk_vectors(d, gates, t0, head, lane);
        vW[d * 128 + v.s0] = __expf(v.g0 - v.gmax); vW[d * 128 + v.s1] = __expf(v.g1 - v.gmax);
        if (lane == 0) { float* sc = (float*)(c.ws + WS_CHSC) + ((size_t)(d * NCHUNK + chunk) * 4 + head) * 2; sc[0] = v.btot; sc[1] = v.btot + v.gmax; } }
    __syncthreads();
#pragma unroll
    for (int i = 0; i < 4; ++i) { const int idx = tid + 512 * i, s = idx & 127, ch = idx >> 7;
        const u32x4 v8 = v8r[i], k8 = k8r[i]; const float wf = vW[s], wb = vW[128 + s];
#pragma unroll
        for (int e = 0; e < 8; ++e) { const unsigned vw = v8[e >> 1], kw = k8[e >> 1]; const float kf = (e & 1) ? bfhi(kw) : bflo(kw);
            LVT[(8 * ch + e) * 136 + s] = (bf16_t)((e & 1) ? (vw >> 16) : (vw & 0xffffu));
            const unsigned fb = pk2(wf * kf, wb * kf); LKF[(8 * ch + e) * 136 + s] = (bf16_t)(fb & 0xffffu); LKB[(8 * ch + e) * 136 + s] = (bf16_t)(fb >> 16); } }
    __syncthreads();
    const int d = wid & 1, cgp = wid >> 1;
    LAS const unsigned char* LKD = (LAS const unsigned char*)(d ? LKB : LKF);
    bf16x8 Y[2][4];
#pragma unroll
    for (int ci = 0; ci < 2; ++ci)
#pragma unroll
        for (int ks = 0; ks < 4; ++ks) Y[ci][ks] = *(LAS const bf16x8*)(LKD + (16 * (2 * cgp + ci) + fr) * 272 + (32 * ks + 8 * fq) * 2);
    bf16_t* ST = (bf16_t*)(c.out) + ((size_t)(d * NCHUNK + chunk) * 4 + head) * ST_ELEMS;
#pragma unroll
    for (int rt = 0; rt < 9; ++rt) {
        bf16x8 X[4];
#pragma unroll
        for (int ks = 0; ks < 4; ++ks) {
            if (rt < 8) X[ks] = *(LAS const bf16x8*)((LAS const unsigned char*)LVT + (16 * rt + fr) * 272 + (32 * ks + 8 * fq) * 2);
            else { const short o = fr == 0 ? (short)0x3F80 : (short)0; X[ks] = (bf16x8){o, o, o, o, o, o, o, o}; } }
#pragma unroll
        for (int ci = 0; ci < 2; ++ci) { f32x4 a = (f32x4){0.f, 0.f, 0.f, 0.f};
#pragma unroll
            for (int ks = 0; ks < 4; ++ks) a = MFMA16(Y[ci][ks], X[ks], a);
            const int v = 16 * rt + fr, k = 16 * (2 * cgp + ci) + 4 * fq;
            if (rt < 8 || fr == 0) { u32x2 w; w.x = pk2(a[0], a[1]); w.y = pk2(a[2], a[3]); *(u32x2*)(ST + (size_t)v * 128 + k) = w; } }
    }
    __syncthreads();
}

DI void attn_unit(LAS unsigned char* lds, const Ctx& c, int qb2, int hk, int tid, int lane, int wid) {
    asm volatile("" : "+v"(tid), "+v"(lane));
    const int t0 = qb2 * 256, fr = lane & 15, fq = lane >> 4;
    const int nseq = qb2 < 64 ? qb2 : ((qb2 - 64) & 15), Nseq = qb2 < 64 ? 64 : 16, pos0 = nseq * 256;
    const bool bv0 = nseq >= 1, bv3 = nseq + 1 < Nseq;
    LAS unsigned char* LKB = lds; LAS bf16_t* LVT = (LAS bf16_t*)(lds + 73728);
    const bf16_t* AK = (const bf16_t*)(c.ws + WS_AK); const bf16_t* AV = (const bf16_t*)(c.ws + WS_AV); const bf16_t* AQ = (const bf16_t*)(c.ws + WS_AQ);
    const float* rope = (const float*)(c.ws + WS_ROPE);
    const int g = wid >> 2, rg = wid & 3, hq = 2 * hk + g, r0 = 64 * rg;
#define ATT_OK(j) ((((j) >> 7) == 0) ? bv0 : ((((j) >> 7) == 3) ? bv3 : true))
    u32x4 kb[6];
#pragma unroll
    for (int i = 0; i < 6; ++i) { const int idx = tid + 512 * i; const int j = idx / 6, ch = 2 + (idx - 6 * j); const bool ok = ATT_OK(j);
        const int tok = ok ? t0 - 128 + j : t0 + (j & 127); kb[i] = *(const u32x4*)((const char*)AK + (unsigned)((tok * 256 + hk * 64 + ch * 8) * 2)); }
    u32x4 kx1, kx2; f32x4 ktb[4];
    { const int j = tid; const bool ok = ATT_OK(j); const int tok = ok ? t0 - 128 + j : t0 + (j & 127);
      const unsigned ko = (unsigned)((tok * 256 + hk * 64) * 2); kx1 = *(const u32x4*)((const char*)AK + ko); kx2 = *(const u32x4*)((const char*)AK + ko + 16u);
      const unsigned to = (unsigned)((ok ? pos0 - 128 + j : 0) * 64);
#pragma unroll
      for (int q = 0; q < 4; ++q) ktb[q] = *(const f32x4*)((const char*)rope + to + 16u * q); }
    u32x4 vb[8];
#pragma unroll
    for (int i = 0; i < 8; ++i) { const int idx = tid + 512 * i, ch = idx >> 9, j = idx & 511; const bool ok = ATT_OK(j);
        const int tok = ok ? t0 - 128 + j : t0 + (j & 127); vb[i] = *(const u32x4*)((const char*)AV + (unsigned)((tok * 256 + hk * 64 + ch * 8) * 2)); }
#pragma unroll
    for (int i = 0; i < 6; ++i) { const int idx = tid + 512 * i; const int j = idx / 6, ch = 2 + (idx - 6 * j); const bool ok = ATT_OK(j);
        *(LAS u32x4*)(LKB + j * 144 + ch * 16) = ok ? kb[i] : (u32x4){0u, 0u, 0u, 0u}; }
    { const int j = tid; const bool ok = ATT_OK(j);
      float ra[8], rb[8];
#pragma unroll
      for (int e = 0; e < 8; ++e) { const float a = (e & 1) ? bfhi(kx1[e >> 1]) : bflo(kx1[e >> 1]), b = (e & 1) ? bfhi(kx2[e >> 1]) : bflo(kx2[e >> 1]); const float cs = ktb[e >> 2][e & 3], sn = ktb[2 + (e >> 2)][e & 3];
          ra[e] = a * cs - b * sn; rb[e] = b * cs + a * sn; }
      u32x4 o1, o2; o1.x = pk2(ra[0], ra[1]); o1.y = pk2(ra[2], ra[3]); o1.z = pk2(ra[4], ra[5]); o1.w = pk2(ra[6], ra[7]); o2.x = pk2(rb[0], rb[1]); o2.y = pk2(rb[2], rb[3]); o2.z = pk2(rb[4], rb[5]); o2.w = pk2(rb[6], rb[7]);
      if (!ok) { o1 = (u32x4){0u, 0u, 0u, 0u}; o2 = o1; }
      *(LAS u32x4*)(LKB + j * 144) = o1; *(LAS u32x4*)(LKB + j * 144 + 16) = o2; }
#pragma unroll
    for (int i = 0; i < 8; ++i) { const int idx = tid + 512 * i, ch = idx >> 9, j = idx & 511; const bool ok = ATT_OK(j);
        const u32x4 v8 = ok ? vb[i] : (u32x4){0u, 0u, 0u, 0u};
#pragma unroll
        for (int e = 0; e < 8; ++e) { const unsigned vw = v8[e >> 1]; LVT[(8 * ch + e) * 520 + j] = (bf16_t)((e & 1) ? (vw >> 16) : (vw & 0xffffu)); } }
    asm volatile("" ::: "memory");
    const float sink = c.in[7][hq] * 1.4426950408889634f;
    bf16x8 Xq[4][2];
#pragma unroll
    for (int mi = 0; mi < 4; ++mi) { const int rho = r0 + 16 * mi + fr; const unsigned qo = (unsigned)(((t0 + rho) * 512 + hq * 64 + 8 * fq) * 2);
#pragma unroll
        for (int ks = 0; ks < 2; ++ks) {
            u32x4 q = *(const u32x4*)((const char*)AQ + qo + 64u * ks);
            if (ks == 0) { u32x4 pr; pr.x = __shfl_xor(q.x, 16); pr.y = __shfl_xor(q.y, 16); pr.z = __shfl_xor(q.z, 16); pr.w = __shfl_xor(q.w, 16);
                if (fq < 2) { float r[8]; const float* tb = rope + (size_t)(pos0 + rho) * 16;
#pragma unroll
                    for (int e = 0; e < 8; ++e) { const float own = (e & 1) ? bfhi(q[e >> 1]) : bflo(q[e >> 1]), oth = (e & 1) ? bfhi(pr[e >> 1]) : bflo(pr[e >> 1]); const float cs = tb[e], sn = tb[8 + e];
                        r[e] = fq == 0 ? (own * cs - oth * sn) : (own * cs + oth * sn); }
                    q.x = pk2(r[0], r[1]); q.y = pk2(r[2], r[3]); q.z = pk2(r[4], r[5]); q.w = pk2(r[6], r[7]); } }
            Xq[mi][ks] = __builtin_bit_cast(bf16x8, q); } }
    __syncthreads();
    f32x4 O[4][4]; float mrow[4], lrow[4];
#pragma unroll
    for (int mi = 0; mi < 4; ++mi) { mrow[mi] = sink; lrow[mi] = fq == 0 ? 1.f : 0.f;
#pragma unroll
        for (int nd = 0; nd < 4; ++nd) O[mi][nd] = (f32x4){0.f, 0.f, 0.f, 0.f}; }
    for (int kt = 0; kt < 10; ++kt) {
        const int j0 = r0 + 32 * kt;
        if (!ATT_OK(j0)) continue;
#pragma unroll
        for (int mh = 0; mh < 2; ++mh) {
            const int ra0 = r0 + 32 * mh;
            if (j0 + 31 < ra0 || j0 > ra0 + 31 + 256) continue;
            f32x4 S[2][2];
#pragma unroll
            for (int m2 = 0; m2 < 2; ++m2)
#pragma unroll
                for (int ni = 0; ni < 2; ++ni) S[m2][ni] = (f32x4){0.f, 0.f, 0.f, 0.f};
#pragma unroll
            for (int ks = 0; ks < 2; ++ks)
#pragma unroll
                for (int ni = 0; ni < 2; ++ni) { const bf16x8 Yk = *(LAS const bf16x8*)(LKB + (j0 + 16 * ni + fr) * 144 + (32 * ks + 8 * fq) * 2);
#pragma unroll
                    for (int m2 = 0; m2 < 2; ++m2) S[m2][ni] = MFMA16(Yk, Xq[2 * mh + m2][ks], S[m2][ni]); }
            bf16x8 Xp[2];
#pragma unroll
            for (int m2 = 0; m2 < 2; ++m2) { const int mi = 2 * mh + m2; const int rhoa = r0 + 16 * mi, rho = rhoa + fr;
                const bool full = (j0 >= rhoa + 15) && (j0 + 31 <= rhoa + 256);
                float mx = -INFINITY;
                if (full) {
#pragma unroll
                    for (int ni = 0; ni < 2; ++ni)
#pragma unroll
                        for (int jj = 0; jj < 4; ++jj) mx = fmaxf(mx, S[m2][ni][jj]);
                } else {
#pragma unroll
                    for (int ni = 0; ni < 2; ++ni)
#pragma unroll
                        for (int jj = 0; jj < 4; ++jj) { const int j = j0 + 16 * ni + 4 * fq + jj; const bool ok = (j >= rho) && (j <= rho + 256);
                            const float sv = ok ? S[m2][ni][jj] : -INFINITY; S[m2][ni][jj] = sv; mx = fmaxf(mx, sv); }
                }
                if (__builtin_amdgcn_ballot_w64(mx > mrow[mi] + 6.0f) != 0ull) {
                    mx = fmaxf(mx, __shfl_xor(mx, 16)); mx = fmaxf(mx, __shfl_xor(mx, 32));
                    const float mnew = fmaxf(mrow[mi], mx), alpha = __builtin_amdgcn_exp2f(mrow[mi] - mnew); mrow[mi] = mnew; lrow[mi] *= alpha;
#pragma unroll
                    for (int nd = 0; nd < 4; ++nd) O[mi][nd] *= alpha; }
                const float mref = mrow[mi];
                float p[8], ps = 0.f;
#pragma unroll
                for (int e = 0; e < 8; ++e) { p[e] = __builtin_amdgcn_exp2f(S[m2][e >> 2][e & 3] - mref); ps += p[e]; }
                lrow[mi] += ps;
                Xp[m2] = pack8(p); }
#pragma unroll
            for (int nd = 0; nd < 4; ++nd) { const LAS bf16_t* vp = LVT + (16 * nd + fr) * 520 + j0 + 4 * fq;
                const s16x4 lo = *(LAS const s16x4*)vp, hi = *(LAS const s16x4*)(vp + 16);
                const bf16x8 Yv = (bf16x8){lo[0], lo[1], lo[2], lo[3], hi[0], hi[1], hi[2], hi[3]};
#pragma unroll
                for (int m2 = 0; m2 < 2; ++m2) O[2 * mh + m2][nd] = MFMA16(Yv, Xp[m2], O[2 * mh + m2][nd]); }
        }
    }
#pragma unroll
    for (int mi = 0; mi < 4; ++mi) { float l = lrow[mi]; l += __shfl_xor(l, 16); l += __shfl_xor(l, 32); const float inv = 1.f / l;
        bf16_t* op = (bf16_t*)(c.ws + WS_HMOA) + (size_t)(t0 + r0 + 16 * mi + fr) * 1024 + 512 + hq * 64 + 4 * fq;
#pragma unroll
        for (int nd = 0; nd < 4; ++nd) { const f32x4 o = O[mi][nd] * inv; u32x2 w; w.x = pk2(o[0], o[1]); w.y = pk2(o[2], o[3]); *(u32x2*)(op + 16 * nd) = w; } }
    __syncthreads();
#undef ATT_OK
}

DI void scan_item(const Ctx& c, int st, int slice, int lane) {
    const int seq = st >> 3, head = (st >> 1) & 3, d = st & 1;
    const int chunk0 = seq == 0 ? 0 : 128 + 32 * (seq - 1), nch = seq == 0 ? 128 : 32;
    const int e0 = slice * 512 + lane * 8; const bool act = e0 < ST_ELEMS;
    bf16_t* CST = (bf16_t*)c.out; const float* CHSC = (const float*)(c.ws + WS_CHSC); float* MP = (float*)(c.ws + WS_MPREV);
    float C[8];
#pragma unroll
    for (int e = 0; e < 8; ++e) C[e] = 0.f;
    float m = 0.f;
    for (int i0 = 0; i0 < nch; i0 += 8) {
        u32x4 ld[8]; float bt[8], ml[8];
#pragma unroll
        for (int u = 0; u < 8; ++u) { const int ch = d ? chunk0 + nch - 1 - (i0 + u) : chunk0 + i0 + u; const size_t ti = (size_t)(d * NCHUNK + ch) * 4 + head;
            ld[u] = act ? *(const u32x4*)(CST + ti * ST_ELEMS + e0) : (u32x4){0u, 0u, 0u, 0u}; bt[u] = CHSC[ti * 2]; ml[u] = CHSC[ti * 2 + 1]; }
#pragma unroll
        for (int u = 0; u < 8; ++u) { const int ch = d ? chunk0 + nch - 1 - (i0 + u) : chunk0 + i0 + u; const size_t ti = (size_t)(d * NCHUNK + ch) * 4 + head;
            if (slice == 0 && lane == 0) MP[ti] = m;
            u32x4 o; o.x = pk2(C[0], C[1]); o.y = pk2(C[2], C[3]); o.z = pk2(C[4], C[5]); o.w = pk2(C[6], C[7]);
            if (act) *(u32x4*)(CST + ti * ST_ELEMS + e0) = o;
            const float mn = fmaxf(bt[u] + m, ml[u]), sp = __expf(bt[u] + m - mn), sl = __expf(ml[u] - mn); m = mn;
#pragma unroll
            for (int e = 0; e < 8; ++e) { const unsigned w = ld[u][e >> 1]; const float cl = (e & 1) ? bfhi(w) : bflo(w); C[e] = sp * C[e] + sl * cl; } }
    }
}

template <int DIR> DI void dir_pass(const f32x4 (&S)[8], const bf16x8 (&Xq)[4], LAS const unsigned char* LS, LAS const unsigned char* LVTb, LAS const float* vec, int trow, int fr, int fq, f32x4 (&hs)[8]) {
    f32x4 acc[9];
#pragma unroll
    for (int nt = 0; nt < 9; ++nt) { acc[nt] = (f32x4){0.f, 0.f, 0.f, 0.f};
#pragma unroll
        for (int ks = 0; ks < 4; ++ks) { const bf16x8 Y = *(LAS const bf16x8*)(LS + (16 * nt + fr) * 272 + (32 * ks + 8 * fq) * 2); acc[nt] = MFMA16(Y, Xq[ks], acc[nt]); } asm volatile("" ::: "memory"); }
    const float Mt = vec[128 + trow], ex = vec[256 + trow], iw = vec[384 + trow];
#pragma unroll
    for (int nt = 0; nt < 9; ++nt) acc[nt] *= iw;
    bf16x8 Xp[4];
#pragma unroll
    for (int kp = 0; kp < 4; ++kp) { float p[8];
#pragma unroll
        for (int h2 = 0; h2 < 2; ++h2) { const int n = 2 * kp + h2; const f32x4 g4 = *(LAS const f32x4*)(vec + 16 * n + 4 * fq);
#pragma unroll
            for (int j = 0; j < 4; ++j) { const int s = 16 * n + 4 * fq + j; const bool ok = DIR == 0 ? (s <= trow) : (s >= trow);
                p[4 * h2 + j] = ok ? S[n][j] * __builtin_amdgcn_exp2f(g4[j] - Mt) : 0.f; } }
        Xp[kp] = pack8(p); }
#pragma unroll
    for (int nt = 0; nt < 8; ++nt)
#pragma unroll
        for (int kp = 0; kp < 4; ++kp) { LAS const unsigned char* vp = LVTb + (16 * nt + fr) * 272 + (32 * kp + 4 * fq) * 2;
            const s16x4 lo = *(LAS const s16x4*)vp, hi = *(LAS const s16x4*)(vp + 32);
            const bf16x8 Y = (bf16x8){lo[0], lo[1], lo[2], lo[3], hi[0], hi[1], hi[2], hi[3]};
            acc[nt] = MFMA16(Y, Xp[kp], acc[nt]); if (kp == 3) asm volatile("" ::: "memory"); }
    { const short o = fr == 0 ? (short)0x3F80 : (short)0; const bf16x8 ones = (bf16x8){o, o, o, o, o, o, o, o};
#pragma unroll
        for (int kp = 0; kp < 4; ++kp) acc[8] = MFMA16(ones, Xp[kp], acc[8]); }
    const float den = __shfl(acc[8][0], fr);
    const float inv = 1.f / fmaxf(fabsf(den), ex);
#pragma unroll
    for (int nt = 0; nt < 8; ++nt) { if (DIR == 0) hs[nt] = acc[nt] * inv; else hs[nt] += acc[nt] * inv; }
}
DI void mlstm_out_unit(LAS unsigned char* lds, const Ctx& c, int chunk, int head, int tid, int lane, int wid) {
    asm volatile("" : "+v"(tid), "+v"(lane));
    const int t0 = chunk * 128, fr = lane & 15, fq = lane >> 4;
    LAS unsigned char* LQ = lds; LAS unsigned char* LK = lds + 34816; LAS unsigned char* LVTb = lds + 73984; LAS unsigned char* LSB = lds + 108800; LAS float* vec = (LAS float*)(lds + 147968);
    LAS bf16_t* LVT = (LAS bf16_t*)LVTb;
    const bf16_t* MQ = (const bf16_t*)(c.ws + WS_MQ); const bf16_t* MK = (const bf16_t*)(c.ws + WS_MK); const bf16_t* MV = (const bf16_t*)(c.ws + WS_MV); bf16_t* MO = (bf16_t*)(c.ws + WS_MO);
    const bf16_t* CSTF = (const bf16_t*)c.out + ((size_t)(0 * NCHUNK + chunk) * 4 + head) * ST_ELEMS; const bf16_t* CSTB = (const bf16_t*)c.out + ((size_t)(1 * NCHUNK + chunk) * 4 + head) * ST_ELEMS;
    ChunkGates cgq; cgq.i0 = cgq.f0 = cgq.i1 = cgq.f1 = 0.f; cgq.s0 = cgq.s1 = 0; float mp_early = 0.f;
    if (wid < 2) { cgq = chunk_gates_load(wid, (const float*)(c.ws + WS_GATES), t0, head, lane); mp_early = ((const float*)(c.ws + WS_MPREV))[(size_t)(wid * NCHUNK + chunk) * 4 + head]; }
    u32x4 qr[4], kr[4], vr[4], sbr[5], sfr[5];
#pragma unroll
    for (int i = 0; i < 4; ++i) { const int idx = tid + 512 * i, r = idx >> 4, ch = idx & 15; const size_t go = (size_t)(t0 + r) * 512 + head * 128 + ch * 8; qr[i] = *(const u32x4*)(MQ + go); kr[i] = *(const u32x4*)(MK + go); }
#pragma unroll
    for (int i = 0; i < 4; ++i) { const int idx = tid + 512 * i, s = idx & 127, ch = idx >> 7; vr[i] = *(const u32x4*)(MV + (size_t)(t0 + s) * 512 + head * 128 + ch * 8); }
#pragma unroll
    for (int i = 0; i < 5; ++i) { int idx = tid + 512 * i; idx = idx < 2304 ? idx : 2303; const int r = idx >> 4, ch = idx & 15, rc = r < 129 ? r : 128;
        sbr[i] = *(const u32x4*)(CSTB + rc * 128 + ch * 8); sfr[i] = *(const u32x4*)(CSTF + rc * 128 + ch * 8); }
#pragma unroll
    for (int i = 0; i < 4; ++i) { const int idx = tid + 512 * i, r = idx >> 4, ch = idx & 15; *(LAS u32x4*)(LQ + r * 272 + ch * 16) = qr[i]; *(LAS u32x4*)(LK + r * 272 + ch * 16) = kr[i]; }
#pragma unroll
    for (int i = 0; i < 4; ++i) { const int idx = tid + 512 * i, s = idx & 127, ch = idx >> 7; const u32x4 v8 = vr[i];
#pragma unroll
        for (int e = 0; e < 8; ++e) { const unsigned vw = v8[e >> 1]; LVT[(8 * ch + e) * 136 + s] = (bf16_t)((e & 1) ? (vw >> 16) : (vw & 0xffffu)); } }
#pragma unroll
    for (int i = 0; i < 5; ++i) { int idx = tid + 512 * i; idx = idx < 2304 ? idx : 2303; const int r = idx >> 4, ch = idx & 15;
        *(LAS u32x4*)(LSB + r * 272 + ch * 16) = r < 129 ? sbr[i] : (u32x4){0u, 0u, 0u, 0u}; }
    if (wid < 2) { const int d = wid; const ChunkVec v = chunk_vectors_from(cgq, lane);
        const float mp = mp_early;
        LAS float* vd = vec + d * 512; const float M0 = fmaxf(mp, v.cm0), M1 = fmaxf(mp, v.cm1);
        constexpr float L2E = 1.4426950408889634f;
        vd[v.s0] = v.g0 * L2E; vd[128 + v.s0] = M0 * L2E; vd[256 + v.s0] = __expf(-(v.b0 + M0)); vd[384 + v.s0] = __expf(mp - M0);
        vd[v.s1] = v.g1 * L2E; vd[128 + v.s1] = M1 * L2E; vd[256 + v.s1] = __expf(-(v.b1 + M1)); vd[384 + v.s1] = __expf(mp - M1); }
    __syncthreads();
    const int trow = 16 * wid + fr;
    bf16x8 Xq[4];
#pragma unroll
    for (int ks = 0; ks < 4; ++ks) Xq[ks] = *(LAS const bf16x8*)(LQ + trow * 272 + (32 * ks + 8 * fq) * 2);
    f32x4 S[8];
#pragma unroll
    for (int n = 0; n < 8; ++n) { S[n] = (f32x4){0.f, 0.f, 0.f, 0.f};
#pragma unroll
        for (int ks = 0; ks < 4; ++ks) { const bf16x8 Yk = *(LAS const bf16x8*)(LK + (16 * n + fr) * 272 + (32 * ks + 8 * fq) * 2); S[n] = MFMA16(Yk, Xq[ks], S[n]); } }
    __syncthreads();
#pragma unroll
    for (int i = 0; i < 5; ++i) { int idx = tid + 512 * i; idx = idx < 2304 ? idx : 2303; const int r = idx >> 4, ch = idx & 15;
        *(LAS u32x4*)(LK + r * 272 + ch * 16) = r < 129 ? sfr[i] : (u32x4){0u, 0u, 0u, 0u}; }
    __syncthreads();
    f32x4 hs[8];
    dir_pass<0>(S, Xq, LK, LVTb, vec, trow, fr, fq, hs);
    dir_pass<1>(S, Xq, LSB, LVTb, vec + 512, trow, fr, fq, hs);
    float sum = 0.f;
#pragma unroll
    for (int nt = 0; nt < 8; ++nt) sum += (hs[nt][0] + hs[nt][1]) + (hs[nt][2] + hs[nt][3]);
    sum += __shfl_xor(sum, 16); sum += __shfl_xor(sum, 32);
    const float mean = sum * (1.f / 128.f); float var = 0.f;
#pragma unroll
    for (int nt = 0; nt < 8; ++nt) { hs[nt] -= mean; var += (hs[nt][0] * hs[nt][0] + hs[nt][1] * hs[nt][1]) + (hs[nt][2] * hs[nt][2] + hs[nt][3] * hs[nt][3]); }
    var += __shfl_xor(var, 16); var += __shfl_xor(var, 32);
    const float rstd = __builtin_amdgcn_rsqf(var * (1.f / 128.f) + EPS);
    const float* nw = c.in[6] + head * 128; bf16_t* mop = MO + (size_t)(t0 + trow) * 512 + head * 128;
#pragma unroll
    for (int nt = 0; nt < 8; ++nt) { const int v = 16 * nt + 4 * fq; const u32x2 mo4 = *(const u32x2*)(mop + v); const f32x4 w4 = *(const f32x4*)(nw + v);
        const float o0 = hs[nt][0] * rstd * w4[0] * sigmoidf_(bflo(mo4.x)), o1 = hs[nt][1] * rstd * w4[1] * sigmoidf_(bfhi(mo4.x));
        const float o2 = hs[nt][2] * rstd * w4[2] * sigmoidf_(bflo(mo4.y)), o3 = hs[nt][3] * rstd * w4[3] * sigmoidf_(bfhi(mo4.y));
        u32x2 w; w.x = pk2(o0, o1); w.y = pk2(o2, o3); *(u32x2*)((bf16_t*)(c.ws + WS_HMOA) + (size_t)(t0 + trow) * 1024 + head * 128 + v) = w; }
    __syncthreads();
}

struct Args { const float* in[17]; float* out; unsigned char* ws; int ph_lo, ph_hi; };
constexpr int NPHASE = 9;

__global__ void __launch_bounds__(512, 2) mega(Args args) {
    extern __shared__ __attribute__((aligned(16))) unsigned char lds_raw[];
    LAS unsigned char* lds = (LAS unsigned char*)lds_raw;
    cg::grid_group grid = cg::this_grid();
    const int tid = threadIdx.x, lane = tid & 63, wid = __builtin_amdgcn_readfirstlane(tid >> 6);
    const int G = gridDim.x, gw = blockIdx.x * 8 + wid, NGW = G * 8;
    Ctx c;
#pragma unroll
    for (int i = 0; i < 17; ++i) c.in[i] = args.in[i];
    c.out = args.out; c.ws = args.ws;
    unsigned char* ws = args.ws;
    const int lo = args.ph_lo, hi = args.ph_hi;
#ifndef PH_MASK
#define PH_MASK 0x3ff
#endif
#define IN(k) (((PH_MASK >> (k)) & 1) && lo <= (k) && (k) < hi)
#define REP(k) for (int rep_ = 0; rep_ < (((DUP_MASK >> (k)) & 1) ? 2 : 1); ++rep_)
#define SEAM(k) do { if (IN(k) && IN((k) + 1)) grid.sync(); } while (0)

    REP(0) if (IN(0)) {
        LAS float* scr = (LAS float*)(lds + wid * 16384);
        for (int i = blockIdx.x * 512 + tid; i < 320 * 64; i += G * 512) ((unsigned*)(ws + WS_CTL))[i] = 0u;
        constexpr int I_W1 = 160 * 16, I_PM = 32 * 8, I_PA = 32 * 8, I_WO = 32 * 16, I_UP = 176 * 16, I_WD = 32 * 44;
        constexpr int NITEMS = I_W1 + I_PM + I_PA + I_WO + I_UP + I_WD;
        for (int it = gw; it < NITEMS; it += NGW) {
            int r = it;
            if (r < I_W1) { const int nb = r >> 4, kb = r & 15, dr = 32 * nb, sc = dr < 2048 ? dr : dr + 16;
                const float ns = (dr >= 512 && dr < 1024) ? 0.08838834764831845f : ((dr >= 2048 && dr < 2560) ? 0.18033688011112042f   : 1.f);
                transpose_item(c.in[3], DIN, sc, 64 * kb, (bf16_t*)(ws + WS_W1), 1024, dr, c.in[2], ns, scr, lane); continue; } r -= I_W1;
            if (r < I_PM) { const int nb = r >> 3, kb = r & 7; transpose_item(c.in[8], 1024, 32 * nb, 64 * kb, (bf16_t*)(ws + WS_W1) + (size_t)5120 * 1024, 1024, 32 * nb, nullptr, 1.f, scr, lane); continue; } r -= I_PM;
            if (r < I_PA) { const int nb = r >> 3, kb = r & 7; transpose_item(c.in[9], 1024, 32 * nb, 64 * kb, (bf16_t*)(ws + WS_W1) + (size_t)5120 * 1024 + 512, 1024, 32 * nb, nullptr, 1.f, scr, lane); continue; } r -= I_PA;
            if (r < I_WO) { const int nb = r >> 4, kb = r & 15; transpose_item(c.in[10], 1024, 32 * nb, 64 * kb, (bf16_t*)(ws + WS_WO), 1024, 32 * nb, nullptr, 1.f, scr, lane); continue; } r -= I_WO;
            if (r < I_UP) { const int nb = r >> 4, kb = r & 15, sc = 32 * nb; const int half = sc >= DFF ? 1 : 0, ch = sc - half * DFF; const int dr = 256 * (ch >> 7) + 128 * half + (ch & 127);
                transpose_item(c.in[12], NUP, sc, 64 * kb, (bf16_t*)(ws + WS_WUP), 1024, dr, c.in[11], 1.f, scr, lane); continue; } r -= I_UP;
            { const int nb = r / 44, kb = r - nb * 44; transpose_item(c.in[15], 1024, 32 * nb, 64 * kb, (bf16_t*)(ws + WS_WD), DFF, 32 * nb, nullptr, 1.f, scr, lane); }
        }
        {
            float* rope = (float*)(ws + WS_ROPE);
            for (int i = blockIdx.x * 512 + tid; i < 16384 * 8; i += G * 512) { const int pos = i >> 3, d = i & 7;
                const float invf = d == 0 ? 1.0f : d == 1 ? 0.1939227432012558f : d == 2 ? 0.03760603070259094f : d == 3 ? 0.007292664609849453f : d == 4 ? 0.0014142135623842478f
                                 : d == 5 ? 0.00027424818836152554f : d == 6 ? 5.3182957344688475e-05f : 1.0313385246263351e-05f;
                const float ang = (float)pos * invf; const float k = rintf(ang * 0.15915494309189535f);
                float rr = fmaf(-k, 6.2831854820251465f, ang); rr = fmaf(-k, -1.7484556025237907e-07f, rr);
                rope[pos * 16 + d] = cosf(rr); rope[pos * 16 + 8 + d] = sinf(rr); }
        }
        __syncthreads();
        LAS float* wg = (LAS float*)lds;
        for (int i = tid; i < 16384; i += 512) { const int k = i >> 4, j = i & 15; wg[j * 1024 + k] = c.in[2][k] * c.in[3][(size_t)k * DIN + 2048 + j]; }
        __syncthreads();
        bf16_t* XN = (bf16_t*)(ws + WS_XN); float* gates = (float*)(ws + WS_GATES);
        const float bias = (lane >> 2) < 8 ? c.in[4][lane >> 2] : c.in[5][(lane >> 2) - 8];
        f32x4 va[4], vb[4];
        { const int r0 = gw * 2 < MTOK ? gw * 2 : 0; const f32x4* xa = (const f32x4*)xrow_ptr(c.in[0], c.in[1], r0) + lane; const f32x4* xb = (const f32x4*)xrow_ptr(c.in[0], c.in[1], r0 + 1) + lane;
#pragma unroll
          for (int j = 0; j < 4; ++j) { va[j] = xa[64 * j]; vb[j] = xb[64 * j]; } }
        for (int r0 = gw * 2; r0 < MTOK; r0 += NGW * 2) {
            f32x4 na[4], nb[4];
            { const int rn = r0 + NGW * 2 < MTOK ? r0 + NGW * 2 : r0; const f32x4* xa = (const f32x4*)xrow_ptr(c.in[0], c.in[1], rn) + lane; const f32x4* xb = (const f32x4*)xrow_ptr(c.in[0], c.in[1], rn + 1) + lane;
#pragma unroll
              for (int j = 0; j < 4; ++j) { na[j] = xa[64 * j]; nb[j] = xb[64 * j]; } }
            float sa = 0.f, sb = 0.f;
#pragma unroll
            for (int j = 0; j < 4; ++j) {
                sa += (va[j][0] * va[j][0] + va[j][1] * va[j][1]) + (va[j][2] * va[j][2] + va[j][3] * va[j][3]); sb += (vb[j][0] * vb[j][0] + vb[j][1] * vb[j][1]) + (vb[j][2] * vb[j][2] + vb[j][3] * vb[j][3]); }
            const float rsa = 1.f / sqrtf(wave_sum(sa) * (1.f / DM) + EPS), rsb = 1.f / sqrtf(wave_sum(sb) * (1.f / DM) + EPS);
            float pa[16], pb[16];
#pragma unroll
            for (int g = 0; g < 16; ++g) { float qa = 0.f, qb = 0.f;
#pragma unroll
                for (int j = 0; j < 4; ++j) { const f32x4 w = *(LAS const f32x4*)(wg + g * 1024 + 256 * j + 4 * lane);
                    qa += (va[j][0] * w[0] + va[j][1] * w[1]) + (va[j][2] * w[2] + va[j][3] * w[3]); qb += (vb[j][0] * w[0] + vb[j][1] * w[1]) + (vb[j][2] * w[2] + vb[j][3] * w[3]); }
                pa[g] = qa; pb[g] = qb; asm volatile("" ::: "memory"); }
            const float ga_ = reduce16(pa, lane), gb_ = reduce16(pb, lane);
            if ((lane & 3) == 0) { gates[(size_t)r0 * 16 + (lane >> 2)] = rsa * ga_ + bias; gates[(size_t)(r0 + 1) * 16 + (lane >> 2)] = rsb * gb_ + bias; }
            unsigned long long* oa = (unsigned long long*)(XN + (size_t)r0 * DM) + lane; unsigned long long* ob = (unsigned long long*)(XN + (size_t)(r0 + 1) * DM) + lane;
#pragma unroll
            for (int j = 0; j < 4; ++j) {
                oa[64 * j] = (unsigned long long)pk2(va[j][0] * rsa, va[j][1] * rsa) | ((unsigned long long)pk2(va[j][2] * rsa, va[j][3] * rsa) << 32);
                ob[64 * j] = (unsigned long long)pk2(vb[j][0] * rsb, vb[j][1] * rsb) | ((unsigned long long)pk2(vb[j][2] * rsb, vb[j][3] * rsb) << 32); }
#pragma unroll
            for (int j = 0; j < 4; ++j) { va[j] = na[j]; vb[j] = nb[j]; }
        }
        __syncthreads();
    }
    SEAM(0);

    if (IN(1)) {
        pg8::Gemm g{(const bf16_t*)(ws + WS_XN), (const bf16_t*)(ws + WS_W1), nullptr, nullptr, 1024};
        pg8::DupOrder S; S.s.init(MTOK / 256, 12, G, (int)blockIdx.x); S.dup = (DUP_MASK >> 1) & 1;
        pg8::EpiProj E{ws};
        pg8::gemm_phase<pg8::EpiProj, pg8::DupOrder, true, false>(lds, g, S, E);
    }
    SEAM(1);

    if (IN(2)) {
        constexpr int NSU = NCHUNK * 4, NAU = (NCHUNK / 2) * 4;
        for (int it0 = blockIdx.x; it0 < (((DUP_MASK >> 2) & 1) ? 2 : 1) * (NSU + NAU); it0 += G) { const int it = it0 >= NSU + NAU ? it0 - (NSU + NAU) : it0;
            if (it < NSU) summary_unit(lds, c, it >> 2, it & 3, tid, lane, wid);
            else { const int a = it - NSU; attn_unit(lds, c, a >> 2, a & 3, tid, lane, wid); }
        }
    }
    SEAM(2);

    REP(3) if (IN(3)) {
        constexpr int NPI = 8 * 33, NSI = 128 * 33;
        if (NGW > 2 * NPI) {
            if (gw < NPI) scan_item(c, gw / 33, gw % 33, lane);
            else { const int stride = NGW - NPI; for (int j = gw - NPI; j < NSI; j += stride) scan_item(c, 8 + j / 33, j % 33, lane); }
        } else {
            for (int j = gw; j < NPI + NSI; j += NGW) scan_item(c, j / 33, j % 33, lane);
        }
    }
    SEAM(3);

    REP(4) if (IN(4)) {
        for (int it = blockIdx.x; it < NCHUNK * 4; it += G) mlstm_out_unit(lds, c, it >> 2, it & 3, tid, lane, wid);
    }
    SEAM(4);

    if (IN(5)) {
        const bf16_t* W1t = (const bf16_t*)(ws + WS_W1);
        pg8::Gemm gg{(const bf16_t*)(ws + WS_XN), W1t + (size_t)3072 * 1024, (const bf16_t*)(ws + WS_XN), W1t + (size_t)4096 * 1024, 1024, 0};
        pg8::Gemm gx{(const bf16_t*)(ws + WS_HMOA), W1t + (size_t)5120 * 1024, (const bf16_t*)(ws + WS_HMOA) + 512, W1t + (size_t)5120 * 1024 + 512, 1024, 8};
        pg8::StaticOrder SO; SO.init(MTOK / 256, DM / 256, G, (int)blockIdx.x);
        pg8::EpiGate EG{ws + WS_QSCR}; pg8::EpiMix EM{(bf16_t*)(ws + WS_Y), ws + WS_QSCR};
        pg8::Unit tu;
        for (int k = 0; SO.next(k, tu); ++k) {
            pg8::TileOrder T{tu.pm, tu.pn};
            pg8::gemm_phase<pg8::EpiGate, pg8::TileOrder, true, false>(lds, gg, T, EG);
            pg8::gemm_phase<pg8::EpiMix, pg8::TileOrder, true, false>(lds, gx, T, EM);
        }
    }
    SEAM(5);

    if (IN(6)) {
        pg8::Gemm g{(const bf16_t*)(ws + WS_Y), (const bf16_t*)(ws + WS_WO), nullptr, nullptr, 1024};
        pg8::DupOrder S; S.s.init(MTOK / 256, DM / 256, G, (int)blockIdx.x); S.dup = (DUP_MASK >> 6) & 1;
        pg8::EpiRes<true> E{c.in[0], c.in[1], c.out, (bf16_t*)(ws + WS_HN), (float*)(ws + WS_SS)};
        pg8::gemm_phase<pg8::EpiRes<true>, pg8::DupOrder, true, false>(lds, g, S, E);
    }
    SEAM(6);

    if (IN(7)) {
        pg8::Gemm g{(const bf16_t*)(ws + WS_HN), (const bf16_t*)(ws + WS_WUP), nullptr, nullptr, 1024};
        pg8::DupOrder S; S.s.init(323, NUP / 256, G, (int)blockIdx.x); S.dup = (DUP_MASK >> 7) & 1;
        pg8::EpiConv E{(bf16_t*)(ws + WS_G), (const float*)(ws + WS_SS), c.in[13], c.in[14], (LAS float*)(lds + 131072)};
        pg8::gemm_phase<pg8::EpiConv, pg8::DupOrder, true, true>(lds, g, S, E);
    }
    SEAM(7);

    if (IN(8)) {
        pg8::Gemm g{(const bf16_t*)(ws + WS_G), (const bf16_t*)(ws + WS_WD), nullptr, nullptr, DFF};
        pg8::StaticOrder S; S.init(MTOK / 256, DM / 256, G, (int)blockIdx.x);
        pg8::EpiFinal E{c.out, (const bf16_t*)(ws + WS_HN), c.in[16], (unsigned*)(ws + WS_SS), (unsigned*)(ws + WS_CTL)};
        pg8::gemm_phase<pg8::EpiFinal, pg8::StaticOrder, true, false>(lds, g, S, E);
    }
#undef IN
#undef SEAM
}

extern "C" void kernel_launch(void* const* d_in, const int* in_sizes, int n_in, void* d_out, int out_size, void* d_ws, size_t ws_size, hipStream_t stream) {
    static int grid = 0;
    if (grid == 0) {
        if (n_in != 17 || out_size != MTOK * DM || ws_size < WS_END2) { fprintf(stderr, "kernel_launch: unexpected problem (n_in %d out %d ws %zu)\n", n_in, out_size, ws_size); grid = -1; return; }
        int dev = 0, cus = 0, per_cu = 0;
        if (hipGetDevice(&dev) != hipSuccess || hipDeviceGetAttribute(&cus, hipDeviceAttributeMultiprocessorCount, dev) != hipSuccess) { grid = -1; return; }
        if (hipFuncSetAttribute((const void*)mega, hipFuncAttributeMaxDynamicSharedMemorySize, LDS_BYTES) != hipSuccess) { fprintf(stderr, "kernel_launch: hipFuncSetAttribute failed\n"); grid = -1; return; }
        if (hipOccupancyMaxActiveBlocksPerMultiprocessor(&per_cu, (const void*)mega, 512, LDS_BYTES) != hipSuccess || per_cu < 1) { fprintf(stderr, "kernel_launch: occupancy query says %d\n", per_cu); per_cu = 1; }
        (void)hipGetLastError();
        grid = cus * per_cu;
    }
    if (grid < 0) return;
    Args a{};
    for (int i = 0; i < 17; ++i) a.in[i] = (const float*)d_in[i];
    a.out = (float*)d_out; a.ws = (unsigned char*)d_ws;
#if MK_SINGLE
    a.ph_lo = 0; a.ph_hi = NPHASE;
    void* kargs[] = {&a};
    hipError_t e = hipLaunchCooperativeKernel((const void*)mega, dim3(grid), dim3(512), kargs, LDS_BYTES, stream);
    if (e != hipSuccess) fprintf(stderr, "cooperative launch failed: %s (grid %d)\n", hipGetErrorString(e), grid);
#else
    for (int p = 0; p < NPHASE; ++p) { a.ph_lo = p; a.ph_hi = p + 1; hipLaunchKernelGGL(mega, dim3(grid), dim3(512), LDS_BYTES, stream, a); }
#endif
}
```

```cpp
#include <hip/hip_runtime.h>
#include <hip/hip_cooperative_groups.h>
#include <cstdio>
#include <cstdint>
namespace cg = cooperative_groups;

#ifndef DUP_MASK
#define DUP_MASK 0
#endif
#ifndef MK_SINGLE
#define MK_SINGLE 1
#endif

#define LAS __attribute__((address_space(3)))
#define DI __device__ __forceinline__
typedef unsigned short bf16_t;
typedef short bf16x8 __attribute__((ext_vector_type(8)));
typedef short s16x4 __attribute__((ext_vector_type(4)));
typedef float f32x4 __attribute__((ext_vector_type(4)));
typedef unsigned u32x4 __attribute__((ext_vector_type(4)));
typedef unsigned u32x2 __attribute__((ext_vector_type(2)));

constexpr int MTOK = 81920, DM = 1024, NPROJ = 5120, DIN = 5136, DFF = 2816, NUP = 5632;
constexpr int NCHUNK = 640, PROMPT = 16384;
constexpr float EPS = 1e-6f;
constexpr int ST_ELEMS = 129 * 128;
constexpr size_t ST_BYTES = (size_t)ST_ELEMS * 2;

constexpr size_t MiB = 1u << 20;
constexpr size_t WS_CTL = 0;
constexpr size_t WS_W1 = 2 * MiB, WS_WPM = 13 * MiB, WS_WPA = 14 * MiB, WS_WO = 15 * MiB, WS_WUP = 17 * MiB, WS_WD = 28 * MiB;
constexpr size_t WS_ROPE = 34 * MiB, WS_GATES = 35 * MiB, WS_SS = 40 * MiB, WS_CHSC = 46 * MiB, WS_MPREV = 47 * MiB;
constexpr size_t WS_MQ = 64 * MiB, WS_MK = 144 * MiB, WS_MV = 224 * MiB, WS_MO = 304 * MiB, WS_AQ = 384 * MiB, WS_AK = 464 * MiB, WS_AV = 504 * MiB,
                 WS_GM = 544 * MiB, WS_GA = 704 * MiB, WS_END = 864 * MiB;
constexpr size_t WS_Y = 64 * MiB, WS_HN = 224 * MiB, WS_G = 384 * MiB;
constexpr size_t WS_OA = 864 * MiB, WS_HM = 944 * MiB, WS_END2 = 1024 * MiB;
constexpr size_t OUT_CST = 0;
constexpr size_t WS_XN = WS_GM, WS_QSCR = WS_GA;
constexpr size_t WS_HMOA = 864 * MiB;
constexpr int LDS_BYTES = 152064;

typedef __bf16 bf16n2 __attribute__((ext_vector_type(2)));
typedef float f32n2 __attribute__((ext_vector_type(2)));
DI unsigned pk2(float lo, float hi) { const f32n2 v = {lo, hi}; return __builtin_bit_cast(unsigned, __builtin_convertvector(v, bf16n2)); }
DI unsigned f2bf(float f) { return pk2(f, f) & 0xffffu; }
DI float bflo(unsigned w) { return __uint_as_float(w << 16); }
DI float bfhi(unsigned w) { return __uint_as_float(w & 0xffff0000u); }
DI unsigned cvt_pk_bf16_asm(float lo, float hi) { unsigned r; asm volatile("v_cvt_pk_bf16_f32 %0, %1, %2" : "=v"(r) : "v"(lo), "v"(hi)); return r; }
DI unsigned cvt_pk_bf16(float lo, float hi) { return pk2(lo, hi); }
DI float wave_sum(float v) {
#pragma unroll
    for (int o = 1; o < 64; o <<= 1) v += __shfl_xor(v, o);
    return v;
}
DI float sigmoidf_(float x) { return __builtin_amdgcn_rcpf(1.f + __expf(-x)); }
DI float logsigmoid_(float x) { return x >= 0.f ? -log1pf(expf(-x)) : x - log1pf(expf(x)); }
#define MFMA16(a, b, c) __builtin_amdgcn_mfma_f32_16x16x32_bf16((a), (b), (c), 0, 0, 0)
DI bf16x8 pack8(const float (&p)[8]) {
    u32x4 w; w.x = pk2(p[0], p[1]); w.y = pk2(p[2], p[3]); w.z = pk2(p[4], p[5]); w.w = pk2(p[6], p[7]);
    return __builtin_bit_cast(bf16x8, w);
}
DI const float* xrow_ptr(const float* xp, const float* xs, int t) { return t < PROMPT ? xp + (size_t)t * DM : xs + (size_t)(t - PROMPT) * DM; }
DI bool seq_start(int t) { return t == 0 || (t >= PROMPT && (t & 4095) == 0); }

namespace pg8 {
constexpr int BM = 256, BK = 64, HALF = 128, HTB = HALF * BK * 2, STAGE_BYTES = 8 * HTB, NXCD = 8, WGM = 8;
DI int lds_byte(int r, int c) { const int st = (r >> 4) * 2 + (c >> 5), rr = r & 15, cc = c & 31, ob = rr * 64 + cc * 2; return st * 1024 + (ob ^ (((ob >> 9) & 1) << 5)); }
DI void stage_rc(int b, int& R, int& C) { const int st = b / 1024, sb = b % 1024, swz = sb ^ (((sb >> 9) & 1) << 5); R = (st >> 1) * 16 + swz / 64; C = (st & 1) * 32 + (swz % 64) / 2; }
DI int perm32(int rho) { const int n = rho >> 4, i = rho & 15; return 8 * (i >> 2) + 4 * n + (i & 3); }

struct Unit { int pm, pn, sel; };
struct Gemm { const bf16_t* A; const bf16_t* Bt; const bf16_t* A2; const bf16_t* Bt2; int K; int ntk = 0; };

struct StaticOrder {
    int nM, nN, nwg, G, c;
    DI void init(int nM_, int nN_, int G_, int c_) { nM = nM_; nN = nN_; nwg = nM * nN; G = G_; c = c_; }
    DI bool next(int i, Unit& u) const {
        const long L = (long)i * G + c; if (L >= nwg) return false;
        int wgid = (int)L; { const int q = nwg / NXCD, r = nwg % NXCD, xcd = wgid % NXCD, off = wgid / NXCD; wgid = (xcd < r ? xcd * (q + 1) : r * (q + 1) + (xcd - r) * q) + off; }
        const int nig = WGM * nN, gid = wgid / nig, fm = gid * WGM, gsz = (nM - fm) < WGM ? (nM - fm) : WGM;
        u.pm = fm + ((wgid % nig) % gsz); u.pn = (wgid % nig) / gsz; u.sel = 0; return true;
    }
};
struct DupOrder { StaticOrder s; int dup; DI bool next(int i, Unit& u) const { return s.next(dup ? (i >> 1) : i, u); } };
struct TileOrder { int pm, pn; DI bool next(int i, Unit& u) const { if (i >= 2) return false; u.pm = pm; u.pn = pn; u.sel = i; return true; } };
struct PairOrder {
    StaticOrder s;
    DI bool next(int i, Unit& u) const { if (!s.next(i >> 1, u)) return false; u.sel = i & 1; return true; }
};

template <class Epi, class Sched, bool ALIGN_EPI, bool CONVA>
DI void gemm_phase(LAS unsigned char* lds, const Gemm g, const Sched& S, const Epi& E) {
    const int tid = threadIdx.x, wid = __builtin_amdgcn_readfirstlane(tid >> 6), lane = tid & 63, wr = wid >> 2, wc = wid & 3, fr = lane & 15, fq = lane >> 4;
    const int K = g.K; const int nt = g.ntk ? g.ntk : K / BK;
    unsigned voffA[2], voffB[2];
#pragma unroll
    for (int i = 0; i < 2; ++i) { int R, C; stage_rc(tid * 16 + i * 8192, R, C); const int Rb = Epi::PERM ? ((R & ~31) + perm32(R & 31)) : R;
        const int Ra = CONVA ? (128 * (R >> 6) + 8 * (R & 15) + ((R >> 4) & 3)) : R;
        voffA[i] = (unsigned)(Ra * K + C) * 2u; voffB[i] = (unsigned)(Rb * K + C) * 2u; }
    const size_t kstep = (size_t)(BK * 2);
    const size_t hstepB = (size_t)HALF * K * 2, tstepB = 2 * hstepB;
    const size_t hstepA = CONVA ? (size_t)4 * K * 2 : hstepB, tstepA = CONVA ? (size_t)254 * K * 2 : tstepB;
    const long abias = CONVA ? -(long)K * 2 : 0;
    const unsigned ldsw = (unsigned)wid * 1024u;
    const int aoff = lds_byte(wr * 64 + fr, fq * 8), boff = lds_byte(wc * 32 + fr, fq * 8);
#define PG8_SA(b, h) (((b) * 2 + (h)) * HTB)
#define PG8_SB(b, h) ((4 + (b) * 2 + (h)) * HTB)
#define PG8_STAGE(bufoff, gbase, voff) do { _Pragma("unroll") for (int _i = 0; _i < 2; ++_i) \
        __builtin_amdgcn_global_load_lds((const unsigned*)((const char*)(gbase) + (voff)[_i]), (LAS unsigned*)(lds + (bufoff) + ldsw + _i * 8192), 16, 0, 0); } while (0)
#define PG8_LDA(dst, b, h) do { _Pragma("unroll") for (int m = 0; m < 4; ++m) _Pragma("unroll") for (int k = 0; k < 2; ++k) dst[m][k] = *(const LAS bf16x8*)(lds + PG8_SA(b, h) + aoff + m * 2048 + k * 1024); } while (0)
#define PG8_LDB(dst, b, h) do { _Pragma("unroll") for (int n = 0; n < 2; ++n) _Pragma("unroll") for (int k = 0; k < 2; ++k) dst[n][k] = *(const LAS bf16x8*)(lds + PG8_SB(b, h) + boff + n * 2048 + k * 1024); } while (0)
#define PG8_MMA(ai, bj, At, Bt) do { __builtin_amdgcn_s_setprio(1); _Pragma("unroll") for (int m = 0; m < 4; ++m) _Pragma("unroll") for (int n = 0; n < 2; ++n) _Pragma("unroll") for (int k = 0; k < 2; ++k) \
        acc[ai][bj][m][n] = __builtin_amdgcn_mfma_f32_16x16x32_bf16(Bt[n][k], At[m][k], acc[ai][bj][m][n], 0, 0, 0); __builtin_amdgcn_s_setprio(0); } while (0)
#define PG8_WAIT_V(n) asm volatile("s_waitcnt vmcnt(" #n ")" ::: "memory")
#define PG8_WAIT_L(n) asm volatile("s_waitcnt lgkmcnt(" #n ")" ::: "memory")
#define PG8_WAIT_VN(n) asm volatile("s_waitcnt vmcnt(%0)" :: "n"(n) : "memory")
#define PG8_BAR __builtin_amdgcn_s_barrier()
#define PG8_SCHED __builtin_amdgcn_sched_barrier(0)
    Unit cur, nxt; int ui = 0;
    if (!S.next(0, cur)) return;
    f32x4 acc[2][2][4][2];
#pragma unroll
    for (int a = 0; a < 2; ++a)
#pragma unroll
        for (int b = 0; b < 2; ++b)
#pragma unroll
            for (int m = 0; m < 4; ++m)
#pragma unroll
                for (int n = 0; n < 2; ++n) acc[a][b][m][n] = (f32x4){0.f, 0.f, 0.f, 0.f};
    bf16x8 At[4][2], B0[2][2], B1[2][2];
    const char* cA = (const char*)(cur.sel ? g.A2 : g.A) + (size_t)cur.pm * tstepA + abias; const char* cB = (const char*)(cur.sel ? g.Bt2 : g.Bt) + (size_t)cur.pn * tstepB;
    PG8_STAGE(PG8_SB(0, 0), cB, voffB); PG8_STAGE(PG8_SB(0, 1), cB + hstepB, voffB); PG8_STAGE(PG8_SA(0, 0), cA, voffA); PG8_STAGE(PG8_SA(0, 1), cA + hstepA, voffA);
    if (wr == 1) PG8_BAR;
    PG8_WAIT_V(2); PG8_BAR;
    PG8_STAGE(PG8_SB(1, 0), cB + kstep, voffB); PG8_STAGE(PG8_SA(1, 0), cA + kstep, voffA); PG8_STAGE(PG8_SB(1, 1), cB + hstepB + kstep, voffB);
    PG8_WAIT_V(6); PG8_BAR;
    for (;;) {
        const bool has_next = S.next(ui + 1, nxt);
        const char* nA = has_next ? (const char*)(nxt.sel ? g.A2 : g.A) + (size_t)nxt.pm * tstepA + abias : cA;
        const char* nB = has_next ? (const char*)(nxt.sel ? g.Bt2 : g.Bt) + (size_t)nxt.pn * tstepB : cB;
#define PG8_KBODY(W12) do { \
            PG8_LDB(B0, 0, 0); PG8_LDB(B1, 0, 1); PG8_SCHED; PG8_LDA(At, 0, 0); PG8_STAGE(PG8_SA(1, 1), a1 + hstepA, voffA); \
            W12; PG8_WAIT_L(0); PG8_BAR; PG8_MMA(0, 0, At, B0); PG8_MMA(0, 1, At, B1); PG8_BAR; PG8_SCHED; \
            PG8_LDA(At, 0, 1); PG8_STAGE(PG8_SB(0, 0), b2, voffB); PG8_STAGE(PG8_SB(0, 1), b2 + hstepB, voffB); PG8_STAGE(PG8_SA(0, 0), a2, voffA); \
            W12; PG8_WAIT_L(0); PG8_BAR; PG8_MMA(1, 0, At, B0); PG8_MMA(1, 1, At, B1); PG8_BAR; PG8_SCHED; \
            PG8_LDB(B0, 1, 0); PG8_LDB(B1, 1, 1); PG8_SCHED; PG8_LDA(At, 1, 0); PG8_STAGE(PG8_SA(0, 1), a2 + hstepA, voffA); \
            PG8_WAIT_V(8); PG8_WAIT_L(0); PG8_BAR; PG8_MMA(0, 0, At, B0); PG8_MMA(0, 1, At, B1); PG8_BAR; PG8_SCHED; \
            PG8_LDA(At, 1, 1); PG8_STAGE(PG8_SB(1, 0), b3, voffB); PG8_STAGE(PG8_SB(1, 1), b3 + hstepB, voffB); PG8_STAGE(PG8_SA(1, 0), a3, voffA); \
            PG8_WAIT_V(8); PG8_WAIT_L(0); PG8_BAR; PG8_MMA(1, 0, At, B0); PG8_MMA(1, 1, At, B1); PG8_BAR; PG8_SCHED; } while (0)
        for (int t = 0; t < nt; t += 2) {
            const bool last = (t == nt - 2);
            const char* a1 = cA + (size_t)(t + 1) * kstep;
            const char* a2 = last ? nA : cA + (size_t)(t + 2) * kstep; const char* b2 = last ? nB : cB + (size_t)(t + 2) * kstep;
            const char* a3 = a2 + kstep; const char* b3 = b2 + kstep;
            PG8_KBODY(PG8_WAIT_V(8));
        }
#undef PG8_KBODY
        if constexpr (ALIGN_EPI) { if (wr == 0) PG8_BAR; }
        E(acc, cur, wr, wc, fr, fq);
        if (!has_next) break;
        if (!E.keep(cur)) {
#pragma unroll
            for (int a = 0; a < 2; ++a)
#pragma unroll
                for (int b = 0; b < 2; ++b)
#pragma unroll
                    for (int m = 0; m < 4; ++m)
#pragma unroll
                        for (int n = 0; n < 2; ++n) acc[a][b][m][n] = (f32x4){0.f, 0.f, 0.f, 0.f};
        }
        cur = nxt; cA = nA; cB = nB; ++ui;
        if constexpr (ALIGN_EPI) { if (wr == 1) PG8_BAR; }
    }
    PG8_WAIT_V(0);
    if constexpr (!ALIGN_EPI) { if (wr == 0) PG8_BAR; }
    PG8_BAR;
#undef PG8_SA
#undef PG8_SB
#undef PG8_STAGE
#undef PG8_LDA
#undef PG8_LDB
#undef PG8_MMA
#undef PG8_WAIT_V
#undef PG8_WAIT_L
#undef PG8_WAIT_VN
#undef PG8_BAR
#undef PG8_SCHED
}

struct EpiProj {
    static constexpr bool PERM = true; static constexpr int NVM = 16;
    unsigned char* ws;
    DI bool keep(const Unit&) const { return false; }
    DI void operator()(f32x4 (&acc)[2][2][4][2], const Unit& u, int wr, int wc, int fr, int fq) const {
        const int ct = u.pn; bf16_t* base; int ldc, colt;
        if (ct < 8) { base = (bf16_t*)(ws + WS_MQ + (size_t)(ct >> 1) * (80 * MiB)); ldc = 512; colt = (ct & 1) * 256; }
        else if (ct < 10) { base = (bf16_t*)(ws + WS_AQ); ldc = 512; colt = (ct - 8) * 256; }
        else if (ct == 10) { base = (bf16_t*)(ws + WS_AK); ldc = 256; colt = 0; }
        else if (ct == 11) { base = (bf16_t*)(ws + WS_AV); ldc = 256; colt = 0; }
        else if (ct < 16) { base = (bf16_t*)(ws + WS_GM); ldc = 1024; colt = (ct - 12) * 256; }
        else { base = (bf16_t*)(ws + WS_GA); ldc = 1024; colt = (ct - 16) * 256; }
        const int row0 = u.pm * BM + wr * 64 + fr, col0 = colt + wc * 32 + 8 * fq;
#pragma unroll
        for (int ai = 0; ai < 2; ++ai)
#pragma unroll
            for (int m = 0; m < 4; ++m) { bf16_t* rowp = base + (size_t)(row0 + ai * HALF + m * 16) * ldc + col0;
#pragma unroll
                for (int bj = 0; bj < 2; ++bj) { const f32x4 v0 = acc[ai][bj][m][0], v1 = acc[ai][bj][m][1];
                    u32x4 w; w.x = cvt_pk_bf16(v0[0], v0[1]); w.y = cvt_pk_bf16(v0[2], v0[3]); w.z = cvt_pk_bf16(v1[0], v1[1]); w.w = cvt_pk_bf16(v1[2], v1[3]);
                    *(u32x4*)(rowp + bj * HALF) = w; } }
    }
};
#define PG8_SCR_SETUP const unsigned lo16 = (threadIdx.x & 63u) * 16u; const int wid_ = __builtin_amdgcn_readfirstlane(threadIdx.x >> 6); \
        unsigned char* sa_u = scr + ((size_t)(blockIdx.x * 2 + 0) * 8 + wid_) * 16384; unsigned char* sb_u = scr + ((size_t)(blockIdx.x * 2 + 1) * 8 + wid_) * 16384;
#define sa(k) (sa_u + (k) * 1024 + lo16)
#define sb(k) (sb_u + (k) * 1024 + lo16)
struct EpiGate {
    static constexpr bool PERM = true; static constexpr int NVM = 16;
    unsigned char* scr;
    DI bool keep(const Unit&) const { return false; }
    DI void operator()(f32x4 (&acc)[2][2][4][2], const Unit& u, int wr, int wc, int fr, int fq) const {
        PG8_SCR_SETUP
        if (u.sel == 0) {
#pragma unroll
            for (int ai = 0; ai < 2; ++ai)
#pragma unroll
                for (int m = 0; m < 4; ++m)
#pragma unroll
                    for (int bj = 0; bj < 2; ++bj) { float v[8];
#pragma unroll
                        for (int e = 0; e < 8; ++e) v[e] = sigmoidf_(acc[ai][bj][m][e >> 2][e & 3]);
                        u32x4 w; w.x = pk2(v[0], v[1]); w.y = pk2(v[2], v[3]); w.z = pk2(v[4], v[5]); w.w = pk2(v[6], v[7]);
                        *(u32x4*)sa(ai * 8 + m * 2 + bj) = w; }
        } else {
#pragma unroll
            for (int ai = 0; ai < 2; ++ai) {
                u32x4 A8[4][2];
#pragma unroll
                for (int m = 0; m < 4; ++m)
#pragma unroll
                    for (int bj = 0; bj < 2; ++bj) A8[m][bj] = *(const u32x4*)sa(ai * 8 + m * 2 + bj);
#pragma unroll
                for (int m = 0; m < 4; ++m)
#pragma unroll
                    for (int bj = 0; bj < 2; ++bj) { float r[8], b[8];
#pragma unroll
                        for (int e = 0; e < 8; ++e) { const float av = (e & 1) ? bfhi(A8[m][bj][e >> 1]) : bflo(A8[m][bj][e >> 1]); const float den = 1.f + __expf(-acc[ai][bj][m][e >> 2][e & 3]);
                            b[e] = __builtin_amdgcn_rcpf(den); r[e] = av * den; }
                        u32x4 wr_, wb_; wr_.x = pk2(r[0], r[1]); wr_.y = pk2(r[2], r[3]); wr_.z = pk2(r[4], r[5]); wr_.w = pk2(r[6], r[7]);
                        wb_.x = pk2(b[0], b[1]); wb_.y = pk2(b[2], b[3]); wb_.z = pk2(b[4], b[5]); wb_.w = pk2(b[6], b[7]);
                        *(u32x4*)sa(ai * 8 + m * 2 + bj) = wr_; *(u32x4*)sb(ai * 8 + m * 2 + bj) = wb_; }
            }
        }
    }
};
struct EpiMix {
    static constexpr bool PERM = true; static constexpr int NVM = 16;
    bf16_t* Y; unsigned char* scr;
    DI bool keep(const Unit& u) const { return u.sel == 0; }
    DI void operator()(f32x4 (&acc)[2][2][4][2], const Unit& u, int wr, int wc, int fr, int fq) const {
        PG8_SCR_SETUP
        if (u.sel == 0) {
#pragma unroll
            for (int ai = 0; ai < 2; ++ai) {
                u32x4 A8[4][2];
#pragma unroll
                for (int m = 0; m < 4; ++m)
#pragma unroll
                    for (int bj = 0; bj < 2; ++bj) A8[m][bj] = *(const u32x4*)sa(ai * 8 + m * 2 + bj);
#pragma unroll
                for (int m = 0; m < 4; ++m)
#pragma unroll
                    for (int bj = 0; bj < 2; ++bj)
#pragma unroll
                        for (int e = 0; e < 8; ++e) { const float rv = (e & 1) ? bfhi(A8[m][bj][e >> 1]) : bflo(A8[m][bj][e >> 1]); acc[ai][bj][m][e >> 2][e & 3] *= rv; }
            }
        } else {
            const int row0 = u.pm * BM + wr * 64 + fr, col0 = u.pn * BM + wc * 32 + 8 * fq;
#pragma unroll
            for (int ai = 0; ai < 2; ++ai) {
                u32x4 B8[4][2];
#pragma unroll
                for (int m = 0; m < 4; ++m)
#pragma unroll
                    for (int bj = 0; bj < 2; ++bj) B8[m][bj] = *(const u32x4*)sb(ai * 8 + m * 2 + bj);
#pragma unroll
                for (int m = 0; m < 4; ++m)
#pragma unroll
                    for (int bj = 0; bj < 2; ++bj) { float v[8];
#pragma unroll
                        for (int e = 0; e < 8; ++e) { const float bv = (e & 1) ? bfhi(B8[m][bj][e >> 1]) : bflo(B8[m][bj][e >> 1]); v[e] = acc[ai][bj][m][e >> 2][e & 3] * bv; }
                        u32x4 w; w.x = pk2(v[0], v[1]); w.y = pk2(v[2], v[3]); w.z = pk2(v[4], v[5]); w.w = pk2(v[6], v[7]);
                        *(u32x4*)(Y + (size_t)(row0 + ai * HALF + m * 16) * DM + col0 + bj * HALF) = w; }
            }
        }
    }
};
#undef PG8_SCR_SETUP
#undef sa
#undef sb
template <bool WITH_HN> struct EpiRes {
    static constexpr bool PERM = true; static constexpr int NVM = 16;
    const float* xp; const float* xs; float* out; bf16_t* hn; float* ss;
    DI bool keep(const Unit&) const { return false; }
    template <int Q> DI void ld(f32x4 (&B)[2][2][2], const Unit& u, int wr, int fr, int cb0) const {
#pragma unroll
        for (int mm = 0; mm < 2; ++mm) { const int t = u.pm * BM + (Q >> 1) * HALF + wr * 64 + (2 * (Q & 1) + mm) * 16 + fr; const float* br = xrow_ptr(xp, xs, t);
#pragma unroll
            for (int bj = 0; bj < 2; ++bj)
#pragma unroll
                for (int n = 0; n < 2; ++n) B[mm][bj][n] = *(const f32x4*)(br + cb0 + bj * HALF + 4 * n); }
    }
    template <int Q> DI void st(const f32x4 (&B)[2][2][2], const f32x4 (&acc)[2][2][4][2], const Unit& u, int wr, int wc, int fr, int fq, int cb0) const {
#pragma unroll
        for (int mm = 0; mm < 2; ++mm) { const int m = 2 * (Q & 1) + mm, ai = Q >> 1; const int t = u.pm * BM + ai * HALF + wr * 64 + m * 16 + fr; float ssq = 0.f;
#pragma unroll
            for (int bj = 0; bj < 2; ++bj) { const int c = cb0 + bj * HALF;
                const f32x4 h0 = B[mm][bj][0] + acc[ai][bj][m][0], h1 = B[mm][bj][1] + acc[ai][bj][m][1];
                ssq += ((h0[0] * h0[0] + h0[1] * h0[1]) + (h0[2] * h0[2] + h0[3] * h0[3])) + ((h1[0] * h1[0] + h1[1] * h1[1]) + (h1[2] * h1[2] + h1[3] * h1[3]));
                u32x4 w; w.x = cvt_pk_bf16(h0[0], h0[1]); w.y = cvt_pk_bf16(h0[2], h0[3]); w.z = cvt_pk_bf16(h1[0], h1[1]); w.w = cvt_pk_bf16(h1[2], h1[3]); *(u32x4*)(hn + (size_t)t * DM + c) = w; }
            ssq += __shfl_xor(ssq, 16); ssq += __shfl_xor(ssq, 32); if (fq == 0) ss[(size_t)t * 16 + u.pn * 4 + wc] = ssq; }
    }
    DI void operator()(f32x4 (&acc)[2][2][4][2], const Unit& u, int wr, int wc, int fr, int fq) const {
        const int cb0 = u.pn * BM + wc * 32 + 8 * fq;
        f32x4 B0[2][2][2], B1[2][2][2];
        ld<0>(B0, u, wr, fr, cb0); ld<1>(B1, u, wr, fr, cb0);
        st<0>(B0, acc, u, wr, wc, fr, fq, cb0); ld<2>(B0, u, wr, fr, cb0);
        st<1>(B1, acc, u, wr, wc, fr, fq, cb0); ld<3>(B1, u, wr, fr, cb0);
        st<2>(B0, acc, u, wr, wc, fr, fq, cb0); st<3>(B1, acc, u, wr, wc, fr, fq, cb0);
    }
};
DI float dpp_ror1(float x) { return __builtin_bit_cast(float, __builtin_amdgcn_update_dpp(0, __builtin_bit_cast(int, x), 0x121, 0xf, 0xf, false)); }
DI float dpp_rol1(float x) { return __builtin_bit_cast(float, __builtin_amdgcn_update_dpp(0, __builtin_bit_cast(int, x), 0x12F, 0xf, 0xf, false)); }
struct EpiConv {
    static constexpr bool PERM = true; static constexpr int NVM = 0;
    bf16_t* G; const float* ss; const float* cw; const float* cb; LAS float* xch;
    DI bool keep(const Unit&) const { return false; }
    DI void operator()(f32x4 (&acc)[2][2][4][2], const Unit& u, int wr, int wc, int fr, int fq) const {
        const int t0 = 254 * u.pm - 1 + 128 * wr + 8 * fr;
        unsigned upz = 0, dnz = 0, stm = 0;
        f32x4 P8[8];
#pragma unroll
        for (int idx = 0; idx < 8; ++idx) { const int t = t0 + idx; const int tc = t < 0 ? 0 : (t >= MTOK ? MTOK - 1 : t); P8[idx] = *(const f32x4*)(ss + (size_t)tc * 16 + 4 * fq); }
#pragma unroll
        for (int idx = 0; idx < 8; ++idx) { const int rho = 128 * wr + 8 * fr + idx, t = t0 + idx;
            const f32x4 p = P8[idx]; float s = (p[0] + p[1]) + (p[2] + p[3]); s += __shfl_xor(s, 16); s += __shfl_xor(s, 32);
            const float rs = __builtin_amdgcn_rsqf(s * (1.f / DM) + EPS);
#pragma unroll
            for (int bj = 0; bj < 2; ++bj)
#pragma unroll
                for (int n = 0; n < 2; ++n) acc[idx >> 2][bj][idx & 3][n] *= rs;
            if (seq_start(t)) upz |= 1u << idx;
            if (t + 1 >= MTOK || seq_start(t + 1)) dnz |= 1u << idx;
            if (rho >= 1 && rho <= 254 && t < MTOK) stm |= 1u << idx; }
        const bool anyb = __builtin_amdgcn_ballot_w64((upz | dnz) != 0u) != 0ull;
        f32x4 X[2][2];
        { LAS float* xw = xch + ((wr * 4 + wc) * 4 + fq) * 16; LAS const float* xr = xch + (((wr ^ 1) * 4 + wc) * 4 + fq) * 16;
          if (wr == 0) { if (fr == 15) {
#pragma unroll
              for (int bj = 0; bj < 2; ++bj)
#pragma unroll
                  for (int n = 0; n < 2; ++n) *(LAS f32x4*)(xw + (bj * 2 + n) * 4) = acc[1][bj][3][n]; } }
          else { if (fr == 0) {
#pragma unroll
              for (int bj = 0; bj < 2; ++bj)
#pragma unroll
                  for (int n = 0; n < 2; ++n) *(LAS f32x4*)(xw + (bj * 2 + n) * 4) = acc[0][bj][0][n]; } }
          asm volatile("s_waitcnt lgkmcnt(0)" ::: "memory"); __builtin_amdgcn_s_barrier(); asm volatile("" ::: "memory");
#pragma unroll
          for (int bj = 0; bj < 2; ++bj)
#pragma unroll
              for (int n = 0; n < 2; ++n) X[bj][n] = *(LAS const f32x4*)(xr + (bj * 2 + n) * 4); }
        const bool xup = (wr == 1) && (fr == 0), xdn = (wr == 0) && (fr == 15);
        f32x4 W[2][4];
#define LOADW(n_) _Pragma("unroll") for (int bj = 0; bj < 2; ++bj) { const int cc = bj * DFF + u.pn * 128 + wc * 32 + 8 * fq + 4 * (n_); \
            W[bj][0] = *(const f32x4*)(cw + cc); W[bj][1] = *(const f32x4*)(cw + NUP + cc); W[bj][2] = *(const f32x4*)(cw + 2 * NUP + cc); W[bj][3] = *(const f32x4*)(cb + cc); }
        LOADW(0)
#pragma unroll
        for (int n = 0; n < 2; ++n) {
            const int ch = u.pn * 128 + wc * 32 + 8 * fq + 4 * n;
            float ca[8][4]; unsigned pk[8][2];
#pragma unroll
            for (int bj = 0; bj < 2; ++bj) {
                const f32x4 w0 = W[bj][0], w1 = W[bj][1], w2 = W[bj][2], bb = W[bj][3];
#pragma unroll
                for (int jp = 0; jp < 2; ++jp) {
                    const f32n2 w0p = {w0[2 * jp], w0[2 * jp + 1]}, w1p = {w1[2 * jp], w1[2 * jp + 1]}, w2p = {w2[2 * jp], w2[2 * jp + 1]}, bbp = {bb[2 * jp], bb[2 * jp + 1]};
                    f32n2 v[8];
#pragma unroll
                    for (int idx = 0; idx < 8; ++idx) v[idx] = (f32n2){acc[idx >> 2][bj][idx & 3][n][2 * jp], acc[idx >> 2][bj][idx & 3][n][2 * jp + 1]};
                    f32n2 up0 = {dpp_ror1(v[7].x), dpp_ror1(v[7].y)}, dn7 = {dpp_rol1(v[0].x), dpp_rol1(v[0].y)};
                    if (xup) up0 = (f32n2){X[bj][n][2 * jp], X[bj][n][2 * jp + 1]};
                    if (xdn) dn7 = (f32n2){X[bj][n][2 * jp], X[bj][n][2 * jp + 1]};
                    f32n2 cv[8];
#pragma unroll
                    for (int idx = 0; idx < 8; ++idx) { f32n2 up = idx ? v[idx > 0 ? idx - 1 : 0] : up0, dn = idx < 7 ? v[idx < 7 ? idx + 1 : 7] : dn7;
                        if (anyb) { if ((upz >> idx) & 1u) up = (f32n2){0.f, 0.f}; if ((dnz >> idx) & 1u) dn = (f32n2){0.f, 0.f}; }
                        cv[idx] = w0p * up + (w1p * v[idx] + (w2p * dn + bbp)); }
                    if (bj == 0) {
#pragma unroll
                        for (int idx = 0; idx < 8; ++idx) { ca[idx][2 * jp] = cv[idx].x; ca[idx][2 * jp + 1] = cv[idx].y; }
                    } else {
#pragma unroll
                        for (int idx = 0; idx < 8; ++idx) { const f32n2 a2 = {ca[idx][2 * jp], ca[idx][2 * jp + 1]}; const f32n2 sg = {sigmoidf_(a2.x), sigmoidf_(a2.y)};
                            const f32n2 r2 = (a2 * sg) * cv[idx]; ca[idx][2 * jp] = r2.x; ca[idx][2 * jp + 1] = r2.y; }
                    } } }
#pragma unroll
            for (int idx = 0; idx < 8; ++idx) { pk[idx][0] = cvt_pk_bf16_asm(ca[idx][0], ca[idx][1]); pk[idx][1] = cvt_pk_bf16_asm(ca[idx][2], ca[idx][3]); }
            if (n == 0) { LOADW(1) }
#pragma unroll
            for (int idx = 0; idx < 8; ++idx) if ((stm >> idx) & 1u) { u32x2 w; w.x = pk[idx][0]; w.y = pk[idx][1]; *(u32x2*)(G + (size_t)(t0 + idx) * DFF + ch) = w; }
        }
#undef LOADW
    }
};
struct EpiFinal {
    static constexpr bool PERM = true; static constexpr int NVM = 32;
    float* out; const bf16_t* hn; const float* nfw; unsigned* xs; unsigned* cnt;
    DI bool keep(const Unit&) const { return false; }
    template <int Q> DI void ld(f32x4 (&B)[2][2][2], const Unit& u, int wr, int fr, int cb0) const {
#pragma unroll
        for (int mm = 0; mm < 2; ++mm) { const int t = u.pm * BM + (Q >> 1) * HALF + wr * 64 + (2 * (Q & 1) + mm) * 16 + fr; const bf16_t* br = hn + (size_t)t * DM;
#pragma unroll
            for (int bj = 0; bj < 2; ++bj) { const u32x4 w = *(const u32x4*)(br + cb0 + bj * HALF);
                B[mm][bj][0] = (f32x4){bflo(w.x), bfhi(w.x), bflo(w.y), bfhi(w.y)}; B[mm][bj][1] = (f32x4){bflo(w.z), bfhi(w.z), bflo(w.w), bfhi(w.w)}; } }
    }
    template <int Q> DI void add(const f32x4 (&B)[2][2][2], f32x4 (&acc)[2][2][4][2], const Unit& u, int wr, int wc, int fr, int fq) const {
#pragma unroll
        for (int mm = 0; mm < 2; ++mm) { const int m = 2 * (Q & 1) + mm, ai = Q >> 1; const int t = u.pm * BM + ai * HALF + wr * 64 + m * 16 + fr; float ssq = 0.f;
#pragma unroll
            for (int bj = 0; bj < 2; ++bj)
#pragma unroll
                for (int n = 0; n < 2; ++n) { const f32x4 hv = B[mm][bj][n] + acc[ai][bj][m][n]; acc[ai][bj][m][n] = hv; ssq += (hv[0] * hv[0] + hv[1] * hv[1]) + (hv[2] * hv[2] + hv[3] * hv[3]); }
            ssq += __shfl_xor(ssq, 16); ssq += __shfl_xor(ssq, 32);
            if (fq == 0) __hip_atomic_store(xs + (size_t)t * 16 + u.pn * 4 + wc, __float_as_uint(ssq), __ATOMIC_RELAXED, __HIP_MEMORY_SCOPE_AGENT); }
    }
    DI void operator()(f32x4 (&acc)[2][2][4][2], const Unit& u, int wr, int wc, int fr, int fq) const {
        const int lane = threadIdx.x & 63, cb0 = u.pn * BM + wc * 32 + 8 * fq;
        { f32x4 B0[2][2][2], B1[2][2][2];
          ld<0>(B0, u, wr, fr, cb0); ld<1>(B1, u, wr, fr, cb0);
          add<0>(B0, acc, u, wr, wc, fr, fq); ld<2>(B0, u, wr, fr, cb0);
          add<1>(B1, acc, u, wr, wc, fr, fq); ld<3>(B1, u, wr, fr, cb0);
          add<2>(B0, acc, u, wr, wc, fr, fq); add<3>(B1, acc, u, wr, wc, fr, fq); }
        asm volatile("s_waitcnt vmcnt(0)" ::: "memory");
        unsigned* cw_ = cnt + 64 * u.pm;
        if (lane == 0) __hip_atomic_fetch_add(cw_, 1u, __ATOMIC_RELAXED, __HIP_MEMORY_SCOPE_AGENT);
        f32x4 W4[2][2];
#pragma unroll
        for (int bj = 0; bj < 2; ++bj)
#pragma unroll
            for (int n = 0; n < 2; ++n) W4[bj][n] = *(const f32x4*)(nfw + cb0 + bj * HALF + 4 * n);
        while ((unsigned)__builtin_amdgcn_readfirstlane(__hip_atomic_load(cw_, __ATOMIC_RELAXED, __HIP_MEMORY_SCOPE_AGENT)) < 32u) __builtin_amdgcn_s_sleep(2);
        asm volatile("" ::: "memory");
        unsigned Pp[8][4];
#pragma unroll
        for (int idx = 0; idx < 8; ++idx) { const int t = u.pm * BM + (idx >> 2) * HALF + wr * 64 + (idx & 3) * 16 + fr; const unsigned* xp_ = xs + (size_t)t * 16 + 4 * fq;
#pragma unroll
            for (int q = 0; q < 4; ++q) Pp[idx][q] = __hip_atomic_load(xp_ + q, __ATOMIC_RELAXED, __HIP_MEMORY_SCOPE_AGENT); }
#pragma unroll
        for (int idx = 0; idx < 8; ++idx) { const int ai = idx >> 2, m = idx & 3; const int t = u.pm * BM + ai * HALF + wr * 64 + m * 16 + fr; float* orow = out + (size_t)t * DM;
            float s = (__uint_as_float(Pp[idx][0]) + __uint_as_float(Pp[idx][1])) + (__uint_as_float(Pp[idx][2]) + __uint_as_float(Pp[idx][3]));
            s += __shfl_xor(s, 16); s += __shfl_xor(s, 32);
            const float rs = 1.f / sqrtf(s * (1.f / DM) + EPS);
#pragma unroll
            for (int bj = 0; bj < 2; ++bj)
#pragma unroll
                for (int n = 0; n < 2; ++n) *(f32x4*)(orow + cb0 + bj * HALF + 4 * n) = acc[ai][bj][m][n] * rs * W4[bj][n]; }
    }
};
}

DI void transpose_item(const float* W, int ldw, int src_col0, int k0, bf16_t* WT, int K, int dst_row0, const float* kscale, float nscale, LAS float* scr, int lane) {
    float wv[32];
#pragma unroll
    for (int i = 0; i < 32; ++i) { const int kk = 2 * i + (lane >> 5); wv[i] = W[(size_t)(k0 + kk) * ldw + src_col0 + (lane & 31)]; }
#pragma unroll
    for (int i = 0; i < 32; ++i) { const int kk = 2 * i + (lane >> 5); const float s = kscale ? kscale[k0 + kk] * nscale : nscale;
        scr[kk * 33 + (lane & 31)] = wv[i] * s; }
    asm volatile("s_waitcnt lgkmcnt(0)" ::: "memory");
    const int c = lane & 7;
#pragma unroll
    for (int j = 0; j < 4; ++j) { const int n = (lane >> 3) + 8 * j; const LAS float* s = scr + (8 * c) * 33 + n;
        u32x4 o; o.x = pk2(s[0 * 33], s[1 * 33]); o.y = pk2(s[2 * 33], s[3 * 33]); o.z = pk2(s[4 * 33], s[5 * 33]); o.w = pk2(s[6 * 33], s[7 * 33]);
        *(u32x4*)(WT + (size_t)(dst_row0 + n) * K + k0 + 8 * c) = o; }
    asm volatile("s_waitcnt lgkmcnt(0)" ::: "memory");
}
DI float reduce16(const float (&p)[16], int lane) {
    const bool b5 = lane & 32, b4 = lane & 16, b3 = lane & 8, b2 = lane & 4;
    float q[8], r[4], s[2];
#pragma unroll
    for (int j = 0; j < 8; ++j) { const float send = b5 ? p[j] : p[j + 8], keep = b5 ? p[j + 8] : p[j]; q[j] = keep + __shfl_xor(send, 32); }
#pragma unroll
    for (int j = 0; j < 4; ++j) { const float send = b4 ? q[j] : q[j + 4], keep = b4 ? q[j + 4] : q[j]; r[j] = keep + __shfl_xor(send, 16); }
#pragma unroll
    for (int j = 0; j < 2; ++j) { const float send = b3 ? r[j] : r[j + 2], keep = b3 ? r[j + 2] : r[j]; s[j] = keep + __shfl_xor(send, 8); }
    const float send = b2 ? s[0] : s[1], keep = b2 ? s[1] : s[0]; float v = keep + __shfl_xor(send, 4);
    v += __shfl_xor(v, 2); v += __shfl_xor(v, 1); return v;
}

struct ChunkVec { float g0, g1, b0, b1, cm0, cm1, btot, gmax; int s0, s1; };
struct ChunkGates { float i0, f0, i1, f1; int s0, s1; };
DI ChunkGates chunk_gates_load(int d, const float* gates, int t0, int head, int lane) {
    ChunkGates q; const int e0 = 2 * lane, e1 = e0 + 1; q.s0 = d ? 127 - e0 : e0; q.s1 = d ? 127 - e1 : e1;
    const float* g0p = gates + (size_t)(t0 + q.s0) * 16 + d * 4 + head; const float* g1p = gates + (size_t)(t0 + q.s1) * 16 + d * 4 + head;
    q.i0 = g0p[0]; q.f0 = g0p[8]; q.i1 = g1p[0]; q.f1 = g1p[8]; return q;
}
DI ChunkVec chunk_vectors_from(const ChunkGates& q, int lane) {
    ChunkVec r; r.s0 = q.s0; r.s1 = q.s1;
    const float i0 = q.i0, f0 = q.f0, i1 = q.i1, f1 = q.f1;
    const float lf0 = logsigmoid_(f0), lf1 = logsigmoid_(f1);
    float ps = lf0 + lf1;
#pragma unroll
    for (int o = 1; o < 64; o <<= 1) { const float t = __shfl_up(ps, o); if (lane >= o) ps += t; }
    const float excl = ps - (lf0 + lf1); r.b0 = excl + lf0; r.b1 = r.b0 + lf1;
    r.g0 = i0 - r.b0; r.g1 = i1 - r.b1;
    float cm = fmaxf(r.g0, r.g1);
#pragma unroll
    for (int o = 1; o < 64; o <<= 1) { const float t = __shfl_up(cm, o); if (lane >= o) cm = fmaxf(cm, t); }
    float ex = __shfl_up(cm, 1); if (lane == 0) ex = -INFINITY;
    r.cm0 = fmaxf(ex, r.g0); r.cm1 = fmaxf(r.cm0, r.g1);
    r.btot = __shfl(r.b1, 63); r.gmax = __shfl(r.cm1, 63);
    return r;
}
DI ChunkVec chunk_vectors(int d, const float* gates, int t0, int head, int lane) { return chunk_vectors_from(chunk_gates_load(d, gates, t0, head, lane), lane); }

struct Ctx {
    const float* in[17]; float* out; unsigned char* ws;
};

DI void summary_prefetch(const Ctx& c, int chunk, int head, int tid, u32x4 (&v8r)[4], u32x4 (&k8r)[4]) {
    const bf16_t* MK = (const bf16_t*)(c.ws + WS_MK); const bf16_t* MV = (const bf16_t*)(c.ws + WS_MV); const int t0 = chunk * 128;
#pragma unroll
    for (int i = 0; i < 4; ++i) { const int idx = tid + 512 * i, s = idx & 127, ch = idx >> 7; const size_t go = (size_t)(t0 + s) * 512 + head * 128 + ch * 8; v8r[i] = *(const u32x4*)(MV + go); k8r[i] = *(const u32x4*)(MK + go); }
}
DI void summary_unit(LAS unsigned char* lds, const Ctx& c, int chunk, int head, int nchunk, int nhead, u32x4 (&v8r)[4], u32x4 (&k8r)[4], int tid, int lane, int wid) {
    asm volatile("" : "+v"(tid), "+v"(lane));
    const int t0 = chunk * 128, fr = lane & 15, fq = lane >> 4;
    LAS bf16_t* LVT = (LAS bf16_t*)lds; LAS bf16_t* LKF = (LAS bf16_t*)(lds + 34816); LAS bf16_t* LKB = (LAS bf16_t*)(lds + 69632); LAS float* vW = (LAS float*)(lds + 104448);
    const float* gates = (const float*)(c.ws + WS_GATES);
    const bf16_t* MK = (const bf16_t*)(c.ws + WS_MK); const bf16_t* MV = (const bf16_t*)(c.ws + WS_MV);
    if (wid < 2) { const int d = wid; const ChunkVec v = chunk_vectors(d, gates, t0, head, lane);
        vW[d * 128 + v.s0] = __expf(v.g0 - v.gmax); vW[d * 128 + v.s1] = __expf(v.g1 - v.gmax);
        if (lane == 0) { float* sc = (float*)(c.ws + WS_CHSC) + ((size_t)(d * NCHUNK + chunk) * 4 + head) * 2; sc[0] = v.btot; sc[1] = v.btot + v.gmax; } }
    __syncthreads();
#pragma unroll
    for (int i = 0; i < 4; ++i) { const int idx = tid + 512 * i, s = idx & 127, ch = idx >> 7;
        const u32x4 v8 = v8r[i], k8 = k8r[i]; const float wf = vW[s], wb = vW[128 + s];
#pragma unroll
        for (int e = 0; e < 8; ++e) { const unsigned vw = v8[e >> 1], kw = k8[e >> 1]; const float kf = (e & 1) ? bfhi(kw) : bflo(kw);
            LVT[(8 * ch + e) * 136 + s] = (bf16_t)((e & 1) ? (vw >> 16) : (vw & 0xffffu));
            const unsigned fb = pk2(wf * kf, wb * kf); LKF[(8 * ch + e) * 136 + s] = (bf16_t)(fb & 0xffffu); LKB[(8 * ch + e) * 136 + s] = (bf16_t)(fb >> 16); } }
    summary_prefetch(c, nchunk, nhead, tid, v8r, k8r);
    __syncthreads();
    const int d = wid & 1, cgp = wid >> 1;
    LAS const unsigned char* LKD = (LAS const unsigned char*)(d ? LKB : LKF);
    bf16x8 Y[2][4];
#pragma unroll
    for (int ci = 0; ci < 2; ++ci)
#pragma unroll
        for (int ks = 0; ks < 4; ++ks) Y[ci][ks] = *(LAS const bf16x8*)(LKD + (16 * (2 * cgp + ci) + fr) * 272 + (32 * ks + 8 * fq) * 2);
    bf16_t* ST = (bf16_t*)(c.out) + ((size_t)(d * NCHUNK + chunk) * 4 + head) * ST_ELEMS;
#pragma unroll
    for (int rt = 0; rt < 9; ++rt) {
        bf16x8 X[4];
#pragma unroll
        for (int ks = 0; ks < 4; ++ks) {
            if (rt < 8) X[ks] = *(LAS const bf16x8*)((LAS const unsigned char*)LVT + (16 * rt + fr) * 272 + (32 * ks + 8 * fq) * 2);
            else { const short o = fr == 0 ? (short)0x3F80 : (short)0; X[ks] = (bf16x8){o, o, o, o, o, o, o, o}; } }
#pragma unroll
        for (int ci = 0; ci < 2; ++ci) { f32x4 a = (f32x4){0.f, 0.f, 0.f, 0.f};
#pragma unroll
            for (int ks = 0; ks < 4; ++ks) a = MFMA16(Y[ci][ks], X[ks], a);
            const int v = 16 * rt + fr, k = 16 * (2 * cgp + ci) + 4 * fq;
            if (rt < 8 || fr == 0) { u32x2 w; w.x = pk2(a[0], a[1]); w.y = pk2(a[2], a[3]); *(u32x2*)(ST + (size_t)v * 128 + k) = w; } }
    }
    __syncthreads();
}

DI void attn_unit(LAS unsigned char* lds, const Ctx& c, int qb2, int hk, int tid, int lane, int wid) {
    asm volatile("" : "+v"(tid), "+v"(lane));
    const int t0 = qb2 * 256, fr = lane & 15, fq = lane >> 4;
    const int nseq = qb2 < 64 ? qb2 : ((qb2 - 64) & 15), Nseq = qb2 < 64 ? 64 : 16, pos0 = nseq * 256;
    const bool bv0 = nseq >= 1, bv3 = nseq + 1 < Nseq;
    LAS unsigned char* LKB = lds; LAS bf16_t* LVT = (LAS bf16_t*)(lds + 73728);
    const bf16_t* AK = (const bf16_t*)(c.ws + WS_AK); const bf16_t* AV = (const bf16_t*)(c.ws + WS_AV); const bf16_t* AQ = (const bf16_t*)(c.ws + WS_AQ);
    const float* rope = (const float*)(c.ws + WS_ROPE);
    const int g = wid >> 2, rg = wid & 3, hq = 2 * hk + g, r0 = 64 * rg;
#define ATT_OK(j) ((((j) >> 7) == 0) ? bv0 : ((((j) >> 7) == 3) ? bv3 : true))
    u32x4 kb[6];
#pragma unroll
    for (int i = 0; i < 6; ++i) { const int idx = tid + 512 * i; const int j = idx / 6, ch = 2 + (idx - 6 * j); const bool ok = ATT_OK(j);
        const int tok = ok ? t0 - 128 + j : t0 + (j & 127); kb[i] = *(const u32x4*)((const char*)AK + (unsigned)((tok * 256 + hk * 64 + ch * 8) * 2)); }
    u32x4 kx1, kx2; f32x4 ktb[4];
    { const int j = tid; const bool ok = ATT_OK(j); const int tok = ok ? t0 - 128 + j : t0 + (j & 127);
      const unsigned ko = (unsigned)((tok * 256 + hk * 64) * 2); kx1 = *(const u32x4*)((const char*)AK + ko); kx2 = *(const u32x4*)((const char*)AK + ko + 16u);
      const unsigned to = (unsigned)((ok ? pos0 - 128 + j : 0) * 64);
#pragma unroll
      for (int q = 0; q < 4; ++q) ktb[q] = *(const f32x4*)((const char*)rope + to + 16u * q); }
    u32x4 vb[8];
#pragma unroll
    for (int i = 0; i < 8; ++i) { const int idx = tid + 512 * i, ch = idx >> 9, j = idx & 511; const bool ok = ATT_OK(j);
        const int tok = ok ? t0 - 128 + j : t0 + (j & 127); vb[i] = *(const u32x4*)((const char*)AV + (unsigned)((tok * 256 + hk * 64 + ch * 8) * 2)); }
#pragma unroll
    for (int i = 0; i < 6; ++i) { const int idx = tid + 512 * i; const int j = idx / 6, ch = 2 + (idx - 6 * j); const bool ok = ATT_OK(j);
        *(LAS u32x4*)(LKB + j * 144 + ch * 16) = ok ? kb[i] : (u32x4){0u, 0u, 0u, 0u}; }
    { const int j = tid; const bool ok = ATT_OK(j);
      float ra[8], rb[8];
#pragma unroll
      for (int e = 0; e < 8; ++e) { const float a = (e & 1) ? bfhi(kx1[e >> 1]) : bflo(kx1[e >> 1]), b = (e & 1) ? bfhi(kx2[e >> 1]) : bflo(kx2[e >> 1]); const float cs = ktb[e >> 2][e & 3], sn = ktb[2 + (e >> 2)][e & 3];
          ra[e] = a * cs - b * sn; rb[e] = b * cs + a * sn; }
      u32x4 o1, o2; o1.x = pk2(ra[0], ra[1]); o1.y = pk2(ra[2], ra[3]); o1.z = pk2(ra[4], ra[5]); o1.w = pk2(ra[6], ra[7]); o2.x = pk2(rb[0], rb[1]); o2.y = pk2(rb[2], rb[3]); o2.z = pk2(rb[4], rb[5]); o2.w = pk2(rb[6], rb[7]);
      if (!ok) { o1 = (u32x4){0u, 0u, 0u, 0u}; o2 = o1; }
      *(LAS u32x4*)(LKB + j * 144) = o1; *(LAS u32x4*)(LKB + j * 144 + 16) = o2; }
#pragma unroll
    for (int i = 0; i < 8; ++i) { const int idx = tid + 512 * i, ch = idx >> 9, j = idx & 511; const bool ok = ATT_OK(j);
        const u32x4 v8 = ok ? vb[i] : (u32x4){0u, 0u, 0u, 0u};
#pragma unroll
        for (int e = 0; e < 8; ++e) { const unsigned vw = v8[e >> 1]; LVT[(8 * ch + e) * 520 + j] = (bf16_t)((e & 1) ? (vw >> 16) : (vw & 0xffffu)); } }
    asm volatile("" ::: "memory");
    const float sink = c.in[7][hq] * 1.4426950408889634f;
    bf16x8 Xq[4][2];
#pragma unroll
    for (int mi = 0; mi < 4; ++mi) { const int rho = r0 + 16 * mi + fr; const unsigned qo = (unsigned)(((t0 + rho) * 512 + hq * 64 + 8 * fq) * 2);
#pragma unroll
        for (int ks = 0; ks < 2; ++ks) {
            u32x4 q = *(const u32x4*)((const char*)AQ + qo + 64u * ks);
            if (ks == 0) { u32x4 pr; pr.x = __shfl_xor(q.x, 16); pr.y = __shfl_xor(q.y, 16); pr.z = __shfl_xor(q.z, 16); pr.w = __shfl_xor(q.w, 16);
                if (fq < 2) { float r[8]; const float* tb = rope + (size_t)(pos0 + rho) * 16;
#pragma unroll
                    for (int e = 0; e < 8; ++e) { const float own = (e & 1) ? bfhi(q[e >> 1]) : bflo(q[e >> 1]), oth = (e & 1) ? bfhi(pr[e >> 1]) : bflo(pr[e >> 1]); const float cs = tb[e], sn = tb[8 + e];
                        r[e] = fq == 0 ? (own * cs - oth * sn) : (own * cs + oth * sn); }
                    q.x = pk2(r[0], r[1]); q.y = pk2(r[2], r[3]); q.z = pk2(r[4], r[5]); q.w = pk2(r[6], r[7]); } }
            Xq[mi][ks] = __builtin_bit_cast(bf16x8, q); } }
    __syncthreads();
    f32x4 O[4][4]; float mrow[4], lrow[4];
#pragma unroll
    for (int mi = 0; mi < 4; ++mi) { mrow[mi] = sink; lrow[mi] = fq == 0 ? 1.f : 0.f;
#pragma unroll
        for (int nd = 0; nd < 4; ++nd) O[mi][nd] = (f32x4){0.f, 0.f, 0.f, 0.f}; }
    for (int kt = 0; kt < 10; ++kt) {
        const int j0 = r0 + 32 * kt;
        if (!ATT_OK(j0)) continue;
#pragma unroll
        for (int mh = 0; mh < 2; ++mh) {
            const int ra0 = r0 + 32 * mh;
            if (j0 + 31 < ra0 || j0 > ra0 + 31 + 256) continue;
            f32x4 S[2][2];
#pragma unroll
            for (int m2 = 0; m2 < 2; ++m2)
#pragma unroll
                for (int ni = 0; ni < 2; ++ni) S[m2][ni] = (f32x4){0.f, 0.f, 0.f, 0.f};
#pragma unroll
            for (int ks = 0; ks < 2; ++ks)
#pragma unroll
                for (int ni = 0; ni < 2; ++ni) { const bf16x8 Yk = *(LAS const bf16x8*)(LKB + (j0 + 16 * ni + fr) * 144 + (32 * ks + 8 * fq) * 2);
#pragma unroll
                    for (int m2 = 0; m2 < 2; ++m2) S[m2][ni] = MFMA16(Yk, Xq[2 * mh + m2][ks], S[m2][ni]); }
            bf16x8 Xp[2];
#pragma unroll
            for (int m2 = 0; m2 < 2; ++m2) { const int mi = 2 * mh + m2; const int rhoa = r0 + 16 * mi, rho = rhoa + fr;
                const bool full = (j0 >= rhoa + 15) && (j0 + 31 <= rhoa + 256);
                float mx = -INFINITY;
                if (full) {
#pragma unroll
                    for (int ni = 0; ni < 2; ++ni)
#pragma unroll
                        for (int jj = 0; jj < 4; ++jj) mx = fmaxf(mx, S[m2][ni][jj]);
                } else {
#pragma unroll
                    for (int ni = 0; ni < 2; ++ni)
#pragma unroll
                        for (int jj = 0; jj < 4; ++jj) { const int j = j0 + 16 * ni + 4 * fq + jj; const bool ok = (j >= rho) && (j <= rho + 256);
                            const float sv = ok ? S[m2][ni][jj] : -INFINITY; S[m2][ni][jj] = sv; mx = fmaxf(mx, sv); }
                }
                if (__builtin_amdgcn_ballot_w64(mx > mrow[mi] + 6.0f) != 0ull) {
                    mx = fmaxf(mx, __shfl_xor(mx, 16)); mx = fmaxf(mx, __shfl_xor(mx, 32));
                    const float mnew = fmaxf(mrow[mi], mx), alpha = __builtin_amdgcn_exp2f(mrow[mi] - mnew); mrow[mi] = mnew; lrow[mi] *= alpha;
#pragma unroll
                    for (int nd = 0; nd < 4; ++nd) O[mi][nd] *= alpha; }
                const float mref = mrow[mi];
                float p[8], ps = 0.f;
#pragma unroll
                for (int e = 0; e < 8; ++e) { p[e] = __builtin_amdgcn_exp2f(S[m2][e >> 2][e & 3] - mref); ps += p[e]; }
                lrow[mi] += ps;
                Xp[m2] = pack8(p); }
#pragma unroll
            for (int nd = 0; nd < 4; ++nd) { const LAS bf16_t* vp = LVT + (16 * nd + fr) * 520 + j0 + 4 * fq;
                const s16x4 lo = *(LAS const s16x4*)vp, hi = *(LAS const s16x4*)(vp + 16);
                const bf16x8 Yv = (bf16x8){lo[0], lo[1], lo[2], lo[3], hi[0], hi[1], hi[2], hi[3]};
#pragma unroll
                for (int m2 = 0; m2 < 2; ++m2) O[2 * mh + m2][nd] = MFMA16(Yv, Xp[m2], O[2 * mh + m2][nd]); }
        }
    }
#pragma unroll
    for (int mi = 0; mi < 4; ++mi) { float l = lrow[mi]; l += __shfl_xor(l, 16); l += __shfl_xor(l, 32); const float inv = 1.f / l;
        bf16_t* op = (bf16_t*)(c.ws + WS_HMOA) + (size_t)(t0 + r0 + 16 * mi + fr) * 1024 + 512 + hq * 64 + 4 * fq;
#pragma unroll
        for (int nd = 0; nd < 4; ++nd) { const f32x4 o = O[mi][nd] * inv; u32x2 w; w.x = pk2(o[0], o[1]); w.y = pk2(o[2], o[3]); *(u32x2*)(op + 16 * nd) = w; } }
    __syncthreads();
#undef ATT_OK
}

DI void scan_item(const Ctx& c, int st, int slice, int lane) {
    const int seq = st >> 3, head = (st >> 1) & 3, d = st & 1;
    const int chunk0 = seq == 0 ? 0 : 128 + 32 * (seq - 1), nch = seq == 0 ? 128 : 32;
    const int e0 = slice * 512 + lane * 8; const bool act = e0 < ST_ELEMS;
    bf16_t* CST = (bf16_t*)c.out; const float* CHSC = (const float*)(c.ws + WS_CHSC); float* MP = (float*)(c.ws + WS_MPREV);
    float C[8];
#pragma unroll
    for (int e = 0; e < 8; ++e) C[e] = 0.f;
    float m = 0.f;
    for (int i0 = 0; i0 < nch; i0 += 8) {
        u32x4 ld[8]; float bt[8], ml[8];
#pragma unroll
        for (int u = 0; u < 8; ++u) { const int ch = d ? chunk0 + nch - 1 - (i0 + u) : chunk0 + i0 + u; const size_t ti = (size_t)(d * NCHUNK + ch) * 4 + head;
            ld[u] = act ? *(const u32x4*)(CST + ti * ST_ELEMS + e0) : (u32x4){0u, 0u, 0u, 0u}; bt[u] = CHSC[ti * 2]; ml[u] = CHSC[ti * 2 + 1]; }
#pragma unroll
        for (int u = 0; u < 8; ++u) { const int ch = d ? chunk0 + nch - 1 - (i0 + u) : chunk0 + i0 + u; const size_t ti = (size_t)(d * NCHUNK + ch) * 4 + head;
            if (slice == 0 && lane == 0) MP[ti] = m;
            u32x4 o; o.x = pk2(C[0], C[1]); o.y = pk2(C[2], C[3]); o.z = pk2(C[4], C[5]); o.w = pk2(C[6], C[7]);
            if (act) *(u32x4*)(CST + ti * ST_ELEMS + e0) = o;
            const float mn = fmaxf(bt[u] + m, ml[u]), sp = __expf(bt[u] + m - mn), sl = __expf(ml[u] - mn); m = mn;
#pragma unroll
            for (int e = 0; e < 8; ++e) { const unsigned w = ld[u][e >> 1]; const float cl = (e & 1) ? bfhi(w) : bflo(w); C[e] = sp * C[e] + sl * cl; } }
    }
}

template <int DIR> DI void dir_pass(const f32x4 (&S)[8], const bf16x8 (&Xq)[4], LAS const unsigned char* LS, LAS const unsigned char* LVTb, LAS const float* vec, int trow, int fr, int fq, f32x4 (&hs)[8]) {
    f32x4 acc[9];
#pragma unroll
    for (int nt = 0; nt < 9; ++nt) { acc[nt] = (f32x4){0.f, 0.f, 0.f, 0.f};
#pragma unroll
        for (int ks = 0; ks < 4; ++ks) { const bf16x8 Y = *(LAS const bf16x8*)(LS + (16 * nt + fr) * 272 + (32 * ks + 8 * fq) * 2); acc[nt] = MFMA16(Y, Xq[ks], acc[nt]); } asm volatile("" ::: "memory"); }
    const float Mt = vec[128 + trow], ex = vec[256 + trow], iw = vec[384 + trow];
#pragma unroll
    for (int nt = 0; nt < 9; ++nt) acc[nt] *= iw;
    bf16x8 Xp[4];
#pragma unroll
    for (int kp = 0; kp < 4; ++kp) { float p[8];
#pragma unroll
        for (int h2 = 0; h2 < 2; ++h2) { const int n = 2 * kp + h2; const f32x4 g4 = *(LAS const f32x4*)(vec + 16 * n + 4 * fq);
#pragma unroll
            for (int j = 0; j < 4; ++j) { const int s = 16 * n + 4 * fq + j; const bool ok = DIR == 0 ? (s <= trow) : (s >= trow);
                p[4 * h2 + j] = ok ? S[n][j] * __builtin_amdgcn_exp2f(g4[j] - Mt) : 0.f; } }
        Xp[kp] = pack8(p); }
#pragma unroll
    for (int nt = 0; nt < 8; ++nt)
#pragma unroll
        for (int kp = 0; kp < 4; ++kp) { LAS const unsigned char* vp = LVTb + (16 * nt + fr) * 272 + (32 * kp + 4 * fq) * 2;
            const s16x4 lo = *(LAS const s16x4*)vp, hi = *(LAS const s16x4*)(vp + 32);
            const bf16x8 Y = (bf16x8){lo[0], lo[1], lo[2], lo[3], hi[0], hi[1], hi[2], hi[3]};
            acc[nt] = MFMA16(Y, Xp[kp], acc[nt]); if (kp == 3) asm volatile("" ::: "memory"); }
    { const short o = fr == 0 ? (short)0x3F80 : (short)0; const bf16x8 ones = (bf16x8){o, o, o, o, o, o, o, o};
#pragma unroll
        for (int kp = 0; kp < 4; ++kp) acc[8] = MFMA16(ones, Xp[kp], acc[8]); }
    const float den = __shfl(acc[8][0], fr);
    const float inv = 1.f / fmaxf(fabsf(den), ex);
#pragma unroll
    for (int nt = 0; nt < 8; ++nt) { if (DIR == 0) hs[nt] = acc[nt] * inv; else hs[nt] += acc[nt] * inv; }
}
DI void mlstm_prefetch_states(const Ctx& c, int chunk, int head, int tid, u32x4 (&sbr)[5], u32x4 (&sfr)[5]) {
    const bf16_t* CSTF = (const bf16_t*)c.out + ((size_t)(0 * NCHUNK + chunk) * 4 + head) * ST_ELEMS; const bf16_t* CSTB = (const bf16_t*)c.out + ((size_t)(1 * NCHUNK + chunk) * 4 + head) * ST_ELEMS;
#pragma unroll
    for (int i = 0; i < 5; ++i) { int idx = tid + 512 * i; idx = idx < 2304 ? idx : 2303; const int r = idx >> 4, ch = idx & 15, rc = r < 129 ? r : 128;
        sbr[i] = *(const u32x4*)(CSTB + rc * 128 + ch * 8); sfr[i] = *(const u32x4*)(CSTF + rc * 128 + ch * 8); }
}
DI void mlstm_out_unit(LAS unsigned char* lds, const Ctx& c, int chunk, int head, int nchunk, int nhead, u32x4 (&sbr)[5], u32x4 (&sfr)[5], int tid, int lane, int wid) {
    asm volatile("" : "+v"(tid), "+v"(lane));
    const int t0 = chunk * 128, fr = lane & 15, fq = lane >> 4;
    LAS unsigned char* LQ = lds; LAS unsigned char* LK = lds + 34816; LAS unsigned char* LVTb = lds + 73984; LAS unsigned char* LSB = lds + 108800; LAS float* vec = (LAS float*)(lds + 147968);
    LAS bf16_t* LVT = (LAS bf16_t*)LVTb;
    const bf16_t* MQ = (const bf16_t*)(c.ws + WS_MQ); const bf16_t* MK = (const bf16_t*)(c.ws + WS_MK); const bf16_t* MV = (const bf16_t*)(c.ws + WS_MV); bf16_t* MO = (bf16_t*)(c.ws + WS_MO);
    const bf16_t* CSTF = (const bf16_t*)c.out + ((size_t)(0 * NCHUNK + chunk) * 4 + head) * ST_ELEMS; const bf16_t* CSTB = (const bf16_t*)c.out + ((size_t)(1 * NCHUNK + chunk) * 4 + head) * ST_ELEMS;
    ChunkGates cgq; cgq.i0 = cgq.f0 = cgq.i1 = cgq.f1 = 0.f; cgq.s0 = cgq.s1 = 0; float mp_early = 0.f;
    if (wid < 2) { cgq = chunk_gates_load(wid, (const float*)(c.ws + WS_GATES), t0, head, lane); mp_early = ((const float*)(c.ws + WS_MPREV))[(size_t)(wid * NCHUNK + chunk) * 4 + head]; }
    u32x4 qr[4], kr[4], vr[4];
#pragma unroll
    for (int i = 0; i < 4; ++i) { const int idx = tid + 512 * i, r = idx >> 4, ch = idx & 15; const size_t go = (size_t)(t0 + r) * 512 + head * 128 + ch * 8; qr[i] = *(const u32x4*)(MQ + go); kr[i] = *(const u32x4*)(MK + go); }
#pragma unroll
    for (int i = 0; i < 4; ++i) { const int idx = tid + 512 * i, s = idx & 127, ch = idx >> 7; vr[i] = *(const u32x4*)(MV + (size_t)(t0 + s) * 512 + head * 128 + ch * 8); }
#pragma unroll
    for (int i = 0; i < 4; ++i) { const int idx = tid + 512 * i, r = idx >> 4, ch = idx & 15; *(LAS u32x4*)(LQ + r * 272 + ch * 16) = qr[i]; *(LAS u32x4*)(LK + r * 272 + ch * 16) = kr[i]; }
#pragma unroll
    for (int i = 0; i < 4; ++i) { const int idx = tid + 512 * i, s = idx & 127, ch = idx >> 7; const u32x4 v8 = vr[i];
#pragma unroll
        for (int e = 0; e < 8; ++e) { const unsigned vw = v8[e >> 1]; LVT[(8 * ch + e) * 136 + s] = (bf16_t)((e & 1) ? (vw >> 16) : (vw & 0xffffu)); } }
#pragma unroll
    for (int i = 0; i < 5; ++i) { int idx = tid + 512 * i; idx = idx < 2304 ? idx : 2303; const int r = idx >> 4, ch = idx & 15;
        *(LAS u32x4*)(LSB + r * 272 + ch * 16) = r < 129 ? sbr[i] : (u32x4){0u, 0u, 0u, 0u}; }
    if (wid < 2) { const int d = wid; const ChunkVec v = chunk_vectors_from(cgq, lane);
        const float mp = mp_early;
        LAS float* vd = vec + d * 512; const float M0 = fmaxf(mp, v.cm0), M1 = fmaxf(mp, v.cm1);
        constexpr float L2E = 1.4426950408889634f;
        vd[v.s0] = v.g0 * L2E; vd[128 + v.s0] = M0 * L2E; vd[256 + v.s0] = __expf(-(v.b0 + M0)); vd[384 + v.s0] = __expf(mp - M0);
        vd[v.s1] = v.g1 * L2E; vd[128 + v.s1] = M1 * L2E; vd[256 + v.s1] = __expf(-(v.b1 + M1)); vd[384 + v.s1] = __expf(mp - M1); }
    __syncthreads();
    const int trow = 16 * wid + fr;
    bf16x8 Xq[4];
#pragma unroll
    for (int ks = 0; ks < 4; ++ks) Xq[ks] = *(LAS const bf16x8*)(LQ + trow * 272 + (32 * ks + 8 * fq) * 2);
    f32x4 S[8];
#pragma unroll
    for (int n = 0; n < 8; ++n) { S[n] = (f32x4){0.f, 0.f, 0.f, 0.f};
#pragma unroll
        for (int ks = 0; ks < 4; ++ks) { const bf16x8 Yk = *(LAS const bf16x8*)(LK + (16 * n + fr) * 272 + (32 * ks + 8 * fq) * 2); S[n] = MFMA16(Yk, Xq[ks], S[n]); } }
    __syncthreads();
#pragma unroll
    for (int i = 0; i < 5; ++i) { int idx = tid + 512 * i; idx = idx < 2304 ? idx : 2303; const int r = idx >> 4, ch = idx & 15;
        *(LAS u32x4*)(LK + r * 272 + ch * 16) = r < 129 ? sfr[i] : (u32x4){0u, 0u, 0u, 0u}; }
    __syncthreads();
    mlstm_prefetch_states(c, nchunk, nhead, tid, sbr, sfr);
    f32x4 hs[8];
    dir_pass<0>(S, Xq, LK, LVTb, vec, trow, fr, fq, hs);
    dir_pass<1>(S, Xq, LSB, LVTb, vec + 512, trow, fr, fq, hs);
    float sum = 0.f;
#pragma unroll
    for (int nt = 0; nt < 8; ++nt) sum += (hs[nt][0] + hs[nt][1]) + (hs[nt][2] + hs[nt][3]);
    sum += __shfl_xor(sum, 16); sum += __shfl_xor(sum, 32);
    const float mean = sum * (1.f / 128.f); float var = 0.f;
#pragma unroll
    for (int nt = 0; nt < 8; ++nt) { hs[nt] -= mean; var += (hs[nt][0] * hs[nt][0] + hs[nt][1] * hs[nt][1]) + (hs[nt][2] * hs[nt][2] + hs[nt][3] * hs[nt][3]); }
    var += __shfl_xor(var, 16); var += __shfl_xor(var, 32);
    const float rstd = __builtin_amdgcn_rsqf(var * (1.f / 128.f) + EPS);
    const float* nw = c.in[6] + head * 128; bf16_t* mop = MO + (size_t)(t0 + trow) * 512 + head * 128;
#pragma unroll
    for (int nt = 0; nt < 8; ++nt) { const int v = 16 * nt + 4 * fq; const u32x2 mo4 = *(const u32x2*)(mop + v); const f32x4 w4 = *(const f32x4*)(nw + v);
        const float o0 = hs[nt][0] * rstd * w4[0] * sigmoidf_(bflo(mo4.x)), o1 = hs[nt][1] * rstd * w4[1] * sigmoidf_(bfhi(mo4.x));
        const float o2 = hs[nt][2] * rstd * w4[2] * sigmoidf_(bflo(mo4.y)), o3 = hs[nt][3] * rstd * w4[3] * sigmoidf_(bfhi(mo4.y));
        u32x2 w; w.x = pk2(o0, o1); w.y = pk2(o2, o3); *(u32x2*)((bf16_t*)(c.ws + WS_HMOA) + (size_t)(t0 + trow) * 1024 + head * 128 + v) = w; }
    __syncthreads();
}

struct Args { const float* in[17]; float* out; unsigned char* ws; int ph_lo, ph_hi; };
constexpr int NPHASE = 9;

__global__ void __launch_bounds__(512, 2) mega(Args args) {
    extern __shared__ __attribute__((aligned(16))) unsigned char lds_raw[];
    LAS unsigned char* lds = (LAS unsigned char*)lds_raw;
    cg::grid_group grid = cg::this_grid();
    const int tid = threadIdx.x, lane = tid & 63, wid = __builtin_amdgcn_readfirstlane(tid >> 6);
    const int G = gridDim.x, gw = blockIdx.x * 8 + wid, NGW = G * 8;
    Ctx c;
#pragma unroll
    for (int i = 0; i < 17; ++i) c.in[i] = args.in[i];
    c.out = args.out; c.ws = args.ws;
    unsigned char* ws = args.ws;
    const int lo = args.ph_lo, hi = args.ph_hi;
#ifndef PH_MASK
#define PH_MASK 0x3ff
#endif
#define IN(k) (((PH_MASK >> (k)) & 1) && lo <= (k) && (k) < hi)
#define REP(k) for (int rep_ = 0; rep_ < (((DUP_MASK >> (k)) & 1) ? 2 : 1); ++rep_)
#define SEAM(k) do { if (IN(k) && IN((k) + 1)) grid.sync(); } while (0)

    REP(0) if (IN(0)) {
        LAS float* scr = (LAS float*)(lds + wid * 16384);
        for (int i = blockIdx.x * 512 + tid; i < 320 * 64; i += G * 512) ((unsigned*)(ws + WS_CTL))[i] = 0u;
        constexpr int I_W1 = 160 * 16, I_PM = 32 * 8, I_PA = 32 * 8, I_WO = 32 * 16, I_UP = 176 * 16, I_WD = 32 * 44;
        constexpr int NITEMS = I_W1 + I_PM + I_PA + I_WO + I_UP + I_WD;
        for (int it = gw; it < NITEMS; it += NGW) {
            int r = it;
            if (r < I_W1) { const int nb = r >> 4, kb = r & 15, dr = 32 * nb, sc = dr < 2048 ? dr : dr + 16;
                const float ns = (dr >= 512 && dr < 1024) ? 0.08838834764831845f : ((dr >= 2048 && dr < 2560) ? 0.18033688011112042f   : 1.f);
                transpose_item(c.in[3], DIN, sc, 64 * kb, (bf16_t*)(ws + WS_W1), 1024, dr, c.in[2], ns, scr, lane); continue; } r -= I_W1;
            if (r < I_PM) { const int nb = r >> 3, kb = r & 7; transpose_item(c.in[8], 1024, 32 * nb, 64 * kb, (bf16_t*)(ws + WS_W1) + (size_t)5120 * 1024, 1024, 32 * nb, nullptr, 1.f, scr, lane); continue; } r -= I_PM;
            if (r < I_PA) { const int nb = r >> 3, kb = r & 7; transpose_item(c.in[9], 1024, 32 * nb, 64 * kb, (bf16_t*)(ws + WS_W1) + (size_t)5120 * 1024 + 512, 1024, 32 * nb, nullptr, 1.f, scr, lane); continue; } r -= I_PA;
            if (r < I_WO) { const int nb = r >> 4, kb = r & 15; transpose_item(c.in[10], 1024, 32 * nb, 64 * kb, (bf16_t*)(ws + WS_WO), 1024, 32 * nb, nullptr, 1.f, scr, lane); continue; } r -= I_WO;
            if (r < I_UP) { const int nb = r >> 4, kb = r & 15, sc = 32 * nb; const int half = sc >= DFF ? 1 : 0, ch = sc - half * DFF; const int dr = 256 * (ch >> 7) + 128 * half + (ch & 127);
                transpose_item(c.in[12], NUP, sc, 64 * kb, (bf16_t*)(ws + WS_WUP), 1024, dr, c.in[11], 1.f, scr, lane); continue; } r -= I_UP;
            { const int nb = r / 44, kb = r - nb * 44; transpose_item(c.in[15], 1024, 32 * nb, 64 * kb, (bf16_t*)(ws + WS_WD), DFF, 32 * nb, nullptr, 1.f, scr, lane); }
        }
        {
            float* rope = (float*)(ws + WS_ROPE);
            for (int i = blockIdx.x * 512 + tid; i < 16384 * 8; i += G * 512) { const int pos = i >> 3, d = i & 7;
                const float invf = d == 0 ? 1.0f : d == 1 ? 0.1939227432012558f : d == 2 ? 0.03760603070259094f : d == 3 ? 0.007292664609849453f : d == 4 ? 0.0014142135623842478f
                                 : d == 5 ? 0.00027424818836152554f : d == 6 ? 5.3182957344688475e-05f : 1.0313385246263351e-05f;
                const float ang = (float)pos * invf; const float k = rintf(ang * 0.15915494309189535f);
                float rr = fmaf(-k, 6.2831854820251465f, ang); rr = fmaf(-k, -1.7484556025237907e-07f, rr);
                rope[pos * 16 + d] = cosf(rr); rope[pos * 16 + 8 + d] = sinf(rr); }
        }
        __syncthreads();
        LAS float* wg = (LAS float*)lds;
        for (int i = tid; i < 16384; i += 512) { const int k = i >> 4, j = i & 15; wg[j * 1024 + k] = c.in[2][k] * c.in[3][(size_t)k * DIN + 2048 + j]; }
        __syncthreads();
        bf16_t* XN = (bf16_t*)(ws + WS_XN); float* gates = (float*)(ws + WS_GATES);
        const float bias = (lane >> 2) < 8 ? c.in[4][lane >> 2] : c.in[5][(lane >> 2) - 8];
        f32x4 va[4], vb[4];
        { const int r0 = gw * 2 < MTOK ? gw * 2 : 0; const f32x4* xa = (const f32x4*)xrow_ptr(c.in[0], c.in[1], r0) + lane; const f32x4* xb = (const f32x4*)xrow_ptr(c.in[0], c.in[1], r0 + 1) + lane;
#pragma unroll
          for (int j = 0; j < 4; ++j) { va[j] = xa[64 * j]; vb[j] = xb[64 * j]; } }
        for (int r0 = gw * 2; r0 < MTOK; r0 += NGW * 2) {
            f32x4 na[4], nb[4];
            { const int rn = r0 + NGW * 2 < MTOK ? r0 + NGW * 2 : r0; const f32x4* xa = (const f32x4*)xrow_ptr(c.in[0], c.in[1], rn) + lane; const f32x4* xb = (const f32x4*)xrow_ptr(c.in[0], c.in[1], rn + 1) + lane;
#pragma unroll
              for (int j = 0; j < 4; ++j) { na[j] = xa[64 * j]; nb[j] = xb[64 * j]; } }
            float sa = 0.f, sb = 0.f;
#pragma unroll
            for (int j = 0; j < 4; ++j) {
                sa += (va[j][0] * va[j][0] + va[j][1] * va[j][1]) + (va[j][2] * va[j][2] + va[j][3] * va[j][3]); sb += (vb[j][0] * vb[j][0] + vb[j][1] * vb[j][1]) + (vb[j][2] * vb[j][2] + vb[j][3] * vb[j][3]); }
            const float rsa = 1.f / sqrtf(wave_sum(sa) * (1.f / DM) + EPS), rsb = 1.f / sqrtf(wave_sum(sb) * (1.f / DM) + EPS);
            float pa[16], pb[16];
#pragma unroll
            for (int g = 0; g < 16; ++g) { float qa = 0.f, qb = 0.f;
#pragma unroll
                for (int j = 0; j < 4; ++j) { const f32x4 w = *(LAS const f32x4*)(wg + g * 1024 + 256 * j + 4 * lane);
                    qa += (va[j][0] * w[0] + va[j][1] * w[1]) + (va[j][2] * w[2] + va[j][3] * w[3]); qb += (vb[j][0] * w[0] + vb[j][1] * w[1]) + (vb[j][2] * w[2] + vb[j][3] * w[3]); }
                pa[g] = qa; pb[g] = qb; asm volatile("" ::: "memory"); }
            const float ga_ = reduce16(pa, lane), gb_ = reduce16(pb, lane);
            if ((lane & 3) == 0) { gates[(size_t)r0 * 16 + (lane >> 2)] = rsa * ga_ + bias; gates[(size_t)(r0 + 1) * 16 + (lane >> 2)] = rsb * gb_ + bias; }
            unsigned long long* oa = (unsigned long long*)(XN + (size_t)r0 * DM) + lane; unsigned long long* ob = (unsigned long long*)(XN + (size_t)(r0 + 1) * DM) + lane;
#pragma unroll
            for (int j = 0; j < 4; ++j) {
                oa[64 * j] = (unsigned long long)pk2(va[j][0] * rsa, va[j][1] * rsa) | ((unsigned long long)pk2(va[j][2] * rsa, va[j][3] * rsa) << 32);
                ob[64 * j] = (unsigned long long)pk2(vb[j][0] * rsb, vb[j][1] * rsb) | ((unsigned long long)pk2(vb[j][2] * rsb, vb[j][3] * rsb) << 32); }
#pragma unroll
            for (int j = 0; j < 4; ++j) { va[j] = na[j]; vb[j] = nb[j]; }
        }
        __syncthreads();
    }
    SEAM(0);

    if (IN(1)) {
        pg8::Gemm g{(const bf16_t*)(ws + WS_XN), (const bf16_t*)(ws + WS_W1), nullptr, nullptr, 1024};
        pg8::DupOrder S; S.s.init(MTOK / 256, 12, G, (int)blockIdx.x); S.dup = (DUP_MASK >> 1) & 1;
        pg8::EpiProj E{ws};
        pg8::gemm_phase<pg8::EpiProj, pg8::DupOrder, true, false>(lds, g, S, E);
    }
    SEAM(1);

    if (IN(2)) {
        constexpr int NSU = NCHUNK * 4, NAU = (NCHUNK / 2) * 4;
        u32x4 v8r[4], k8r[4];
        if ((int)blockIdx.x < NSU) summary_prefetch(c, (int)blockIdx.x >> 2, (int)blockIdx.x & 3, tid, v8r, k8r);
        for (int it0 = blockIdx.x; it0 < (((DUP_MASK >> 2) & 1) ? 2 : 1) * (NSU + NAU); it0 += G) { const int it = it0 >= NSU + NAU ? it0 - (NSU + NAU) : it0;
            if (it < NSU) { const int nx = it0 + G < NSU ? it0 + G : it; summary_unit(lds, c, it >> 2, it & 3, nx >> 2, nx & 3, v8r, k8r, tid, lane, wid); }
            else { const int a = it - NSU; attn_unit(lds, c, a >> 2, a & 3, tid, lane, wid); }
        }
    }
    SEAM(2);

    REP(3) if (IN(3)) {
        constexpr int NPI = 8 * 33, NSI = 128 * 33;
        if (NGW > 2 * NPI) {
            if (gw < NPI) scan_item(c, gw / 33, gw % 33, lane);
            else { const int stride = NGW - NPI; for (int j = gw - NPI; j < NSI; j += stride) scan_item(c, 8 + j / 33, j % 33, lane); }
        } else {
            for (int j = gw; j < NPI + NSI; j += NGW) scan_item(c, j / 33, j % 33, lane);
        }
    }
    SEAM(3);

    REP(4) if (IN(4)) {
        u32x4 sbr[5], sfr[5];
        if ((int)blockIdx.x < NCHUNK * 4) mlstm_prefetch_states(c, (int)blockIdx.x >> 2, (int)blockIdx.x & 3, tid, sbr, sfr);
        for (int it = blockIdx.x; it < NCHUNK * 4; it += G) { const int nx = it + G < NCHUNK * 4 ? it + G : it; mlstm_out_unit(lds, c, it >> 2, it & 3, nx >> 2, nx & 3, sbr, sfr, tid, lane, wid); }
    }
    SEAM(4);

    if (IN(5)) {
        const bf16_t* W1t = (const bf16_t*)(ws + WS_W1);
        pg8::Gemm gg{(const bf16_t*)(ws + WS_XN), W1t + (size_t)3072 * 1024, (const bf16_t*)(ws + WS_XN), W1t + (size_t)4096 * 1024, 1024, 0};
        pg8::Gemm gx{(const bf16_t*)(ws + WS_HMOA), W1t + (size_t)5120 * 1024, (const bf16_t*)(ws + WS_HMOA) + 512, W1t + (size_t)5120 * 1024 + 512, 1024, 8};
        pg8::StaticOrder SO; SO.init(MTOK / 256, DM / 256, G, (int)blockIdx.x);
        pg8::EpiGate EG{ws + WS_QSCR}; pg8::EpiMix EM{(bf16_t*)(ws + WS_Y), ws + WS_QSCR};
        pg8::Unit tu;
        for (int k = 0; SO.next(k, tu); ++k) {
            pg8::TileOrder T{tu.pm, tu.pn};
            pg8::gemm_phase<pg8::EpiGate, pg8::TileOrder, true, false>(lds, gg, T, EG);
            pg8::gemm_phase<pg8::EpiMix, pg8::TileOrder, true, false>(lds, gx, T, EM);
        }
    }
    SEAM(5);

    if (IN(6)) {
        pg8::Gemm g{(const bf16_t*)(ws + WS_Y), (const bf16_t*)(ws + WS_WO), nullptr, nullptr, 1024};
        pg8::DupOrder S; S.s.init(MTOK / 256, DM / 256, G, (int)blockIdx.x); S.dup = (DUP_MASK >> 6) & 1;
        pg8::EpiRes<true> E{c.in[0], c.in[1], c.out, (bf16_t*)(ws + WS_HN), (float*)(ws + WS_SS)};
        pg8::gemm_phase<pg8::EpiRes<true>, pg8::DupOrder, true, false>(lds, g, S, E);
    }
    SEAM(6);

    if (IN(7)) {
        pg8::Gemm g{(const bf16_t*)(ws + WS_HN), (const bf16_t*)(ws + WS_WUP), nullptr, nullptr, 1024};
        pg8::DupOrder S; S.s.init(323, NUP / 256, G, (int)blockIdx.x); S.dup = (DUP_MASK >> 7) & 1;
        pg8::EpiConv E{(bf16_t*)(ws + WS_G), (const float*)(ws + WS_SS), c.in[13], c.in[14], (LAS float*)(lds + 131072)};
        pg8::gemm_phase<pg8::EpiConv, pg8::DupOrder, true, true>(lds, g, S, E);
    }
    SEAM(7);

    if (IN(8)) {
        pg8::Gemm g{(const bf16_t*)(ws + WS_G), (const bf16_t*)(ws + WS_WD), nullptr, nullptr, DFF};
        pg8::StaticOrder S; S.init(MTOK / 256, DM / 256, G, (int)blockIdx.x);
        pg8::EpiFinal E{c.out, (const bf16_t*)(ws + WS_HN), c.in[16], (unsigned*)(ws + WS_SS), (unsigned*)(ws + WS_CTL)};
        pg8::gemm_phase<pg8::EpiFinal, pg8::StaticOrder, true, false>(lds, g, S, E);
    }
#undef IN
#undef SEAM
}

extern "C" void kernel_launch(void* const* d_in, const int* in_sizes, int n_in, void* d_out, int out_size, void* d_ws, size_t ws_size, hipStream_t stream) {
    static int grid = 0;
    if (grid == 0) {
        if (n_in != 17 || out_size != MTOK * DM || ws_size < WS_END2) { fprintf(stderr, "kernel_launch: unexpected problem (n_in %d out %d ws %zu)\n", n_in, out_size, ws_size); grid = -1; return; }
        int dev = 0, cus = 0, per_cu = 0;
        if (hipGetDevice(&dev) != hipSuccess || hipDeviceGetAttribute(&cus, hipDeviceAttributeMultiprocessorCount, dev) != hipSuccess) { grid = -1; return; }
        if (hipFuncSetAttribute((const void*)mega, hipFuncAttributeMaxDynamicSharedMemorySize, LDS_BYTES) != hipSuccess) { fprintf(stderr, "kernel_launch: hipFuncSetAttribute failed\n"); grid = -1; return; }
        if (hipOccupancyMaxActiveBlocksPerMultiprocessor(&per_cu, (const void*)mega, 512, LDS_BYTES) != hipSuccess || per_cu < 1) { fprintf(stderr, "kernel_launch: occupancy query says %d\n", per_cu); per_cu = 1; }
        (void)hipGetLastError();
        grid = cus * per_cu;
    }
    if (grid < 0) return;
    Args a{};
    for (int i = 0; i < 17; ++i) a.in[i] = (const float*)d_in[i];
    a.out = (float*)d_out; a.ws = (unsigned char*)d_ws;
#if MK_SINGLE
    a.ph_lo = 0; a.ph_hi = NPHASE;
    void* kargs[] = {&a};
    hipError_t e = hipLaunchCooperativeKernel((const void*)mega, dim3(grid), dim3(512), kargs, LDS_BYTES, stream);
    if (e != hipSuccess) fprintf(stderr, "cooperative launch failed: %s (grid %d)\n", hipGetErrorString(e), grid);
#else
    for (int p = 0; p < NPHASE; ++p) { a.ph_lo = p; a.ph_hi = p + 1; hipLaunchKernelGGL(mega, dim3(grid), dim3(512), LDS_BYTES, stream, a); }
#endif
}
```

```cpp
#include <hip/hip_runtime.h>
#include <hip/hip_cooperative_groups.h>
#include <cstdio>
#include <cstdint>
namespace cg = cooperative_groups;

#ifndef DUP_MASK
#define DUP_MASK 0
#endif
#ifndef MK_SINGLE
#define MK_SINGLE 1
#endif

#define LAS __attribute__((address_space(3)))
#define DI __device__ __forceinline__
typedef unsigned short bf16_t;
typedef short bf16x8 __attribute__((ext_vector_type(8)));
typedef short s16x4 __attribute__((ext_vector_type(4)));
typedef float f32x4 __attribute__((ext_vector_type(4)));
typedef unsigned u32x4 __attribute__((ext_vector_type(4)));
typedef unsigned u32x2 __attribute__((ext_vector_type(2)));

constexpr int MTOK = 81920, DM = 1024, NPROJ = 5120, DIN = 5136, DFF = 2816, NUP = 5632;
constexpr int NCHUNK = 640, PROMPT = 16384;
constexpr float EPS = 1e-6f;
constexpr int ST_ELEMS = 129 * 128;
constexpr size_t ST_BYTES = (size_t)ST_ELEMS * 2;

constexpr size_t MiB = 1u << 20;
constexpr size_t WS_CTL = 0;
constexpr size_t WS_W1 = 2 * MiB, WS_WPM = 13 * MiB, WS_WPA = 14 * MiB, WS_WO = 15 * MiB, WS_WUP = 17 * MiB, WS_WD = 28 * MiB;
constexpr size_t WS_ROPE = 34 * MiB, WS_GATES = 35 * MiB, WS_SS = 40 * MiB, WS_CHSC = 46 * MiB, WS_MPREV = 47 * MiB;
constexpr size_t WS_MQ = 64 * MiB, WS_MK = 144 * MiB, WS_MV = 224 * MiB, WS_MO = 304 * MiB, WS_AQ = 384 * MiB, WS_AK = 464 * MiB, WS_AV = 504 * MiB,
                 WS_GM = 544 * MiB, WS_GA = 704 * MiB, WS_END = 864 * MiB;
constexpr size_t WS_Y = 64 * MiB, WS_HN = 224 * MiB, WS_G = 384 * MiB;
constexpr size_t WS_OA = 864 * MiB, WS_HM = 944 * MiB, WS_END2 = 1024 * MiB;
constexpr size_t OUT_CST = 0;
constexpr size_t WS_XN = WS_GM, WS_QSCR = WS_GA;
constexpr size_t WS_HMOA = 864 * MiB;
constexpr int LDS_BYTES = 152064;

typedef __bf16 bf16n2 __attribute__((ext_vector_type(2)));
typedef float f32n2 __attribute__((ext_vector_type(2)));
DI unsigned pk2(float lo, float hi) { const f32n2 v = {lo, hi}; return __builtin_bit_cast(unsigned, __builtin_convertvector(v, bf16n2)); }
DI unsigned f2bf(float f) { return pk2(f, f) & 0xffffu; }
DI float bflo(unsigned w) { return __uint_as_float(w << 16); }
DI float bfhi(unsigned w) { return __uint_as_float(w & 0xffff0000u); }
DI unsigned cvt_pk_bf16_asm(float lo, float hi) { unsigned r; asm volatile("v_cvt_pk_bf16_f32 %0, %1, %2" : "=v"(r) : "v"(lo), "v"(hi)); return r; }
DI unsigned cvt_pk_bf16(float lo, float hi) { return pk2(lo, hi); }
DI float wave_sum(float v) {
#pragma unroll
    for (int o = 1; o < 64; o <<= 1) v += __shfl_xor(v, o);
    return v;
}
DI float sigmoidf_(float x) { return __builtin_amdgcn_rcpf(1.f + __expf(-x)); }
DI float logsigmoid_(float x) { return x >= 0.f ? -log1pf(expf(-x)) : x - log1pf(expf(x)); }
#define MFMA16(a, b, c) __builtin_amdgcn_mfma_f32_16x16x32_bf16((a), (b), (c), 0, 0, 0)
DI bf16x8 pack8(const float (&p)[8]) {
    u32x4 w; w.x = pk2(p[0], p[1]); w.y = pk2(p[2], p[3]); w.z = pk2(p[4], p[5]); w.w = pk2(p[6], p[7]);
    return __builtin_bit_cast(bf16x8, w);
}
DI const float* xrow_ptr(const float* xp, const float* xs, int t) { return t < PROMPT ? xp + (size_t)t * DM : xs + (size_t)(t - PROMPT) * DM; }
DI bool seq_start(int t) { return t == 0 || (t >= PROMPT && (t & 4095) == 0); }

namespace pg8 {
constexpr int BM = 256, BK = 64, HALF = 128, HTB = HALF * BK * 2, STAGE_BYTES = 8 * HTB, NXCD = 8, WGM = 8;
DI int lds_byte(int r, int c) { const int st = (r >> 4) * 2 + (c >> 5), rr = r & 15, cc = c & 31, ob = rr * 64 + cc * 2; return st * 1024 + (ob ^ (((ob >> 9) & 1) << 5)); }
DI void stage_rc(int b, int& R, int& C) { const int st = b / 1024, sb = b % 1024, swz = sb ^ (((sb >> 9) & 1) << 5); R = (st >> 1) * 16 + swz / 64; C = (st & 1) * 32 + (swz % 64) / 2; }
DI int perm32(int rho) { const int n = rho >> 4, i = rho & 15; return 8 * (i >> 2) + 4 * n + (i & 3); }

struct Unit { int pm, pn, sel; };
struct Gemm { const bf16_t* A; const bf16_t* Bt; const bf16_t* A2; const bf16_t* Bt2; int K; int ntk = 0; };

struct StaticOrder {
    int nM, nN, nwg, G, c;
    DI void init(int nM_, int nN_, int G_, int c_) { nM = nM_; nN = nN_; nwg = nM * nN; G = G_; c = c_; }
    DI bool next(int i, Unit& u) const {
        const long L = (long)i * G + c; if (L >= nwg) return false;
        int wgid = (int)L; { const int q = nwg / NXCD, r = nwg % NXCD, xcd = wgid % NXCD, off = wgid / NXCD; wgid = (xcd < r ? xcd * (q + 1) : r * (q + 1) + (xcd - r) * q) + off; }
        const int nig = WGM * nN, gid = wgid / nig, fm = gid * WGM, gsz = (nM - fm) < WGM ? (nM - fm) : WGM;
        u.pm = fm + ((wgid % nig) % gsz); u.pn = (wgid % nig) / gsz; u.sel = 0; return true;
    }
};
struct DupOrder { StaticOrder s; int dup; DI bool next(int i, Unit& u) const { return s.next(dup ? (i >> 1) : i, u); } };
struct TileOrder { int pm, pn; DI bool next(int i, Unit& u) const { if (i >= 2) return false; u.pm = pm; u.pn = pn; u.sel = i; return true; } };
struct PairOrder {
    StaticOrder s;
    DI bool next(int i, Unit& u) const { if (!s.next(i >> 1, u)) return false; u.sel = i & 1; return true; }
};

template <class Epi, class Sched, bool ALIGN_EPI, bool CONVA>
DI void gemm_phase(LAS unsigned char* lds, const Gemm g, const Sched& S, const Epi& E) {
    const int tid = threadIdx.x, wid = __builtin_amdgcn_readfirstlane(tid >> 6), lane = tid & 63, wr = wid >> 2, wc = wid & 3, fr = lane & 15, fq = lane >> 4;
    const int K = g.K; const int nt = g.ntk ? g.ntk : K / BK;
    unsigned voffA[2], voffB[2];
#pragma unroll
    for (int i = 0; i < 2; ++i) { int R, C; stage_rc(tid * 16 + i * 8192, R, C); const int Rb = Epi::PERM ? ((R & ~31) + perm32(R & 31)) : R;
        const int Ra = CONVA ? (128 * (R >> 6) + 8 * (R & 15) + ((R >> 4) & 3)) : R;
        voffA[i] = (unsigned)(Ra * K + C) * 2u; voffB[i] = (unsigned)(Rb * K + C) * 2u; }
    const size_t kstep = (size_t)(BK * 2);
    const size_t hstepB = (size_t)HALF * K * 2, tstepB = 2 * hstepB;
    const size_t hstepA = CONVA ? (size_t)4 * K * 2 : hstepB, tstepA = CONVA ? (size_t)254 * K * 2 : tstepB;
    const long abias = CONVA ? -(long)K * 2 : 0;
    const unsigned ldsw = (unsigned)wid * 1024u;
    const int aoff = lds_byte(wr * 64 + fr, fq * 8), boff = lds_byte(wc * 32 + fr, fq * 8);
#define PG8_SA(b, h) (((b) * 2 + (h)) * HTB)
#define PG8_SB(b, h) ((4 + (b) * 2 + (h)) * HTB)
#define PG8_STAGE(bufoff, gbase, voff) do { _Pragma("unroll") for (int _i = 0; _i < 2; ++_i) \
        __builtin_amdgcn_global_load_lds((const unsigned*)((const char*)(gbase) + (voff)[_i]), (LAS unsigned*)(lds + (bufoff) + ldsw + _i * 8192), 16, 0, 0); } while (0)
#define PG8_LDA(dst, b, h) do { _Pragma("unroll") for (int m = 0; m < 4; ++m) _Pragma("unroll") for (int k = 0; k < 2; ++k) dst[m][k] = *(const LAS bf16x8*)(lds + PG8_SA(b, h) + aoff + m * 2048 + k * 1024); } while (0)
#define PG8_LDB(dst, b, h) do { _Pragma("unroll") for (int n = 0; n < 2; ++n) _Pragma("unroll") for (int k = 0; k < 2; ++k) dst[n][k] = *(const LAS bf16x8*)(lds + PG8_SB(b, h) + boff + n * 2048 + k * 1024); } while (0)
#define PG8_MMA(ai, bj, At, Bt) do { __builtin_amdgcn_s_setprio(1); _Pragma("unroll") for (int m = 0; m < 4; ++m) _Pragma("unroll") for (int n = 0; n < 2; ++n) _Pragma("unroll") for (int k = 0; k < 2; ++k) \
        acc[ai][bj][m][n] = __builtin_amdgcn_mfma_f32_16x16x32_bf16(Bt[n][k], At[m][k], acc[ai][bj][m][n], 0, 0, 0); __builtin_amdgcn_s_setprio(0); } while (0)
#define PG8_WAIT_V(n) asm volatile("s_waitcnt vmcnt(" #n ")" ::: "memory")
#define PG8_WAIT_L(n) asm volatile("s_waitcnt lgkmcnt(" #n ")" ::: "memory")
#define PG8_WAIT_VN(n) asm volatile("s_waitcnt vmcnt(%0)" :: "n"(n) : "memory")
#define PG8_BAR __builtin_amdgcn_s_barrier()
#define PG8_SCHED __builtin_amdgcn_sched_barrier(0)
    Unit cur, nxt; int ui = 0;
    if (!S.next(0, cur)) return;
    f32x4 acc[2][2][4][2];
#pragma unroll
    for (int a = 0; a < 2; ++a)
#pragma unroll
        for (int b = 0; b < 2; ++b)
#pragma unroll
            for (int m = 0; m < 4; ++m)
#pragma unroll
                for (int n = 0; n < 2; ++n) acc[a][b][m][n] = (f32x4){0.f, 0.f, 0.f, 0.f};
    bf16x8 At[4][2], B0[2][2], B1[2][2];
    const char* cA = (const char*)(cur.sel ? g.A2 : g.A) + (size_t)cur.pm * tstepA + abias; const char* cB = (const char*)(cur.sel ? g.Bt2 : g.Bt) + (size_t)cur.pn * tstepB;
    PG8_STAGE(PG8_SB(0, 0), cB, voffB); PG8_STAGE(PG8_SB(0, 1), cB + hstepB, voffB); PG8_STAGE(PG8_SA(0, 0), cA, voffA); PG8_STAGE(PG8_SA(0, 1), cA + hstepA, voffA);
    if (wr == 1) PG8_BAR;
    PG8_WAIT_V(2); PG8_BAR;
    PG8_STAGE(PG8_SB(1, 0), cB + kstep, voffB); PG8_STAGE(PG8_SA(1, 0), cA + kstep, voffA); PG8_STAGE(PG8_SB(1, 1), cB + hstepB + kstep, voffB);
    PG8_WAIT_V(6); PG8_BAR;
    for (;;) {
        const bool has_next = S.next(ui + 1, nxt);
        const char* nA = has_next ? (const char*)(nxt.sel ? g.A2 : g.A) + (size_t)nxt.pm * tstepA + abias : cA;
        const char* nB = has_next ? (const char*)(nxt.sel ? g.Bt2 : g.Bt) + (size_t)nxt.pn * tstepB : cB;
#define PG8_KBODY(W12) do { \
            PG8_LDB(B0, 0, 0); PG8_LDB(B1, 0, 1); PG8_SCHED; PG8_LDA(At, 0, 0); PG8_STAGE(PG8_SA(1, 1), a1 + hstepA, voffA); \
            W12; PG8_WAIT_L(0); PG8_BAR; PG8_MMA(0, 0, At, B0); PG8_MMA(0, 1, At, B1); PG8_BAR; PG8_SCHED; \
            PG8_LDA(At, 0, 1); PG8_STAGE(PG8_SB(0, 0), b2, voffB); PG8_STAGE(PG8_SB(0, 1), b2 + hstepB, voffB); PG8_STAGE(PG8_SA(0, 0), a2, voffA); \
            W12; PG8_WAIT_L(0); PG8_BAR; PG8_MMA(1, 0, At, B0); PG8_MMA(1, 1, At, B1); PG8_BAR; PG8_SCHED; \
            PG8_LDB(B0, 1, 0); PG8_LDB(B1, 1, 1); PG8_SCHED; PG8_LDA(At, 1, 0); PG8_STAGE(PG8_SA(0, 1), a2 + hstepA, voffA); \
            PG8_WAIT_V(8); PG8_WAIT_L(0); PG8_BAR; PG8_MMA(0, 0, At, B0); PG8_MMA(0, 1, At, B1); PG8_BAR; PG8_SCHED; \
            PG8_LDA(At, 1, 1); PG8_STAGE(PG8_SB(1, 0), b3, voffB); PG8_STAGE(PG8_SB(1, 1), b3 + hstepB, voffB); PG8_STAGE(PG8_SA(1, 0), a3, voffA); \
            PG8_WAIT_V(8); PG8_WAIT_L(0); PG8_BAR; PG8_MMA(1, 0, At, B0); PG8_MMA(1, 1, At, B1); PG8_BAR; PG8_SCHED; } while (0)
        for (int t = 0; t < nt; t += 2) {
            const bool last = (t == nt - 2);
            const char* a1 = cA + (size_t)(t + 1) * kstep;
            const char* a2 = last ? nA : cA + (size_t)(t + 2) * kstep; const char* b2 = last ? nB : cB + (size_t)(t + 2) * kstep;
            const char* a3 = a2 + kstep; const char* b3 = b2 + kstep;
            PG8_KBODY(PG8_WAIT_V(8));
        }
#undef PG8_KBODY
        if constexpr (ALIGN_EPI) { if (wr == 0) PG8_BAR; }
        E(acc, cur, wr, wc, fr, fq);
        if (!has_next) break;
        if (!E.keep(cur)) {
#pragma unroll
            for (int a = 0; a < 2; ++a)
#pragma unroll
                for (int b = 0; b < 2; ++b)
#pragma unroll
                    for (int m = 0; m < 4; ++m)
#pragma unroll
                        for (int n = 0; n < 2; ++n) acc[a][b][m][n] = (f32x4){0.f, 0.f, 0.f, 0.f};
        }
        cur = nxt; cA = nA; cB = nB; ++ui;
        if constexpr (ALIGN_EPI) { if (wr == 1) PG8_BAR; }
    }
    PG8_WAIT_V(0);
    if constexpr (!ALIGN_EPI) { if (wr == 0) PG8_BAR; }
    PG8_BAR;
#undef PG8_SA
#undef PG8_SB
#undef PG8_STAGE
#undef PG8_LDA
#undef PG8_LDB
#undef PG8_MMA
#undef PG8_WAIT_V
#undef PG8_WAIT_L
#undef PG8_WAIT_VN
#undef PG8_BAR
#undef PG8_SCHED
}

struct EpiProj {
    static constexpr bool PERM = true; static constexpr int NVM = 16;
    unsigned char* ws;
    DI bool keep(const Unit&) const { return false; }
    DI void operator()(f32x4 (&acc)[2][2][4][2], const Unit& u, int wr, int wc, int fr, int fq) const {
        const int ct = u.pn; bf16_t* base; int ldc, colt;
        if (ct < 8) { base = (bf16_t*)(ws + WS_MQ + (size_t)(ct >> 1) * (80 * MiB)); ldc = 512; colt = (ct & 1) * 256; }
        else if (ct < 10) { base = (bf16_t*)(ws + WS_AQ); ldc = 512; colt = (ct - 8) * 256; }
        else if (ct == 10) { base = (bf16_t*)(ws + WS_AK); ldc = 256; colt = 0; }
        else if (ct == 11) { base = (bf16_t*)(ws + WS_AV); ldc = 256; colt = 0; }
        else if (ct < 16) { base = (bf16_t*)(ws + WS_GM); ldc = 1024; colt = (ct - 12) * 256; }
        else { base = (bf16_t*)(ws + WS_GA); ldc = 1024; colt = (ct - 16) * 256; }
        const int row0 = u.pm * BM + wr * 64 + fr, col0 = colt + wc * 32 + 8 * fq;
#pragma unroll
        for (int ai = 0; ai < 2; ++ai)
#pragma unroll
            for (int m = 0; m < 4; ++m) { bf16_t* rowp = base + (size_t)(row0 + ai * HALF + m * 16) * ldc + col0;
#pragma unroll
                for (int bj = 0; bj < 2; ++bj) { const f32x4 v0 = acc[ai][bj][m][0], v1 = acc[ai][bj][m][1];
                    u32x4 w; w.x = cvt_pk_bf16(v0[0], v0[1]); w.y = cvt_pk_bf16(v0[2], v0[3]); w.z = cvt_pk_bf16(v1[0], v1[1]); w.w = cvt_pk_bf16(v1[2], v1[3]);
                    *(u32x4*)(rowp + bj * HALF) = w; } }
    }
};
#define PG8_SCR_SETUP const unsigned lo16 = (threadIdx.x & 63u) * 16u; const int wid_ = __builtin_amdgcn_readfirstlane(threadIdx.x >> 6); \
        unsigned char* sa_u = scr + ((size_t)(blockIdx.x * 2 + 0) * 8 + wid_) * 16384; unsigned char* sb_u = scr + ((size_t)(blockIdx.x * 2 + 1) * 8 + wid_) * 16384;
#define sa(k) (sa_u + (k) * 1024 + lo16)
#define sb(k) (sb_u + (k) * 1024 + lo16)
struct EpiGate {
    static constexpr bool PERM = true; static constexpr int NVM = 16;
    unsigned char* scr;
    DI bool keep(const Unit&) const { return false; }
    DI void operator()(f32x4 (&acc)[2][2][4][2], const Unit& u, int wr, int wc, int fr, int fq) const {
        PG8_SCR_SETUP
        if (u.sel == 0) {
#pragma unroll
            for (int ai = 0; ai < 2; ++ai)
#pragma unroll
                for (int m = 0; m < 4; ++m)
#pragma unroll
                    for (int bj = 0; bj < 2; ++bj) { float v[8];
#pragma unroll
                        for (int e = 0; e < 8; ++e) v[e] = sigmoidf_(acc[ai][bj][m][e >> 2][e & 3]);
                        u32x4 w; w.x = pk2(v[0], v[1]); w.y = pk2(v[2], v[3]); w.z = pk2(v[4], v[5]); w.w = pk2(v[6], v[7]);
                        *(u32x4*)sa(ai * 8 + m * 2 + bj) = w; }
        } else {
#pragma unroll
            for (int ai = 0; ai < 2; ++ai) {
                u32x4 A8[4][2];
#pragma unroll
                for (int m = 0; m < 4; ++m)
#pragma unroll
                    for (int bj = 0; bj < 2; ++bj) A8[m][bj] = *(const u32x4*)sa(ai * 8 + m * 2 + bj);
#pragma unroll
                for (int m = 0; m < 4; ++m)
#pragma unroll
                    for (int bj = 0; bj < 2; ++bj) { float r[8], b[8];
#pragma unroll
                        for (int e = 0; e < 8; ++e) { const float av = (e & 1) ? bfhi(A8[m][bj][e >> 1]) : bflo(A8[m][bj][e >> 1]); const float den = 1.f + __expf(-acc[ai][bj][m][e >> 2][e & 3]);
                            b[e] = __builtin_amdgcn_rcpf(den); r[e] = av * den; }
                        u32x4 wr_, wb_; wr_.x = pk2(r[0], r[1]); wr_.y = pk2(r[2], r[3]); wr_.z = pk2(r[4], r[5]); wr_.w = pk2(r[6], r[7]);
                        wb_.x = pk2(b[0], b[1]); wb_.y = pk2(b[2], b[3]); wb_.z = pk2(b[4], b[5]); wb_.w = pk2(b[6], b[7]);
                        *(u32x4*)sa(ai * 8 + m * 2 + bj) = wr_; *(u32x4*)sb(ai * 8 + m * 2 + bj) = wb_; }
            }
        }
    }
};
struct EpiMix {
    static constexpr bool PERM = true; static constexpr int NVM = 16;
    bf16_t* Y; unsigned char* scr;
    DI bool keep(const Unit& u) const { return u.sel == 0; }
    DI void operator()(f32x4 (&acc)[2][2][4][2], const Unit& u, int wr, int wc, int fr, int fq) const {
        PG8_SCR_SETUP
        if (u.sel == 0) {
#pragma unroll
            for (int ai = 0; ai < 2; ++ai) {
                u32x4 A8[4][2];
#pragma unroll
                for (int m = 0; m < 4; ++m)
#pragma unroll
                    for (int bj = 0; bj < 2; ++bj) A8[m][bj] = *(const u32x4*)sa(ai * 8 + m * 2 + bj);
#pragma unroll
                for (int m = 0; m < 4; ++m)
#pragma unroll
                    for (int bj = 0; bj < 2; ++bj)
#pragma unroll
                        for (int e = 0; e < 8; ++e) { const float rv = (e & 1) ? bfhi(A8[m][bj][e >> 1]) : bflo(A8[m][bj][e >> 1]); acc[ai][bj][m][e >> 2][e & 3] *= rv; }
            }
        } else {
            const int row0 = u.pm * BM + wr * 64 + fr, col0 = u.pn * BM + wc * 32 + 8 * fq;
#pragma unroll
            for (int ai = 0; ai < 2; ++ai) {
                u32x4 B8[4][2];
#pragma unroll
                for (int m = 0; m < 4; ++m)
#pragma unroll
                    for (int bj = 0; bj < 2; ++bj) B8[m][bj] = *(const u32x4*)sb(ai * 8 + m * 2 + bj);
#pragma unroll
                for (int m = 0; m < 4; ++m)
#pragma unroll
                    for (int bj = 0; bj < 2; ++bj) { float v[8];
#pragma unroll
                        for (int e = 0; e < 8; ++e) { const float bv = (e & 1) ? bfhi(B8[m][bj][e >> 1]) : bflo(B8[m][bj][e >> 1]); v[e] = acc[ai][bj][m][e >> 2][e & 3] * bv; }
                        u32x4 w; w.x = pk2(v[0], v[1]); w.y = pk2(v[2], v[3]); w.z = pk2(v[4], v[5]); w.w = pk2(v[6], v[7]);
                        *(u32x4*)(Y + (size_t)(row0 + ai * HALF + m * 16) * DM + col0 + bj * HALF) = w; }
            }
        }
    }
};
#undef PG8_SCR_SETUP
#undef sa
#undef sb
template <bool WITH_HN> struct EpiRes {
    static constexpr bool PERM = true; static constexpr int NVM = 16;
    const float* xp; const float* xs; float* out; bf16_t* hn; float* ss;
    DI bool keep(const Unit&) const { return false; }
    template <int Q> DI void ld(f32x4 (&B)[2][2][2], const Unit& u, int wr, int fr, int cb0) const {
#pragma unroll
        for (int mm = 0; mm < 2; ++mm) { const int t = u.pm * BM + (Q >> 1) * HALF + wr * 64 + (2 * (Q & 1) + mm) * 16 + fr; const float* br = xrow_ptr(xp, xs, t);
#pragma unroll
            for (int bj = 0; bj < 2; ++bj)
#pragma unroll
                for (int n = 0; n < 2; ++n) B[mm][bj][n] = *(const f32x4*)(br + cb0 + bj * HALF + 4 * n); }
    }
    template <int Q> DI void st(const f32x4 (&B)[2][2][2], const f32x4 (&acc)[2][2][4][2], const Unit& u, int wr, int wc, int fr, int fq, int cb0) const {
#pragma unroll
        for (int mm = 0; mm < 2; ++mm) { const int m = 2 * (Q & 1) + mm, ai = Q >> 1; const int t = u.pm * BM + ai * HALF + wr * 64 + m * 16 + fr; float ssq = 0.f;
#pragma unroll
            for (int bj = 0; bj < 2; ++bj) { const int c = cb0 + bj * HALF;
                const f32x4 h0 = B[mm][bj][0] + acc[ai][bj][m][0], h1 = B[mm][bj][1] + acc[ai][bj][m][1];
                ssq += ((h0[0] * h0[0] + h0[1] * h0[1]) + (h0[2] * h0[2] + h0[3] * h0[3])) + ((h1[0] * h1[0] + h1[1] * h1[1]) + (h1[2] * h1[2] + h1[3] * h1[3]));
                u32x4 w; w.x = cvt_pk_bf16(h0[0], h0[1]); w.y = cvt_pk_bf16(h0[2], h0[3]); w.z = cvt_pk_bf16(h1[0], h1[1]); w.w = cvt_pk_bf16(h1[2], h1[3]); *(u32x4*)(hn + (size_t)t * DM + c) = w; }
            ssq += __shfl_xor(ssq, 16); ssq += __shfl_xor(ssq, 32); if (fq == 0) ss[(size_t)t * 16 + u.pn * 4 + wc] = ssq; }
    }
    DI void operator()(f32x4 (&acc)[2][2][4][2], const Unit& u, int wr, int wc, int fr, int fq) const {
        const int cb0 = u.pn * BM + wc * 32 + 8 * fq;
        f32x4 B0[2][2][2], B1[2][2][2];
        ld<0>(B0, u, wr, fr, cb0); ld<1>(B1, u, wr, fr, cb0);
        st<0>(B0, acc, u, wr, wc, fr, fq, cb0); ld<2>(B0, u, wr, fr, cb0);
        st<1>(B1, acc, u, wr, wc, fr, fq, cb0); ld<3>(B1, u, wr, fr, cb0);
        st<2>(B0, acc, u, wr, wc, fr, fq, cb0); st<3>(B1, acc, u, wr, wc, fr, fq, cb0);
    }
};
DI float dpp_ror1(float x) { return __builtin_bit_cast(float, __builtin_amdgcn_update_dpp(0, __builtin_bit_cast(int, x), 0x121, 0xf, 0xf, false)); }
DI float dpp_rol1(float x) { return __builtin_bit_cast(float, __builtin_amdgcn_update_dpp(0, __builtin_bit_cast(int, x), 0x12F, 0xf, 0xf, false)); }
struct EpiConv {
    static constexpr bool PERM = true; static constexpr int NVM = 0;
    bf16_t* G; const float* ss; const float* cw; const float* cb; LAS float* xch;
    DI bool keep(const Unit&) const { return false; }
    DI void operator()(f32x4 (&acc)[2][2][4][2], const Unit& u, int wr, int wc, int fr, int fq) const {
        const int t0 = 254 * u.pm - 1 + 128 * wr + 8 * fr;
        unsigned upz = 0, dnz = 0, stm = 0;
        f32x4 P8[8];
#pragma unroll
        for (int idx = 0; idx < 8; ++idx) { const int t = t0 + idx; const int tc = t < 0 ? 0 : (t >= MTOK ? MTOK - 1 : t); P8[idx] = *(const f32x4*)(ss + (size_t)tc * 16 + 4 * fq); }
#pragma unroll
        for (int idx = 0; idx < 8; ++idx) { const int rho = 128 * wr + 8 * fr + idx, t = t0 + idx;
            const f32x4 p = P8[idx]; float s = (p[0] + p[1]) + (p[2] + p[3]); s += __shfl_xor(s, 16); s += __shfl_xor(s, 32);
            const float rs = __builtin_amdgcn_rsqf(s * (1.f / DM) + EPS);
#pragma unroll
            for (int bj = 0; bj < 2; ++bj)
#pragma unroll
                for (int n = 0; n < 2; ++n) acc[idx >> 2][bj][idx & 3][n] *= rs;
            if (seq_start(t)) upz |= 1u << idx;
            if (t + 1 >= MTOK || seq_start(t + 1)) dnz |= 1u << idx;
            if (rho >= 1 && rho <= 254 && t < MTOK) stm |= 1u << idx; }
        const bool anyb = __builtin_amdgcn_ballot_w64((upz | dnz) != 0u) != 0ull;
        f32x4 X[2][2];
        { LAS float* xw = xch + ((wr * 4 + wc) * 4 + fq) * 16; LAS const float* xr = xch + (((wr ^ 1) * 4 + wc) * 4 + fq) * 16;
          if (wr == 0) { if (fr == 15) {
#pragma unroll
              for (int bj = 0; bj < 2; ++bj)
#pragma unroll
                  for (int n = 0; n < 2; ++n) *(LAS f32x4*)(xw + (bj * 2 + n) * 4) = acc[1][bj][3][n]; } }
          else { if (fr == 0) {
#pragma unroll
              for (int bj = 0; bj < 2; ++bj)
#pragma unroll
                  for (int n = 0; n < 2; ++n) *(LAS f32x4*)(xw + (bj * 2 + n) * 4) = acc[0][bj][0][n]; } }
          asm volatile("s_waitcnt lgkmcnt(0)" ::: "memory"); __builtin_amdgcn_s_barrier(); asm volatile("" ::: "memory");
#pragma unroll
          for (int bj = 0; bj < 2; ++bj)
#pragma unroll
              for (int n = 0; n < 2; ++n) X[bj][n] = *(LAS const f32x4*)(xr + (bj * 2 + n) * 4); }
        const bool xup = (wr == 1) && (fr == 0), xdn = (wr == 0) && (fr == 15);
        f32x4 W[2][4];
#define LOADW(n_) _Pragma("unroll") for (int bj = 0; bj < 2; ++bj) { const int cc = bj * DFF + u.pn * 128 + wc * 32 + 8 * fq + 4 * (n_); \
            W[bj][0] = *(const f32x4*)(cw + cc); W[bj][1] = *(const f32x4*)(cw + NUP + cc); W[bj][2] = *(const f32x4*)(cw + 2 * NUP + cc); W[bj][3] = *(const f32x4*)(cb + cc); }
        LOADW(0)
        unsigned pk[2][8][2];
#pragma unroll
        for (int n = 0; n < 2; ++n) {
            const int ch = u.pn * 128 + wc * 32 + 8 * fq + 4 * n;
            float ca[8][4];
#pragma unroll
            for (int bj = 0; bj < 2; ++bj) {
                const f32x4 w0 = W[bj][0], w1 = W[bj][1], w2 = W[bj][2], bb = W[bj][3];
#pragma unroll
                for (int jp = 0; jp < 2; ++jp) {
                    const f32n2 w0p = {w0[2 * jp], w0[2 * jp + 1]}, w1p = {w1[2 * jp], w1[2 * jp + 1]}, w2p = {w2[2 * jp], w2[2 * jp + 1]}, bbp = {bb[2 * jp], bb[2 * jp + 1]};
                    f32n2 v[8];
#pragma unroll
                    for (int idx = 0; idx < 8; ++idx) v[idx] = (f32n2){acc[idx >> 2][bj][idx & 3][n][2 * jp], acc[idx >> 2][bj][idx & 3][n][2 * jp + 1]};
                    f32n2 up0 = {dpp_ror1(v[7].x), dpp_ror1(v[7].y)}, dn7 = {dpp_rol1(v[0].x), dpp_rol1(v[0].y)};
                    if (xup) up0 = (f32n2){X[bj][n][2 * jp], X[bj][n][2 * jp + 1]};
                    if (xdn) dn7 = (f32n2){X[bj][n][2 * jp], X[bj][n][2 * jp + 1]};
                    f32n2 cv[8];
#pragma unroll
                    for (int idx = 0; idx < 8; ++idx) { f32n2 up = idx ? v[idx > 0 ? idx - 1 : 0] : up0, dn = idx < 7 ? v[idx < 7 ? idx + 1 : 7] : dn7;
                        if (anyb) { if ((upz >> idx) & 1u) up = (f32n2){0.f, 0.f}; if ((dnz >> idx) & 1u) dn = (f32n2){0.f, 0.f}; }
                        cv[idx] = w0p * up + (w1p * v[idx] + (w2p * dn + bbp)); }
                    if (bj == 0) {
#pragma unroll
                        for (int idx = 0; idx < 8; ++idx) { ca[idx][2 * jp] = cv[idx].x; ca[idx][2 * jp + 1] = cv[idx].y; }
                    } else {
#pragma unroll
                        for (int idx = 0; idx < 8; ++idx) { const f32n2 a2 = {ca[idx][2 * jp], ca[idx][2 * jp + 1]}; const f32n2 sg = {sigmoidf_(a2.x), sigmoidf_(a2.y)};
                            const f32n2 r2 = (a2 * sg) * cv[idx]; ca[idx][2 * jp] = r2.x; ca[idx][2 * jp + 1] = r2.y; }
                    } } }
#pragma unroll
            for (int idx = 0; idx < 8; ++idx) { pk[n][idx][0] = cvt_pk_bf16_asm(ca[idx][0], ca[idx][1]); pk[n][idx][1] = cvt_pk_bf16_asm(ca[idx][2], ca[idx][3]); }
            if (n == 0) { LOADW(1) }
            (void)ch;
        }
        { const int ch0 = u.pn * 128 + wc * 32 + 8 * fq;
#pragma unroll
          for (int idx = 0; idx < 8; ++idx) if ((stm >> idx) & 1u) { u32x4 w; w.x = pk[0][idx][0]; w.y = pk[0][idx][1]; w.z = pk[1][idx][0]; w.w = pk[1][idx][1]; *(u32x4*)(G + (size_t)(t0 + idx) * DFF + ch0) = w; } }
#undef LOADW
    }
};
struct EpiFinal {
    static constexpr bool PERM = true; static constexpr int NVM = 32;
    float* out; const bf16_t* hn; const float* nfw; unsigned* xs; unsigned* cnt;
    DI bool keep(const Unit&) const { return false; }
    template <int Q> DI void ld(f32x4 (&B)[2][2][2], const Unit& u, int wr, int fr, int cb0) const {
#pragma unroll
        for (int mm = 0; mm < 2; ++mm) { const int t = u.pm * BM + (Q >> 1) * HALF + wr * 64 + (2 * (Q & 1) + mm) * 16 + fr; const bf16_t* br = hn + (size_t)t * DM;
#pragma unroll
            for (int bj = 0; bj < 2; ++bj) { const u32x4 w = *(const u32x4*)(br + cb0 + bj * HALF);
                B[mm][bj][0] = (f32x4){bflo(w.x), bfhi(w.x), bflo(w.y), bfhi(w.y)}; B[mm][bj][1] = (f32x4){bflo(w.z), bfhi(w.z), bflo(w.w), bfhi(w.w)}; } }
    }
    template <int Q> DI void add(const f32x4 (&B)[2][2][2], f32x4 (&acc)[2][2][4][2], const Unit& u, int wr, int wc, int fr, int fq) const {
#pragma unroll
        for (int mm = 0; mm < 2; ++mm) { const int m = 2 * (Q & 1) + mm, ai = Q >> 1; const int t = u.pm * BM + ai * HALF + wr * 64 + m * 16 + fr; float ssq = 0.f;
#pragma unroll
            for (int bj = 0; bj < 2; ++bj)
#pragma unroll
                for (int n = 0; n < 2; ++n) { const f32x4 hv = B[mm][bj][n] + acc[ai][bj][m][n]; acc[ai][bj][m][n] = hv; ssq += (hv[0] * hv[0] + hv[1] * hv[1]) + (hv[2] * hv[2] + hv[3] * hv[3]); }
            ssq += __shfl_xor(ssq, 16); ssq += __shfl_xor(ssq, 32);
            if (fq == 0) __hip_atomic_store(xs + (size_t)t * 16 + u.pn * 4 + wc, __float_as_uint(ssq), __ATOMIC_RELAXED, __HIP_MEMORY_SCOPE_AGENT); }
    }
    DI void operator()(f32x4 (&acc)[2][2][4][2], const Unit& u, int wr, int wc, int fr, int fq) const {
        const int lane = threadIdx.x & 63, cb0 = u.pn * BM + wc * 32 + 8 * fq;
        { f32x4 B0[2][2][2], B1[2][2][2];
          ld<0>(B0, u, wr, fr, cb0); ld<1>(B1, u, wr, fr, cb0);
          add<0>(B0, acc, u, wr, wc, fr, fq); ld<2>(B0, u, wr, fr, cb0);
          add<1>(B1, acc, u, wr, wc, fr, fq); ld<3>(B1, u, wr, fr, cb0);
          add<2>(B0, acc, u, wr, wc, fr, fq); add<3>(B1, acc, u, wr, wc, fr, fq); }
        asm volatile("s_waitcnt vmcnt(0)" ::: "memory");
        unsigned* cw_ = cnt + 64 * u.pm;
        if (lane == 0) __hip_atomic_fetch_add(cw_, 1u, __ATOMIC_RELAXED, __HIP_MEMORY_SCOPE_AGENT);
        f32x4 W4[2][2];
#pragma unroll
        for (int bj = 0; bj < 2; ++bj)
#pragma unroll
            for (int n = 0; n < 2; ++n) W4[bj][n] = *(const f32x4*)(nfw + cb0 + bj * HALF + 4 * n);
        while ((unsigned)__builtin_amdgcn_readfirstlane(__hip_atomic_load(cw_, __ATOMIC_RELAXED, __HIP_MEMORY_SCOPE_AGENT)) < 32u) __builtin_amdgcn_s_sleep(2);
        asm volatile("" ::: "memory");
        unsigned Pp[8][4];
#pragma unroll
        for (int idx = 0; idx < 8; ++idx) { const int t = u.pm * BM + (idx >> 2) * HALF + wr * 64 + (idx & 3) * 16 + fr; const unsigned* xp_ = xs + (size_t)t * 16 + 4 * fq;
#pragma unroll
            for (int q = 0; q < 4; ++q) Pp[idx][q] = __hip_atomic_load(xp_ + q, __ATOMIC_RELAXED, __HIP_MEMORY_SCOPE_AGENT); }
#pragma unroll
        for (int idx = 0; idx < 8; ++idx) { const int ai = idx >> 2, m = idx & 3; const int t = u.pm * BM + ai * HALF + wr * 64 + m * 16 + fr; float* orow = out + (size_t)t * DM;
            float s = (__uint_as_float(Pp[idx][0]) + __uint_as_float(Pp[idx][1])) + (__uint_as_float(Pp[idx][2]) + __uint_as_float(Pp[idx][3]));
            s += __shfl_xor(s, 16); s += __shfl_xor(s, 32);
            const float rs = 1.f / sqrtf(s * (1.f / DM) + EPS);
#pragma unroll
            for (int bj = 0; bj < 2; ++bj)
#pragma unroll
                for (int n = 0; n < 2; ++n) *(f32x4*)(orow + cb0 + bj * HALF + 4 * n) = acc[ai][bj][m][n] * rs * W4[bj][n]; }
    }
};
}

DI void transpose_item(const float* W, int ldw, int src_col0, int k0, bf16_t* WT, int K, int dst_row0, const float* kscale, float nscale, LAS float* scr, int lane) {
    float wv[32];
#pragma unroll
    for (int i = 0; i < 32; ++i) { const int kk = 2 * i + (lane >> 5); wv[i] = W[(size_t)(k0 + kk) * ldw + src_col0 + (lane & 31)]; }
#pragma unroll
    for (int i = 0; i < 32; ++i) { const int kk = 2 * i + (lane >> 5); const float s = kscale ? kscale[k0 + kk] * nscale : nscale;
        scr[kk * 33 + (lane & 31)] = wv[i] * s; }
    asm volatile("s_waitcnt lgkmcnt(0)" ::: "memory");
    const int c = lane & 7;
#pragma unroll
    for (int j = 0; j < 4; ++j) { const int n = (lane >> 3) + 8 * j; const LAS float* s = scr + (8 * c) * 33 + n;
        u32x4 o; o.x = pk2(s[0 * 33], s[1 * 33]); o.y = pk2(s[2 * 33], s[3 * 33]); o.z = pk2(s[4 * 33], s[5 * 33]); o.w = pk2(s[6 * 33], s[7 * 33]);
        *(u32x4*)(WT + (size_t)(dst_row0 + n) * K + k0 + 8 * c) = o; }
    asm volatile("s_waitcnt lgkmcnt(0)" ::: "memory");
}
DI float reduce16(const float (&p)[16], int lane) {
    const bool b5 = lane & 32, b4 = lane & 16, b3 = lane & 8, b2 = lane & 4;
    float q[8], r[4], s[2];
#pragma unroll
    for (int j = 0; j < 8; ++j) { const float send = b5 ? p[j] : p[j + 8], keep = b5 ? p[j + 8] : p[j]; q[j] = keep + __shfl_xor(send, 32); }
#pragma unroll
    for (int j = 0; j < 4; ++j) { const float send = b4 ? q[j] : q[j + 4], keep = b4 ? q[j + 4] : q[j]; r[j] = keep + __shfl_xor(send, 16); }
#pragma unroll
    for (int j = 0; j < 2; ++j) { const float send = b3 ? r[j] : r[j + 2], keep = b3 ? r[j + 2] : r[j]; s[j] = keep + __shfl_xor(send, 8); }
    const float send = b2 ? s[0] : s[1], keep = b2 ? s[1] : s[0]; float v = keep + __shfl_xor(send, 4);
    v += __shfl_xor(v, 2); v += __shfl_xor(v, 1); return v;
}

struct ChunkVec { float g0, g1, b0, b1, cm0, cm1, btot, gmax; int s0, s1; };
struct ChunkGates { float i0, f0, i1, f1; int s0, s1; };
DI ChunkGates chunk_gates_load(int d, const float* gates, int t0, int head, int lane) {
    ChunkGates q; const int e0 = 2 * lane, e1 = e0 + 1; q.s0 = d ? 127 - e0 : e0; q.s1 = d ? 127 - e1 : e1;
    const float* g0p = gates + (size_t)(t0 + q.s0) * 16 + d * 4 + head; const float* g1p = gates + (size_t)(t0 + q.s1) * 16 + d * 4 + head;
    q.i0 = g0p[0]; q.f0 = g0p[8]; q.i1 = g1p[0]; q.f1 = g1p[8]; return q;
}
DI ChunkVec chunk_vectors_from(const ChunkGates& q, int lane) {
    ChunkVec r; r.s0 = q.s0; r.s1 = q.s1;
    const float i0 = q.i0, f0 = q.f0, i1 = q.i1, f1 = q.f1;
    const float lf0 = logsigmoid_(f0), lf1 = logsigmoid_(f1);
    float ps = lf0 + lf1;
#pragma unroll
    for (int o = 1; o < 64; o <<= 1) { const float t = __shfl_up(ps, o); if (lane >= o) ps += t; }
    const float excl = ps - (lf0 + lf1); r.b0 = excl + lf0; r.b1 = r.b0 + lf1;
    r.g0 = i0 - r.b0; r.g1 = i1 - r.b1;
    float cm = fmaxf(r.g0, r.g1);
#pragma unroll
    for (int o = 1; o < 64; o <<= 1) { const float t = __shfl_up(cm, o); if (lane >= o) cm = fmaxf(cm, t); }
    float ex = __shfl_up(cm, 1); if (lane == 0) ex = -INFINITY;
    r.cm0 = fmaxf(ex, r.g0); r.cm1 = fmaxf(r.cm0, r.g1);
    r.btot = __shfl(r.b1, 63); r.gmax = __shfl(r.cm1, 63);
    return r;
}
DI ChunkVec chunk_vectors(int d, const float* gates, int t0, int head, int lane) { return chunk_vectors_from(chunk_gates_load(d, gates, t0, head, lane), lane); }

struct Ctx {
    const float* in[17]; float* out; unsigned char* ws;
};

DI void summary_prefetch(const Ctx& c, int chunk, int head, int tid, u32x4 (&v8r)[4], u32x4 (&k8r)[4]) {
    const bf16_t* MK = (const bf16_t*)(c.ws + WS_MK); const bf16_t* MV = (const bf16_t*)(c.ws + WS_MV); const int t0 = chunk * 128;
#pragma unroll
    for (int i = 0; i < 4; ++i) { const int idx = tid + 512 * i, s = idx & 127, ch = idx >> 7; const size_t go = (size_t)(t0 + s) * 512 + head * 128 + ch * 8; v8r[i] = *(const u32x4*)(MV + go); k8r[i] = *(const u32x4*)(MK + go); }
}
DI void summary_unit(LAS unsigned char* lds, const Ctx& c, int chunk, int head, int nchunk, int nhead, u32x4 (&v8r)[4], u32x4 (&k8r)[4], int tid, int lane, int wid) {
    asm volatile("" : "+v"(tid), "+v"(lane));
    const int t0 = chunk * 128, fr = lane & 15, fq = lane >> 4;
    LAS bf16_t* LVT = (LAS bf16_t*)lds; LAS bf16_t* LKF = (LAS bf16_t*)(lds + 34816); LAS bf16_t* LKB = (LAS bf16_t*)(lds + 69632); LAS float* vW = (LAS float*)(lds + 104448);
    const float* gates = (const float*)(c.ws + WS_GATES);
    const bf16_t* MK = (const bf16_t*)(c.ws + WS_MK); const bf16_t* MV = (const bf16_t*)(c.ws + WS_MV);
    if (wid < 2) { const int d = wid; const ChunkVec v = chunk_vectors(d, gates, t0, head, lane);
        vW[d * 128 + v.s0] = __expf(v.g0 - v.gmax); vW[d * 128 + v.s1] = __expf(v.g1 - v.gmax);
        if (lane == 0) { float* sc = (float*)(c.ws + WS_CHSC) + ((size_t)(d * NCHUNK + chunk) * 4 + head) * 2; sc[0] = v.btot; sc[1] = v.btot + v.gmax; } }
    __syncthreads();
#pragma unroll
    for (int i = 0; i < 4; ++i) { const int idx = tid + 512 * i, s = idx & 127, ch = idx >> 7;
        const u32x4 v8 = v8r[i], k8 = k8r[i]; const float wf = vW[s], wb = vW[128 + s];
#pragma unroll
        for (int e = 0; e < 8; ++e) { const unsigned vw = v8[e >> 1], kw = k8[e >> 1]; const float kf = (e & 1) ? bfhi(kw) : bflo(kw);
            LVT[(8 * ch + e) * 136 + s] = (bf16_t)((e & 1) ? (vw >> 16) : (vw & 0xffffu));
            const unsigned fb = pk2(wf * kf, wb * kf); LKF[(8 * ch + e) * 136 + s] = (bf16_t)(fb & 0xffffu); LKB[(8 * ch + e) * 136 + s] = (bf16_t)(fb >> 16); } }
    summary_prefetch(c, nchunk, nhead, tid, v8r, k8r);
    __syncthreads();
    const int d = wid & 1, cgp = wid >> 1;
    LAS const unsigned char* LKD = (LAS const unsigned char*)(d ? LKB : LKF);
    bf16x8 Y[2][4];
#pragma unroll
    for (int ci = 0; ci < 2; ++ci)
#pragma unroll
        for (int ks = 0; ks < 4; ++ks) Y[ci][ks] = *(LAS const bf16x8*)(LKD + (16 * (2 * cgp + ci) + fr) * 272 + (32 * ks + 8 * fq) * 2);
    bf16_t* ST = (bf16_t*)(c.out) + ((size_t)(d * NCHUNK + chunk) * 4 + head) * ST_ELEMS;
#pragma unroll
    for (int rt = 0; rt < 9; ++rt) {
        bf16x8 X[4];
#pragma unroll
        for (int ks = 0; ks < 4; ++ks) {
            if (rt < 8) X[ks] = *(LAS const bf16x8*)((LAS const unsigned char*)LVT + (16 * rt + fr) * 272 + (32 * ks + 8 * fq) * 2);
            else { const short o = fr == 0 ? (short)0x3F80 : (short)0; X[ks] = (bf16x8){o, o, o, o, o, o, o, o}; } }
#pragma unroll
        for (int ci = 0; ci < 2; ++ci) { f32x4 a = (f32x4){0.f, 0.f, 0.f, 0.f};
#pragma unroll
            for (int ks = 0; ks < 4; ++ks) a = MFMA16(Y[ci][ks], X[ks], a);
            const int v = 16 * rt + fr, k = 16 * (2 * cgp + ci) + 4 * fq;
            if (rt < 8 || fr == 0) { u32x2 w; w.x = pk2(a[0], a[1]); w.y = pk2(a[2], a[3]); *(u32x2*)(ST + (size_t)v * 128 + k) = w; } }
    }
    __syncthreads();
}

DI void attn_unit(LAS unsigned char* lds, const Ctx& c, int qb2, int hk, int tid, int lane, int wid) {
    asm volatile("" : "+v"(tid), "+v"(lane));
    const int t0 = qb2 * 256, fr = lane & 15, fq = lane >> 4;
    const int nseq = qb2 < 64 ? qb2 : ((qb2 - 64) & 15), Nseq = qb2 < 64 ? 64 : 16, pos0 = nseq * 256;
    const bool bv0 = nseq >= 1, bv3 = nseq + 1 < Nseq;
    LAS unsigned char* LKB = lds; LAS bf16_t* LVT = (LAS bf16_t*)(lds + 73728);
    const bf16_t* AK = (const bf16_t*)(c.ws + WS_AK); const bf16_t* AV = (const bf16_t*)(c.ws + WS_AV); const bf16_t* AQ = (const bf16_t*)(c.ws + WS_AQ);
    const float* rope = (const float*)(c.ws + WS_ROPE);
    const int g = wid >> 2, rg = wid & 3, hq = 2 * hk + g, r0 = 64 * rg;
#define ATT_OK(j) ((((j) >> 7) == 0) ? bv0 : ((((j) >> 7) == 3) ? bv3 : true))
    u32x4 kb[6];
#pragma unroll
    for (int i = 0; i < 6; ++i) { const int idx = tid + 512 * i; const int j = idx / 6, ch = 2 + (idx - 6 * j); const bool ok = ATT_OK(j);
        const int tok = ok ? t0 - 128 + j : t0 + (j & 127); kb[i] = *(const u32x4*)((const char*)AK + (unsigned)((tok * 256 + hk * 64 + ch * 8) * 2)); }
    u32x4 kx1, kx2; f32x4 ktb[4];
    { const int j = tid; const bool ok = ATT_OK(j); const int tok = ok ? t0 - 128 + j : t0 + (j & 127);
      const unsigned ko = (unsigned)((tok * 256 + hk * 64) * 2); kx1 = *(const u32x4*)((const char*)AK + ko); kx2 = *(const u32x4*)((const char*)AK + ko + 16u);
      const unsigned to = (unsigned)((ok ? pos0 - 128 + j : 0) * 64);
#pragma unroll
      for (int q = 0; q < 4; ++q) ktb[q] = *(const f32x4*)((const char*)rope + to + 16u * q); }
    u32x4 vb[8];
#pragma unroll
    for (int i = 0; i < 8; ++i) { const int idx = tid + 512 * i, ch = idx >> 9, j = idx & 511; const bool ok = ATT_OK(j);
        const int tok = ok ? t0 - 128 + j : t0 + (j & 127); vb[i] = *(const u32x4*)((const char*)AV + (unsigned)((tok * 256 + hk * 64 + ch * 8) * 2)); }
#pragma unroll
    for (int i = 0; i < 6; ++i) { const int idx = tid + 512 * i; const int j = idx / 6, ch = 2 + (idx - 6 * j); const bool ok = ATT_OK(j);
        *(LAS u32x4*)(LKB + j * 144 + ch * 16) = ok ? kb[i] : (u32x4){0u, 0u, 0u, 0u}; }
    { const int j = tid; const bool ok = ATT_OK(j);
      float ra[8], rb[8];
#pragma unroll
      for (int e = 0; e < 8; ++e) { const float a = (e & 1) ? bfhi(kx1[e >> 1]) : bflo(kx1[e >> 1]), b = (e & 1) ? bfhi(kx2[e >> 1]) : bflo(kx2[e >> 1]); const float cs = ktb[e >> 2][e & 3], sn = ktb[2 + (e >> 2)][e & 3];
          ra[e] = a * cs - b * sn; rb[e] = b * cs + a * sn; }
      u32x4 o1, o2; o1.x = pk2(ra[0], ra[1]); o1.y = pk2(ra[2], ra[3]); o1.z = pk2(ra[4], ra[5]); o1.w = pk2(ra[6], ra[7]); o2.x = pk2(rb[0], rb[1]); o2.y = pk2(rb[2], rb[3]); o2.z = pk2(rb[4], rb[5]); o2.w = pk2(rb[6], rb[7]);
      if (!ok) { o1 = (u32x4){0u, 0u, 0u, 0u}; o2 = o1; }
      *(LAS u32x4*)(LKB + j * 144) = o1; *(LAS u32x4*)(LKB + j * 144 + 16) = o2; }
#pragma unroll
    for (int i = 0; i < 8; ++i) { const int idx = tid + 512 * i, ch = idx >> 9, j = idx & 511; const bool ok = ATT_OK(j);
        const u32x4 v8 = ok ? vb[i] : (u32x4){0u, 0u, 0u, 0u};
#pragma unroll
        for (int e = 0; e < 8; ++e) { const unsigned vw = v8[e >> 1]; LVT[(8 * ch + e) * 520 + j] = (bf16_t)((e & 1) ? (vw >> 16) : (vw & 0xffffu)); } }
    asm volatile("" ::: "memory");
    const float sink = c.in[7][hq] * 1.4426950408889634f;
    bf16x8 Xq[4][2];
#pragma unroll
    for (int mi = 0; mi < 4; ++mi) { const int rho = r0 + 16 * mi + fr; const unsigned qo = (unsigned)(((t0 + rho) * 512 + hq * 64 + 8 * fq) * 2);
#pragma unroll
        for (int ks = 0; ks < 2; ++ks) {
            u32x4 q = *(const u32x4*)((const char*)AQ + qo + 64u * ks);
            if (ks == 0) { u32x4 pr; pr.x = __shfl_xor(q.x, 16); pr.y = __shfl_xor(q.y, 16); pr.z = __shfl_xor(q.z, 16); pr.w = __shfl_xor(q.w, 16);
                if (fq < 2) { float r[8]; const float* tb = rope + (size_t)(pos0 + rho) * 16;
#pragma unroll
                    for (int e = 0; e < 8; ++e) { const float own = (e & 1) ? bfhi(q[e >> 1]) : bflo(q[e >> 1]), oth = (e & 1) ? bfhi(pr[e >> 1]) : bflo(pr[e >> 1]); const float cs = tb[e], sn = tb[8 + e];
                        r[e] = fq == 0 ? (own * cs - oth * sn) : (own * cs + oth * sn); }
                    q.x = pk2(r[0], r[1]); q.y = pk2(r[2], r[3]); q.z = pk2(r[4], r[5]); q.w = pk2(r[6], r[7]); } }
            Xq[mi][ks] = __builtin_bit_cast(bf16x8, q); } }
    __syncthreads();
    f32x4 O[4][4]; float mrow[4], lrow[4];
#pragma unroll
    for (int mi = 0; mi < 4; ++mi) { mrow[mi] = sink; lrow[mi] = fq == 0 ? 1.f : 0.f;
#pragma unroll
        for (int nd = 0; nd < 4; ++nd) O[mi][nd] = (f32x4){0.f, 0.f, 0.f, 0.f}; }
    for (int kt = 0; kt < 10; ++kt) {
        const int j0 = r0 + 32 * kt;
        if (!ATT_OK(j0)) continue;
#pragma unroll
        for (int mh = 0; mh < 2; ++mh) {
            const int ra0 = r0 + 32 * mh;
            if (j0 + 31 < ra0 || j0 > ra0 + 31 + 256) continue;
            f32x4 S[2][2];
#pragma unroll
            for (int m2 = 0; m2 < 2; ++m2)
#pragma unroll
                for (int ni = 0; ni < 2; ++ni) S[m2][ni] = (f32x4){0.f, 0.f, 0.f, 0.f};
#pragma unroll
            for (int ks = 0; ks < 2; ++ks)
#pragma unroll
                for (int ni = 0; ni < 2; ++ni) { const bf16x8 Yk = *(LAS const bf16x8*)(LKB + (j0 + 16 * ni + fr) * 144 + (32 * ks + 8 * fq) * 2);
#pragma unroll
                    for (int m2 = 0; m2 < 2; ++m2) S[m2][ni] = MFMA16(Yk, Xq[2 * mh + m2][ks], S[m2][ni]); }
            bf16x8 Xp[2];
#pragma unroll
            for (int m2 = 0; m2 < 2; ++m2) { const int mi = 2 * mh + m2; const int rhoa = r0 + 16 * mi, rho = rhoa + fr;
                const bool full = (j0 >= rhoa + 15) && (j0 + 31 <= rhoa + 256);
                float mx = -INFINITY;
                if (full) {
#pragma unroll
                    for (int ni = 0; ni < 2; ++ni)
#pragma unroll
                        for (int jj = 0; jj < 4; ++jj) mx = fmaxf(mx, S[m2][ni][jj]);
                } else {
#pragma unroll
                    for (int ni = 0; ni < 2; ++ni)
#pragma unroll
                        for (int jj = 0; jj < 4; ++jj) { const int j = j0 + 16 * ni + 4 * fq + jj; const bool ok = (j >= rho) && (j <= rho + 256);
                            const float sv = ok ? S[m2][ni][jj] : -INFINITY; S[m2][ni][jj] = sv; mx = fmaxf(mx, sv); }
                }
                if (__builtin_amdgcn_ballot_w64(mx > mrow[mi] + 6.0f) != 0ull) {
                    mx = fmaxf(mx, __shfl_xor(mx, 16)); mx = fmaxf(mx, __shfl_xor(mx, 32));
                    const float mnew = fmaxf(mrow[mi], mx), alpha = __builtin_amdgcn_exp2f(mrow[mi] - mnew); mrow[mi] = mnew; lrow[mi] *= alpha;
#pragma unroll
                    for (int nd = 0; nd < 4; ++nd) O[mi][nd] *= alpha; }
                const float mref = mrow[mi];
                float p[8], ps = 0.f;
#pragma unroll
                for (int e = 0; e < 8; ++e) { p[e] = __builtin_amdgcn_exp2f(S[m2][e >> 2][e & 3] - mref); ps += p[e]; }
                lrow[mi] += ps;
                Xp[m2] = pack8(p); }
#pragma unroll
            for (int nd = 0; nd < 4; ++nd) { const LAS bf16_t* vp = LVT + (16 * nd + fr) * 520 + j0 + 4 * fq;
                const s16x4 lo = *(LAS const s16x4*)vp, hi = *(LAS const s16x4*)(vp + 16);
                const bf16x8 Yv = (bf16x8){lo[0], lo[1], lo[2], lo[3], hi[0], hi[1], hi[2], hi[3]};
#pragma unroll
                for (int m2 = 0; m2 < 2; ++m2) O[2 * mh + m2][nd] = MFMA16(Yv, Xp[m2], O[2 * mh + m2][nd]); }
        }
    }
#pragma unroll
    for (int mi = 0; mi < 4; ++mi) { float l = lrow[mi]; l += __shfl_xor(l, 16); l += __shfl_xor(l, 32); const float inv = 1.f / l;
        bf16_t* op = (bf16_t*)(c.ws + WS_HMOA) + (size_t)(t0 + r0 + 16 * mi + fr) * 1024 + 512 + hq * 64 + 4 * fq;
#pragma unroll
        for (int nd = 0; nd < 4; ++nd) { const f32x4 o = O[mi][nd] * inv; u32x2 w; w.x = pk2(o[0], o[1]); w.y = pk2(o[2], o[3]); *(u32x2*)(op + 16 * nd) = w; } }
    __syncthreads();
#undef ATT_OK
}

DI void scan_item(const Ctx& c, int st, int slice, int lane) {
    const int seq = st >> 3, head = (st >> 1) & 3, d = st & 1;
    const int chunk0 = seq == 0 ? 0 : 128 + 32 * (seq - 1), nch = seq == 0 ? 128 : 32;
    const int e0 = slice * 512 + lane * 8; const bool act = e0 < ST_ELEMS;
    bf16_t* CST = (bf16_t*)c.out; const float* CHSC = (const float*)(c.ws + WS_CHSC); float* MP = (float*)(c.ws + WS_MPREV);
    float C[8];
#pragma unroll
    for (int e = 0; e < 8; ++e) C[e] = 0.f;
    float m = 0.f;
    for (int i0 = 0; i0 < nch; i0 += 8) {
        u32x4 ld[8]; float bt[8], ml[8];
#pragma unroll
        for (int u = 0; u < 8; ++u) { const int ch = d ? chunk0 + nch - 1 - (i0 + u) : chunk0 + i0 + u; const size_t ti = (size_t)(d * NCHUNK + ch) * 4 + head;
            ld[u] = act ? *(const u32x4*)(CST + ti * ST_ELEMS + e0) : (u32x4){0u, 0u, 0u, 0u}; bt[u] = CHSC[ti * 2]; ml[u] = CHSC[ti * 2 + 1]; }
#pragma unroll
        for (int u = 0; u < 8; ++u) { const int ch = d ? chunk0 + nch - 1 - (i0 + u) : chunk0 + i0 + u; const size_t ti = (size_t)(d * NCHUNK + ch) * 4 + head;
            if (slice == 0 && lane == 0) MP[ti] = m;
            u32x4 o; o.x = pk2(C[0], C[1]); o.y = pk2(C[2], C[3]); o.z = pk2(C[4], C[5]); o.w = pk2(C[6], C[7]);
            if (act) *(u32x4*)(CST + ti * ST_ELEMS + e0) = o;
            const float mn = fmaxf(bt[u] + m, ml[u]), sp = __expf(bt[u] + m - mn), sl = __expf(ml[u] - mn); m = mn;
#pragma unroll
            for (int e = 0; e < 8; ++e) { const unsigned w = ld[u][e >> 1]; const float cl = (e & 1) ? bfhi(w) : bflo(w); C[e] = sp * C[e] + sl * cl; } }
    }
}

template <int DIR> DI void dir_pass(const f32x4 (&S)[8], const bf16x8 (&Xq)[4], LAS const unsigned char* LS, LAS const unsigned char* LVTb, LAS const float* vec, int trow, int fr, int fq, f32x4 (&hs)[8]) {
    f32x4 acc[9];
#pragma unroll
    for (int nt = 0; nt < 9; ++nt) { acc[nt] = (f32x4){0.f, 0.f, 0.f, 0.f};
#pragma unroll
        for (int ks = 0; ks < 4; ++ks) { const bf16x8 Y = *(LAS const bf16x8*)(LS + (16 * nt + fr) * 272 + (32 * ks + 8 * fq) * 2); acc[nt] = MFMA16(Y, Xq[ks], acc[nt]); } asm volatile("" ::: "memory"); }
    const float Mt = vec[128 + trow], ex = vec[256 + trow], iw = vec[384 + trow];
#pragma unroll
    for (int nt = 0; nt < 9; ++nt) acc[nt] *= iw;
    bf16x8 Xp[4];
#pragma unroll
    for (int kp = 0; kp < 4; ++kp) { float p[8];
#pragma unroll
        for (int h2 = 0; h2 < 2; ++h2) { const int n = 2 * kp + h2; const f32x4 g4 = *(LAS const f32x4*)(vec + 16 * n + 4 * fq);
#pragma unroll
            for (int j = 0; j < 4; ++j) { const int s = 16 * n + 4 * fq + j; const bool ok = DIR == 0 ? (s <= trow) : (s >= trow);
                p[4 * h2 + j] = ok ? S[n][j] * __builtin_amdgcn_exp2f(g4[j] - Mt) : 0.f; } }
        Xp[kp] = pack8(p); }
#pragma unroll
    for (int nt = 0; nt < 8; ++nt)
#pragma unroll
        for (int kp = 0; kp < 4; ++kp) { LAS const unsigned char* vp = LVTb + (16 * nt + fr) * 272 + (32 * kp + 4 * fq) * 2;
            const s16x4 lo = *(LAS const s16x4*)vp, hi = *(LAS const s16x4*)(vp + 32);
            const bf16x8 Y = (bf16x8){lo[0], lo[1], lo[2], lo[3], hi[0], hi[1], hi[2], hi[3]};
            acc[nt] = MFMA16(Y, Xp[kp], acc[nt]); if (kp == 3) asm volatile("" ::: "memory"); }
    { const short o = fr == 0 ? (short)0x3F80 : (short)0; const bf16x8 ones = (bf16x8){o, o, o, o, o, o, o, o};
#pragma unroll
        for (int kp = 0; kp < 4; ++kp) acc[8] = MFMA16(ones, Xp[kp], acc[8]); }
    const float den = __shfl(acc[8][0], fr);
    const float inv = 1.f / fmaxf(fabsf(den), ex);
#pragma unroll
    for (int nt = 0; nt < 8; ++nt) { if (DIR == 0) hs[nt] = acc[nt] * inv; else hs[nt] += acc[nt] * inv; }
}
DI void mlstm_prefetch_states(const Ctx& c, int chunk, int head, int tid, u32x4 (&sbr)[5], u32x4 (&sfr)[5]) {
    const bf16_t* CSTF = (const bf16_t*)c.out + ((size_t)(0 * NCHUNK + chunk) * 4 + head) * ST_ELEMS; const bf16_t* CSTB = (const bf16_t*)c.out + ((size_t)(1 * NCHUNK + chunk) * 4 + head) * ST_ELEMS;
#pragma unroll
    for (int i = 0; i < 5; ++i) { int idx = tid + 512 * i; idx = idx < 2304 ? idx : 2303; const int r = idx >> 4, ch = idx & 15, rc = r < 129 ? r : 128;
        sbr[i] = *(const u32x4*)(CSTB + rc * 128 + ch * 8); sfr[i] = *(const u32x4*)(CSTF + rc * 128 + ch * 8); }
}
DI void mlstm_out_unit(LAS unsigned char* lds, const Ctx& c, int chunk, int head, int nchunk, int nhead, u32x4 (&sbr)[5], u32x4 (&sfr)[5], int tid, int lane, int wid) {
    asm volatile("" : "+v"(tid), "+v"(lane));
    const int t0 = chunk * 128, fr = lane & 15, fq = lane >> 4;
    LAS unsigned char* LQ = lds; LAS unsigned char* LK = lds + 34816; LAS unsigned char* LVTb = lds + 73984; LAS unsigned char* LSB = lds + 108800; LAS float* vec = (LAS float*)(lds + 147968);
    LAS bf16_t* LVT = (LAS bf16_t*)LVTb;
    const bf16_t* MQ = (const bf16_t*)(c.ws + WS_MQ); const bf16_t* MK = (const bf16_t*)(c.ws + WS_MK); const bf16_t* MV = (const bf16_t*)(c.ws + WS_MV); bf16_t* MO = (bf16_t*)(c.ws + WS_MO);
    const bf16_t* CSTF = (const bf16_t*)c.out + ((size_t)(0 * NCHUNK + chunk) * 4 + head) * ST_ELEMS; const bf16_t* CSTB = (const bf16_t*)c.out + ((size_t)(1 * NCHUNK + chunk) * 4 + head) * ST_ELEMS;
    ChunkGates cgq; cgq.i0 = cgq.f0 = cgq.i1 = cgq.f1 = 0.f; cgq.s0 = cgq.s1 = 0; float mp_early = 0.f;
    if (wid < 2) { cgq = chunk_gates_load(wid, (const float*)(c.ws + WS_GATES), t0, head, lane); mp_early = ((const float*)(c.ws + WS_MPREV))[(size_t)(wid * NCHUNK + chunk) * 4 + head]; }
    u32x4 qr[4], kr[4], vr[4];
#pragma unroll
    for (int i = 0; i < 4; ++i) { const int idx = tid + 512 * i, r = idx >> 4, ch = idx & 15; const size_t go = (size_t)(t0 + r) * 512 + head * 128 + ch * 8; qr[i] = *(const u32x4*)(MQ + go); kr[i] = *(const u32x4*)(MK + go); }
#pragma unroll
    for (int i = 0; i < 4; ++i) { const int idx = tid + 512 * i, s = idx & 127, ch = idx >> 7; vr[i] = *(const u32x4*)(MV + (size_t)(t0 + s) * 512 + head * 128 + ch * 8); }
#pragma unroll
    for (int i = 0; i < 4; ++i) { const int idx = tid + 512 * i, r = idx >> 4, ch = idx & 15; *(LAS u32x4*)(LQ + r * 272 + ch * 16) = qr[i]; *(LAS u32x4*)(LK + r * 272 + ch * 16) = kr[i]; }
#pragma unroll
    for (int i = 0; i < 4; ++i) { const int idx = tid + 512 * i, s = idx & 127, ch = idx >> 7; const u32x4 v8 = vr[i];
#pragma unroll
        for (int e = 0; e < 8; ++e) { const unsigned vw = v8[e >> 1]; LVT[(8 * ch + e) * 136 + s] = (bf16_t)((e & 1) ? (vw >> 16) : (vw & 0xffffu)); } }
#pragma unroll
    for (int i = 0; i < 5; ++i) { int idx = tid + 512 * i; idx = idx < 2304 ? idx : 2303; const int r = idx >> 4, ch = idx & 15;
        *(LAS u32x4*)(LSB + r * 272 + ch * 16) = r < 129 ? sbr[i] : (u32x4){0u, 0u, 0u, 0u}; }
    if (wid < 2) { const int d = wid; const ChunkVec v = chunk_vectors_from(cgq, lane);
        const float mp = mp_early;
        LAS float* vd = vec + d * 512; const float M0 = fmaxf(mp, v.cm0), M1 = fmaxf(mp, v.cm1);
        constexpr float L2E = 1.4426950408889634f;
        vd[v.s0] = v.g0 * L2E; vd[128 + v.s0] = M0 * L2E; vd[256 + v.s0] = __expf(-(v.b0 + M0)); vd[384 + v.s0] = __expf(mp - M0);
        vd[v.s1] = v.g1 * L2E; vd[128 + v.s1] = M1 * L2E; vd[256 + v.s1] = __expf(-(v.b1 + M1)); vd[384 + v.s1] = __expf(mp - M1); }
    __syncthreads();
    const int trow = 16 * wid + fr;
    bf16x8 Xq[4];
#pragma unroll
    for (int ks = 0; ks < 4; ++ks) Xq[ks] = *(LAS const bf16x8*)(LQ + trow * 272 + (32 * ks + 8 * fq) * 2);
    f32x4 S[8];
#pragma unroll
    for (int n = 0; n < 8; ++n) { S[n] = (f32x4){0.f, 0.f, 0.f, 0.f};
#pragma unroll
        for (int ks = 0; ks < 4; ++ks) { const bf16x8 Yk = *(LAS const bf16x8*)(LK + (16 * n + fr) * 272 + (32 * ks + 8 * fq) * 2); S[n] = MFMA16(Yk, Xq[ks], S[n]); } }
    __syncthreads();
#pragma unroll
    for (int i = 0; i < 5; ++i) { int idx = tid + 512 * i; idx = idx < 2304 ? idx : 2303; const int r = idx >> 4, ch = idx & 15;
        *(LAS u32x4*)(LK + r * 272 + ch * 16) = r < 129 ? sfr[i] : (u32x4){0u, 0u, 0u, 0u}; }
    __syncthreads();
    mlstm_prefetch_states(c, nchunk, nhead, tid, sbr, sfr);
    f32x4 hs[8];
    dir_pass<0>(S, Xq, LK, LVTb, vec, trow, fr, fq, hs);
    dir_pass<1>(S, Xq, LSB, LVTb, vec + 512, trow, fr, fq, hs);
    float sum = 0.f;
#pragma unroll
    for (int nt = 0; nt < 8; ++nt) sum += (hs[nt][0] + hs[nt][1]) + (hs[nt][2] + hs[nt][3]);
    sum += __shfl_xor(sum, 16); sum += __shfl_xor(sum, 32);
    const float mean = sum * (1.f / 128.f); float var = 0.f;
#pragma unroll
    for (int nt = 0; nt < 8; ++nt) { hs[nt] -= mean; var += (hs[nt][0] * hs[nt][0] + hs[nt][1] * hs[nt][1]) + (hs[nt][2] * hs[nt][2] + hs[nt][3] * hs[nt][3]); }
    var += __shfl_xor(var, 16); var += __shfl_xor(var, 32);
    const float rstd = __builtin_amdgcn_rsqf(var * (1.f / 128.f) + EPS);
    const float* nw = c.in[6] + head * 128; bf16_t* mop = MO + (size_t)(t0 + trow) * 512 + head * 128;
#pragma unroll
    for (int nt = 0; nt < 8; ++nt) { const int v = 16 * nt + 4 * fq; const u32x2 mo4 = *(const u32x2*)(mop + v); const f32x4 w4 = *(const f32x4*)(nw + v);
        const float o0 = hs[nt][0] * rstd * w4[0] * sigmoidf_(bflo(mo4.x)), o1 = hs[nt][1] * rstd * w4[1] * sigmoidf_(bfhi(mo4.x));
        const float o2 = hs[nt][2] * rstd * w4[2] * sigmoidf_(bflo(mo4.y)), o3 = hs[nt][3] * rstd * w4[3] * sigmoidf_(bfhi(mo4.y));
        u32x2 w; w.x = pk2(o0, o1); w.y = pk2(o2, o3); *(u32x2*)((bf16_t*)(c.ws + WS_HMOA) + (size_t)(t0 + trow) * 1024 + head * 128 + v) = w; }
    __syncthreads();
}

struct Args { const float* in[17]; float* out; unsigned char* ws; int ph_lo, ph_hi; };
constexpr int NPHASE = 9;

__global__ void __launch_bounds__(512, 2) mega(Args args) {
    extern __shared__ __attribute__((aligned(16))) unsigned char lds_raw[];
    LAS unsigned char* lds = (LAS unsigned char*)lds_raw;
    cg::grid_group grid = cg::this_grid();
    const int tid = threadIdx.x, lane = tid & 63, wid = __builtin_amdgcn_readfirstlane(tid >> 6);
    const int G = gridDim.x, gw = blockIdx.x * 8 + wid, NGW = G * 8;
    Ctx c;
#pragma unroll
    for (int i = 0; i < 17; ++i) c.in[i] = args.in[i];
    c.out = args.out; c.ws = args.ws;
    unsigned char* ws = args.ws;
    const int lo = args.ph_lo, hi = args.ph_hi;
#ifndef PH_MASK
#define PH_MASK 0x3ff
#endif
#define IN(k) (((PH_MASK >> (k)) & 1) && lo <= (k) && (k) < hi)
#define REP(k) for (int rep_ = 0; rep_ < (((DUP_MASK >> (k)) & 1) ? 2 : 1); ++rep_)
#define SEAM(k) do { if (IN(k) && IN((k) + 1)) grid.sync(); } while (0)

    REP(0) if (IN(0)) {
        LAS float* scr = (LAS float*)(lds + wid * 16384);
        for (int i = blockIdx.x * 512 + tid; i < 320 * 64; i += G * 512) ((unsigned*)(ws + WS_CTL))[i] = 0u;
        constexpr int I_W1 = 160 * 16, I_PM = 32 * 8, I_PA = 32 * 8, I_WO = 32 * 16, I_UP = 176 * 16, I_WD = 32 * 44;
        constexpr int NITEMS = I_W1 + I_PM + I_PA + I_WO + I_UP + I_WD;
        for (int it = gw; it < NITEMS; it += NGW) {
            int r = it;
            if (r < I_W1) { const int nb = r >> 4, kb = r & 15, dr = 32 * nb, sc = dr < 2048 ? dr : dr + 16;
                const float ns = (dr >= 512 && dr < 1024) ? 0.08838834764831845f : ((dr >= 2048 && dr < 2560) ? 0.18033688011112042f   : 1.f);
                transpose_item(c.in[3], DIN, sc, 64 * kb, (bf16_t*)(ws + WS_W1), 1024, dr, c.in[2], ns, scr, lane); continue; } r -= I_W1;
            if (r < I_PM) { const int nb = r >> 3, kb = r & 7; transpose_item(c.in[8], 1024, 32 * nb, 64 * kb, (bf16_t*)(ws + WS_W1) + (size_t)5120 * 1024, 1024, 32 * nb, nullptr, 1.f, scr, lane); continue; } r -= I_PM;
            if (r < I_PA) { const int nb = r >> 3, kb = r & 7; transpose_item(c.in[9], 1024, 32 * nb, 64 * kb, (bf16_t*)(ws + WS_W1) + (size_t)5120 * 1024 + 512, 1024, 32 * nb, nullptr, 1.f, scr, lane); continue; } r -= I_PA;
            if (r < I_WO) { const int nb = r >> 4, kb = r & 15; transpose_item(c.in[10], 1024, 32 * nb, 64 * kb, (bf16_t*)(ws + WS_WO), 1024, 32 * nb, nullptr, 1.f, scr, lane); continue; } r -= I_WO;
            if (r < I_UP) { const int nb = r >> 4, kb = r & 15, sc = 32 * nb; const int half = sc >= DFF ? 1 : 0, ch = sc - half * DFF; const int dr = 256 * (ch >> 7) + 128 * half + (ch & 127);
                transpose_item(c.in[12], NUP, sc, 64 * kb, (bf16_t*)(ws + WS_WUP), 1024, dr, c.in[11], 1.f, scr, lane); continue; } r -= I_UP;
            { const int nb = r / 44, kb = r - nb * 44; transpose_item(c.in[15], 1024, 32 * nb, 64 * kb, (bf16_t*)(ws + WS_WD), DFF, 32 * nb, nullptr, 1.f, scr, lane); }
        }
        {
            float* rope = (float*)(ws + WS_ROPE);
            for (int i = blockIdx.x * 512 + tid; i < 16384 * 8; i += G * 512) { const int pos = i >> 3, d = i & 7;
                const float invf = d == 0 ? 1.0f : d == 1 ? 0.1939227432012558f : d == 2 ? 0.03760603070259094f : d == 3 ? 0.007292664609849453f : d == 4 ? 0.0014142135623842478f
                                 : d == 5 ? 0.00027424818836152554f : d == 6 ? 5.3182957344688475e-05f : 1.0313385246263351e-05f;
                const float ang = (float)pos * invf; const float k = rintf(ang * 0.15915494309189535f);
                float rr = fmaf(-k, 6.2831854820251465f, ang); rr = fmaf(-k, -1.7484556025237907e-07f, rr);
                rope[pos * 16 + d] = cosf(rr); rope[pos * 16 + 8 + d] = sinf(rr); }
        }
        __syncthreads();
        LAS float* wg = (LAS float*)lds;
        for (int i = tid; i < 16384; i += 512) { const int k = i >> 4, j = i & 15; wg[j * 1024 + k] = c.in[2][k] * c.in[3][(size_t)k * DIN + 2048 + j]; }
        __syncthreads();
        bf16_t* XN = (bf16_t*)(ws + WS_XN); float* gates = (float*)(ws + WS_GATES);
        const float bias = (lane >> 2) < 8 ? c.in[4][lane >> 2] : c.in[5][(lane >> 2) - 8];
        f32x4 va[4], vb[4];
        { const int r0 = gw * 2 < MTOK ? gw * 2 : 0; const f32x4* xa = (const f32x4*)xrow_ptr(c.in[0], c.in[1], r0) + lane; const f32x4* xb = (const f32x4*)xrow_ptr(c.in[0], c.in[1], r0 + 1) + lane;
#pragma unroll
          for (int j = 0; j < 4; ++j) { va[j] = xa[64 * j]; vb[j] = xb[64 * j]; } }
        for (int r0 = gw * 2; r0 < MTOK; r0 += NGW * 2) {
            f32x4 na[4], nb[4];
            { const int rn = r0 + NGW * 2 < MTOK ? r0 + NGW * 2 : r0; const f32x4* xa = (const f32x4*)xrow_ptr(c.in[0], c.in[1], rn) + lane; const f32x4* xb = (const f32x4*)xrow_ptr(c.in[0], c.in[1], rn + 1) + lane;
#pragma unroll
              for (int j = 0; j < 4; ++j) { na[j] = xa[64 * j]; nb[j] = xb[64 * j]; } }
            float sa = 0.f, sb = 0.f;
#pragma unroll
            for (int j = 0; j < 4; ++j) {
                sa += (va[j][0] * va[j][0] + va[j][1] * va[j][1]) + (va[j][2] * va[j][2] + va[j][3] * va[j][3]); sb += (vb[j][0] * vb[j][0] + vb[j][1] * vb[j][1]) + (vb[j][2] * vb[j][2] + vb[j][3] * vb[j][3]); }
            const float rsa = 1.f / sqrtf(wave_sum(sa) * (1.f / DM) + EPS), rsb = 1.f / sqrtf(wave_sum(sb) * (1.f / DM) + EPS);
            float pa[16], pb[16];
#pragma unroll
            for (int g = 0; g < 16; ++g) { float qa = 0.f, qb = 0.f;
#pragma unroll
                for (int j = 0; j < 4; ++j) { const f32x4 w = *(LAS const f32x4*)(wg + g * 1024 + 256 * j + 4 * lane);
                    qa += (va[j][0] * w[0] + va[j][1] * w[1]) + (va[j][2] * w[2] + va[j][3] * w[3]); qb += (vb[j][0] * w[0] + vb[j][1] * w[1]) + (vb[j][2] * w[2] + vb[j][3] * w[3]); }
                pa[g] = qa; pb[g] = qb; asm volatile("" ::: "memory"); }
            const float ga_ = reduce16(pa, lane), gb_ = reduce16(pb, lane);
            if ((lane & 3) == 0) { gates[(size_t)r0 * 16 + (lane >> 2)] = rsa * ga_ + bias; gates[(size_t)(r0 + 1) * 16 + (lane >> 2)] = rsb * gb_ + bias; }
            unsigned long long* oa = (unsigned long long*)(XN + (size_t)r0 * DM) + lane; unsigned long long* ob = (unsigned long long*)(XN + (size_t)(r0 + 1) * DM) + lane;
#pragma unroll
            for (int j = 0; j < 4; ++j) {
                oa[64 * j] = (unsigned long long)pk2(va[j][0] * rsa, va[j][1] * rsa) | ((unsigned long long)pk2(va[j][2] * rsa, va[j][3] * rsa) << 32);
                ob[64 * j] = (unsigned long long)pk2(vb[j][0] * rsb, vb[j][1] * rsb) | ((unsigned long long)pk2(vb[j][2] * rsb, vb[j][3] * rsb) << 32); }
#pragma unroll
            for (int j = 0; j < 4; ++j) { va[j] = na[j]; vb[j] = nb[j]; }
        }
        __syncthreads();
    }
    SEAM(0);

    if (IN(1)) {
        pg8::Gemm g{(const bf16_t*)(ws + WS_XN), (const bf16_t*)(ws + WS_W1), nullptr, nullptr, 1024};
        pg8::DupOrder S; S.s.init(MTOK / 256, 12, G, (int)blockIdx.x); S.dup = (DUP_MASK >> 1) & 1;
        pg8::EpiProj E{ws};
        pg8::gemm_phase<pg8::EpiProj, pg8::DupOrder, true, false>(lds, g, S, E);
    }
    SEAM(1);

    if (IN(2)) {
        constexpr int NSU = NCHUNK * 4, NAU = (NCHUNK / 2) * 4;
        u32x4 v8r[4], k8r[4];
        if ((int)blockIdx.x < NSU) summary_prefetch(c, (int)blockIdx.x >> 2, (int)blockIdx.x & 3, tid, v8r, k8r);
        for (int it0 = blockIdx.x; it0 < (((DUP_MASK >> 2) & 1) ? 2 : 1) * (NSU + NAU); it0 += G) { const int it = it0 >= NSU + NAU ? it0 - (NSU + NAU) : it0;
            if (it < NSU) { const int nx = it0 + G < NSU ? it0 + G : it; summary_unit(lds, c, it >> 2, it & 3, nx >> 2, nx & 3, v8r, k8r, tid, lane, wid); }
            else { const int a = it - NSU; attn_unit(lds, c, a >> 2, a & 3, tid, lane, wid); }
        }
    }
    SEAM(2);

    REP(3) if (IN(3)) {
        constexpr int NPI = 8 * 33, NSI = 128 * 33;
        if (NGW > 2 * NPI) {
            if (gw < NPI) scan_item(c, gw / 33, gw % 33, lane);
            else { const int stride = NGW - NPI; for (int j = gw - NPI; j < NSI; j += stride) scan_item(c, 8 + j / 33, j % 33, lane); }
        } else {
            for (int j = gw; j < NPI + NSI; j += NGW) scan_item(c, j / 33, j % 33, lane);
        }
    }
    SEAM(3);

    REP(4) if (IN(4)) {
        u32x4 sbr[5], sfr[5];
        if ((int)blockIdx.x < NCHUNK * 4) mlstm_prefetch_states(c, (int)blockIdx.x >> 2, (int)blockIdx.x & 3, tid, sbr, sfr);
        for (int it = blockIdx.x; it < NCHUNK * 4; it += G) { const int nx = it + G < NCHUNK * 4 ? it + G : it; mlstm_out_unit(lds, c, it >> 2, it & 3, nx >> 2, nx & 3, sbr, sfr, tid, lane, wid); }
    }
    SEAM(4);

    if (IN(5)) {
        const bf16_t* W1t = (const bf16_t*)(ws + WS_W1);
        pg8::Gemm gg{(const bf16_t*)(ws + WS_XN), W1t + (size_t)3072 * 1024, (const bf16_t*)(ws + WS_XN), W1t + (size_t)4096 * 1024, 1024, 0};
        pg8::Gemm gx{(const bf16_t*)(ws + WS_HMOA), W1t + (size_t)5120 * 1024, (const bf16_t*)(ws + WS_HMOA) + 512, W1t + (size_t)5120 * 1024 + 512, 1024, 8};
        pg8::StaticOrder SO; SO.init(MTOK / 256, DM / 256, G, (int)blockIdx.x);
        pg8::EpiGate EG{ws + WS_QSCR}; pg8::EpiMix EM{(bf16_t*)(ws + WS_Y), ws + WS_QSCR};
        pg8::Unit tu;
        for (int k = 0; SO.next(k, tu); ++k) {
            pg8::TileOrder T{tu.pm, tu.pn};
            pg8::gemm_phase<pg8::EpiGate, pg8::TileOrder, true, false>(lds, gg, T, EG);
            pg8::gemm_phase<pg8::EpiMix, pg8::TileOrder, true, false>(lds, gx, T, EM);
        }
    }
    SEAM(5);

    if (IN(6)) {
        pg8::Gemm g{(const bf16_t*)(ws + WS_Y), (const bf16_t*)(ws + WS_WO), nullptr, nullptr, 1024};
        pg8::DupOrder S; S.s.init(MTOK / 256, DM / 256, G, (int)blockIdx.x); S.dup = (DUP_MASK >> 6) & 1;
        pg8::EpiRes<true> E{c.in[0], c.in[1], c.out, (bf16_t*)(ws + WS_HN), (float*)(ws + WS_SS)};
        pg8::gemm_phase<pg8::EpiRes<true>, pg8::DupOrder, true, false>(lds, g, S, E);
    }
    SEAM(6);

    if (IN(7)) {
        pg8::Gemm g{(const bf16_t*)(ws + WS_HN), (const bf16_t*)(ws + WS_WUP), nullptr, nullptr, 1024};
        pg8::DupOrder S; S.s.init(323, NUP / 256, G, (int)blockIdx.x); S.dup = (DUP_MASK >> 7) & 1;
        pg8::EpiConv E{(bf16_t*)(ws + WS_G), (const float*)(ws + WS_SS), c.in[13], c.in[14], (LAS float*)(lds + 131072)};
        pg8::gemm_phase<pg8::EpiConv, pg8::DupOrder, true, true>(lds, g, S, E);
    }
    SEAM(7);

    if (IN(8)) {
        pg8::Gemm g{(const bf16_t*)(ws + WS_G), (const bf16_t*)(ws + WS_WD), nullptr, nullptr, DFF};
        pg8::StaticOrder S; S.init(MTOK / 256, DM / 256, G, (int)blockIdx.x);
        pg8::EpiFinal E{c.out, (const bf16_t*)(ws + WS_HN), c.in[16], (unsigned*)(ws + WS_SS), (unsigned*)(ws + WS_CTL)};
        pg8::gemm_phase<pg8::EpiFinal, pg8::StaticOrder, true, false>(lds, g, S, E);
    }
#undef IN
#undef SEAM
}

extern "C" void kernel_launch(void* const* d_in, const int* in_sizes, int n_in, void* d_out, int out_size, void* d_ws, size_t ws_size, hipStream_t stream) {
    static int grid = 0;
    if (grid == 0) {
        if (n_in != 17 || out_size != MTOK * DM || ws_size < WS_END2) { fprintf(stderr, "kernel_launch: unexpected problem (n_in %d out %d ws %zu)\n", n_in, out_size, ws_size); grid = -1; return; }
        int dev = 0, cus = 0, per_cu = 0;
        if (hipGetDevice(&dev) != hipSuccess || hipDeviceGetAttribute(&cus, hipDeviceAttributeMultiprocessorCount, dev) != hipSuccess) { grid = -1; return; }
        if (hipFuncSetAttribute((const void*)mega, hipFuncAttributeMaxDynamicSharedMemorySize, LDS_BYTES) != hipSuccess) { fprintf(stderr, "kernel_launch: hipFuncSetAttribute failed\n"); grid = -1; return; }
        if (hipOccupancyMaxActiveBlocksPerMultiprocessor(&per_cu, (const void*)mega, 512, LDS_BYTES) != hipSuccess || per_cu < 1) { fprintf(stderr, "kernel_launch: occupancy query says %d\n", per_cu); per_cu = 1; }
        (void)hipGetLastError();
        grid = cus * per_cu;
    }
    if (grid < 0) return;
    Args a{};
    for (int i = 0; i < 17; ++i) a.in[i] = (const float*)d_in[i];
    a.out = (float*)d_out; a.ws = (unsigned char*)d_ws;
#if MK_SINGLE
    a.ph_lo = 0; a.ph_hi = NPHASE;
    void* kargs[] = {&a};
    hipError_t e = hipLaunchCooperativeKernel((const void*)mega, dim3(grid), dim3(512), kargs, LDS_BYTES, stream);
    if (e != hipSuccess) fprintf(stderr, "cooperative launch failed: %s (grid %d)\n", hipGetErrorString(e), grid);
#else
    for (int p = 0; p < NPHASE; ++p) { a.ph_lo = p; a.ph_hi = p + 1; hipLaunchKernelGGL(mega, dim3(grid), dim3(512), LDS_BYTES, stream, a); }
#endif
}
```

```cpp
#include <hip/hip_runtime.h>
#include <hip/hip_cooperative_groups.h>
#include <cstdio>
#include <cstdint>
namespace cg = cooperative_groups;

#ifndef DUP_MASK
#define DUP_MASK 0
#endif
#ifndef MK_SINGLE
#define MK_SINGLE 1
#endif

#define LAS __attribute__((address_space(3)))
#define DI __device__ __forceinline__
typedef unsigned short bf16_t;
typedef short bf16x8 __attribute__((ext_vector_type(8)));
typedef short s16x4 __attribute__((ext_vector_type(4)));
typedef float f32x4 __attribute__((ext_vector_type(4)));
typedef unsigned u32x4 __attribute__((ext_vector_type(4)));
typedef unsigned u32x2 __attribute__((ext_vector_type(2)));

constexpr int MTOK = 81920, DM = 1024, NPROJ = 5120, DIN = 5136, DFF = 2816, NUP = 5632;
constexpr int NCHUNK = 640, PROMPT = 16384;
constexpr float EPS = 1e-6f;
constexpr int ST_ELEMS = 129 * 128;
constexpr size_t ST_BYTES = (size_t)ST_ELEMS * 2;

constexpr size_t MiB = 1u << 20;
constexpr size_t WS_CTL = 0;
constexpr size_t WS_W1 = 2 * MiB, WS_WPM = 13 * MiB, WS_WPA = 14 * MiB, WS_WO = 15 * MiB, WS_WUP = 17 * MiB, WS_WD = 28 * MiB;
constexpr size_t WS_ROPE = 34 * MiB, WS_GATES = 35 * MiB, WS_SS = 40 * MiB, WS_CHSC = 46 * MiB, WS_MPREV = 47 * MiB;
constexpr size_t WS_MQ = 64 * MiB, WS_MK = 144 * MiB, WS_MV = 224 * MiB, WS_MO = 304 * MiB, WS_AQ = 384 * MiB, WS_AK = 464 * MiB, WS_AV = 504 * MiB,
                 WS_GM = 544 * MiB, WS_GA = 704 * MiB, WS_END = 864 * MiB;
constexpr size_t WS_Y = 64 * MiB, WS_HN = 224 * MiB, WS_G = 384 * MiB;
constexpr size_t WS_OA = 864 * MiB, WS_HM = 944 * MiB, WS_END2 = 1024 * MiB;
constexpr size_t OUT_CST = 0;
constexpr size_t WS_XN = WS_GM, WS_QSCR = WS_GA;
constexpr size_t WS_HMOA = 864 * MiB;
constexpr int LDS_BYTES = 152064;

typedef __bf16 bf16n2 __attribute__((ext_vector_type(2)));
typedef float f32n2 __attribute__((ext_vector_type(2)));
DI unsigned pk2(float lo, float hi) { const f32n2 v = {lo, hi}; return __builtin_bit_cast(unsigned, __builtin_convertvector(v, bf16n2)); }
DI unsigned f2bf(float f) { return pk2(f, f) & 0xffffu; }
DI float bflo(unsigned w) { return __uint_as_float(w << 16); }
DI float bfhi(unsigned w) { return __uint_as_float(w & 0xffff0000u); }
DI unsigned cvt_pk_bf16_asm(float lo, float hi) { unsigned r; asm volatile("v_cvt_pk_bf16_f32 %0, %1, %2" : "=v"(r) : "v"(lo), "v"(hi)); return r; }
DI unsigned cvt_pk_bf16(float lo, float hi) { return pk2(lo, hi); }
DI float wave_sum(float v) {
#pragma unroll
    for (int o = 1; o < 64; o <<= 1) v += __shfl_xor(v, o);
    return v;
}
DI float sigmoidf_(float x) { return __builtin_amdgcn_rcpf(1.f + __expf(-x)); }
DI float logsigmoid_(float x) { return x >= 0.f ? -log1pf(expf(-x)) : x - log1pf(expf(x)); }
#define MFMA16(a, b, c) __builtin_amdgcn_mfma_f32_16x16x32_bf16((a), (b), (c), 0, 0, 0)
DI bf16x8 pack8(const float (&p)[8]) {
    u32x4 w; w.x = pk2(p[0], p[1]); w.y = pk2(p[2], p[3]); w.z = pk2(p[4], p[5]); w.w = pk2(p[6], p[7]);
    return __builtin_bit_cast(bf16x8, w);
}
DI const float* xrow_ptr(const float* xp, const float* xs, int t) { return t < PROMPT ? xp + (size_t)t * DM : xs + (size_t)(t - PROMPT) * DM; }
DI bool seq_start(int t) { return t == 0 || (t >= PROMPT && (t & 4095) == 0); }

namespace pg8 {
constexpr int BM = 256, BK = 64, HALF = 128, HTB = HALF * BK * 2, STAGE_BYTES = 8 * HTB, NXCD = 8, WGM = 8;
DI int lds_byte(int r, int c) { const int st = (r >> 4) * 2 + (c >> 5), rr = r & 15, cc = c & 31, ob = rr * 64 + cc * 2; return st * 1024 + (ob ^ (((ob >> 9) & 1) << 5)); }
DI void stage_rc(int b, int& R, int& C) { const int st = b / 1024, sb = b % 1024, swz = sb ^ (((sb >> 9) & 1) << 5); R = (st >> 1) * 16 + swz / 64; C = (st & 1) * 32 + (swz % 64) / 2; }
DI int perm32(int rho) { const int n = rho >> 4, i = rho & 15; return 8 * (i >> 2) + 4 * n + (i & 3); }

struct Unit { int pm, pn, sel; };
struct Gemm { const bf16_t* A; const bf16_t* Bt; const bf16_t* A2; const bf16_t* Bt2; int K; int ntk = 0; };

struct StaticOrder {
    int nM, nN, nwg, G, c;
    DI void init(int nM_, int nN_, int G_, int c_) { nM = nM_; nN = nN_; nwg = nM * nN; G = G_; c = c_; }
    DI bool next(int i, Unit& u) const {
        const long L = (long)i * G + c; if (L >= nwg) return false;
        int wgid = (int)L; { const int q = nwg / NXCD, r = nwg % NXCD, xcd = wgid % NXCD, off = wgid / NXCD; wgid = (xcd < r ? xcd * (q + 1) : r * (q + 1) + (xcd - r) * q) + off; }
        const int nig = WGM * nN, gid = wgid / nig, fm = gid * WGM, gsz = (nM - fm) < WGM ? (nM - fm) : WGM;
        u.pm = fm + ((wgid % nig) % gsz); u.pn = (wgid % nig) / gsz; u.sel = 0; return true;
    }
};
struct DupOrder { StaticOrder s; int dup; DI bool next(int i, Unit& u) const { return s.next(dup ? (i >> 1) : i, u); } };
struct TileOrder { int pm, pn; DI bool next(int i, Unit& u) const { if (i >= 2) return false; u.pm = pm; u.pn = pn; u.sel = i; return true; } };
struct PairOrder {
    StaticOrder s;
    DI bool next(int i, Unit& u) const { if (!s.next(i >> 1, u)) return false; u.sel = i & 1; return true; }
};

template <class Epi, class Sched, bool ALIGN_EPI, bool CONVA>
DI void gemm_phase(LAS unsigned char* lds, const Gemm g, const Sched& S, const Epi& E) {
    const int tid = threadIdx.x, wid = __builtin_amdgcn_readfirstlane(tid >> 6), lane = tid & 63, wr = wid >> 2, wc = wid & 3, fr = lane & 15, fq = lane >> 4;
    const int K = g.K; const int nt = g.ntk ? g.ntk : K / BK;
    unsigned voffA[2], voffB[2];
#pragma unroll
    for (int i = 0; i < 2; ++i) { int R, C; stage_rc(tid * 16 + i * 8192, R, C); const int Rb = Epi::PERM ? ((R & ~31) + perm32(R & 31)) : R;
        const int Ra = CONVA ? (128 * (R >> 6) + 8 * (R & 15) + ((R >> 4) & 3)) : R;
        voffA[i] = (unsigned)(Ra * K + C) * 2u; voffB[i] = (unsigned)(Rb * K + C) * 2u; }
    const size_t kstep = (size_t)(BK * 2);
    const size_t hstepB = (size_t)HALF * K * 2, tstepB = 2 * hstepB;
    const size_t hstepA = CONVA ? (size_t)4 * K * 2 : hstepB, tstepA = CONVA ? (size_t)254 * K * 2 : tstepB;
    const long abias = CONVA ? -(long)K * 2 : 0;
    const unsigned ldsw = (unsigned)wid * 1024u;
    const int aoff = lds_byte(wr * 64 + fr, fq * 8), boff = lds_byte(wc * 32 + fr, fq * 8);
#define PG8_SA(b, h) (((b) * 2 + (h)) * HTB)
#define PG8_SB(b, h) ((4 + (b) * 2 + (h)) * HTB)
#define PG8_STAGE(bufoff, gbase, voff) do { _Pragma("unroll") for (int _i = 0; _i < 2; ++_i) \
        __builtin_amdgcn_global_load_lds((const unsigned*)((const char*)(gbase) + (voff)[_i]), (LAS unsigned*)(lds + (bufoff) + ldsw + _i * 8192), 16, 0, 0); } while (0)
#define PG8_LDA(dst, b, h) do { _Pragma("unroll") for (int m = 0; m < 4; ++m) _Pragma("unroll") for (int k = 0; k < 2; ++k) dst[m][k] = *(const LAS bf16x8*)(lds + PG8_SA(b, h) + aoff + m * 2048 + k * 1024); } while (0)
#define PG8_LDB(dst, b, h) do { _Pragma("unroll") for (int n = 0; n < 2; ++n) _Pragma("unroll") for (int k = 0; k < 2; ++k) dst[n][k] = *(const LAS bf16x8*)(lds + PG8_SB(b, h) + boff + n * 2048 + k * 1024); } while (0)
#define PG8_MMA(ai, bj, At, Bt) do { __builtin_amdgcn_s_setprio(1); _Pragma("unroll") for (int m = 0; m < 4; ++m) _Pragma("unroll") for (int n = 0; n < 2; ++n) _Pragma("unroll") for (int k = 0; k < 2; ++k) \
        acc[ai][bj][m][n] = __builtin_amdgcn_mfma_f32_16x16x32_bf16(Bt[n][k], At[m][k], acc[ai][bj][m][n], 0, 0, 0); __builtin_amdgcn_s_setprio(0); } while (0)
#define PG8_WAIT_V(n) asm volatile("s_waitcnt vmcnt(" #n ")" ::: "memory")
#define PG8_WAIT_L(n) asm volatile("s_waitcnt lgkmcnt(" #n ")" ::: "memory")
#define PG8_WAIT_VN(n) asm volatile("s_waitcnt vmcnt(%0)" :: "n"(n) : "memory")
#define PG8_BAR __builtin_amdgcn_s_barrier()
#define PG8_SCHED __builtin_amdgcn_sched_barrier(0)
    Unit cur, nxt; int ui = 0;
    if (!S.next(0, cur)) return;
    f32x4 acc[2][2][4][2];
#pragma unroll
    for (int a = 0; a < 2; ++a)
#pragma unroll
        for (int b = 0; b < 2; ++b)
#pragma unroll
            for (int m = 0; m < 4; ++m)
#pragma unroll
                for (int n = 0; n < 2; ++n) acc[a][b][m][n] = (f32x4){0.f, 0.f, 0.f, 0.f};
    bf16x8 At[4][2], B0[2][2], B1[2][2];
    const char* cA = (const char*)(cur.sel ? g.A2 : g.A) + (size_t)cur.pm * tstepA + abias; const char* cB = (const char*)(cur.sel ? g.Bt2 : g.Bt) + (size_t)cur.pn * tstepB;
    PG8_STAGE(PG8_SB(0, 0), cB, voffB); PG8_STAGE(PG8_SB(0, 1), cB + hstepB, voffB); PG8_STAGE(PG8_SA(0, 0), cA, voffA); PG8_STAGE(PG8_SA(0, 1), cA + hstepA, voffA);
    if (wr == 1) PG8_BAR;
    PG8_WAIT_V(2); PG8_BAR;
    PG8_STAGE(PG8_SB(1, 0), cB + kstep, voffB); PG8_STAGE(PG8_SA(1, 0), cA + kstep, voffA); PG8_STAGE(PG8_SB(1, 1), cB + hstepB + kstep, voffB);
    PG8_WAIT_V(6); PG8_BAR;
    for (;;) {
        const bool has_next = S.next(ui + 1, nxt);
        const char* nA = has_next ? (const char*)(nxt.sel ? g.A2 : g.A) + (size_t)nxt.pm * tstepA + abias : cA;
        const char* nB = has_next ? (const char*)(nxt.sel ? g.Bt2 : g.Bt) + (size_t)nxt.pn * tstepB : cB;
#define PG8_KBODY(W12) do { \
            PG8_LDB(B0, 0, 0); PG8_LDB(B1, 0, 1); PG8_SCHED; PG8_LDA(At, 0, 0); PG8_STAGE(PG8_SA(1, 1), a1 + hstepA, voffA); \
            W12; PG8_WAIT_L(0); PG8_BAR; PG8_MMA(0, 0, At, B0); PG8_MMA(0, 1, At, B1); PG8_BAR; PG8_SCHED; \
            PG8_LDA(At, 0, 1); PG8_STAGE(PG8_SB(0, 0), b2, voffB); PG8_STAGE(PG8_SB(0, 1), b2 + hstepB, voffB); PG8_STAGE(PG8_SA(0, 0), a2, voffA); \
            W12; PG8_WAIT_L(0); PG8_BAR; PG8_MMA(1, 0, At, B0); PG8_MMA(1, 1, At, B1); PG8_BAR; PG8_SCHED; \
            PG8_LDB(B0, 1, 0); PG8_LDB(B1, 1, 1); PG8_SCHED; PG8_LDA(At, 1, 0); PG8_STAGE(PG8_SA(0, 1), a2 + hstepA, voffA); \
            PG8_WAIT_V(8); PG8_WAIT_L(0); PG8_BAR; PG8_MMA(0, 0, At, B0); PG8_MMA(0, 1, At, B1); PG8_BAR; PG8_SCHED; \
            PG8_LDA(At, 1, 1); PG8_STAGE(PG8_SB(1, 0), b3, voffB); PG8_STAGE(PG8_SB(1, 1), b3 + hstepB, voffB); PG8_STAGE(PG8_SA(1, 0), a3, voffA); \
            PG8_WAIT_V(8); PG8_WAIT_L(0); PG8_BAR; PG8_MMA(1, 0, At, B0); PG8_MMA(1, 1, At, B1); PG8_BAR; PG8_SCHED; } while (0)
        for (int t = 0; t < nt; t += 2) {
            const bool last = (t == nt - 2);
            const char* a1 = cA + (size_t)(t + 1) * kstep;
            const char* a2 = last ? nA : cA + (size_t)(t + 2) * kstep; const char* b2 = last ? nB : cB + (size_t)(t + 2) * kstep;
            const char* a3 = a2 + kstep; const char* b3 = b2 + kstep;
            PG8_KBODY(PG8_WAIT_V(8));
        }
#undef PG8_KBODY
        if constexpr (ALIGN_EPI) { if (wr == 0) PG8_BAR; }
        E(acc, cur, wr, wc, fr, fq);
        if (!has_next) break;
        if (!E.keep(cur)) {
#pragma unroll
            for (int a = 0; a < 2; ++a)
#pragma unroll
                for (int b = 0; b < 2; ++b)
#pragma unroll
                    for (int m = 0; m < 4; ++m)
#pragma unroll
                        for (int n = 0; n < 2; ++n) acc[a][b][m][n] = (f32x4){0.f, 0.f, 0.f, 0.f};
        }
        cur = nxt; cA = nA; cB = nB; ++ui;
        if constexpr (ALIGN_EPI) { if (wr == 1) PG8_BAR; }
    }
    PG8_WAIT_V(0);
    if constexpr (!ALIGN_EPI) { if (wr == 0) PG8_BAR; }
    PG8_BAR;
#undef PG8_SA
#undef PG8_SB
#undef PG8_STAGE
#undef PG8_LDA
#undef PG8_LDB
#undef PG8_MMA
#undef PG8_WAIT_V
#undef PG8_WAIT_L
#undef PG8_WAIT_VN
#undef PG8_BAR
#undef PG8_SCHED
}

struct EpiProj {
    static constexpr bool PERM = true; static constexpr int NVM = 16;
    unsigned char* ws;
    DI bool keep(const Unit&) const { return false; }
    DI void operator()(f32x4 (&acc)[2][2][4][2], const Unit& u, int wr, int wc, int fr, int fq) const {
        const int ct = u.pn; bf16_t* base; int ldc, colt;
        if (ct < 8) { base = (bf16_t*)(ws + WS_MQ + (size_t)(ct >> 1) * (80 * MiB)); ldc = 512; colt = (ct & 1) * 256; }
        else if (ct < 10) { base = (bf16_t*)(ws + WS_AQ); ldc = 512; colt = (ct - 8) * 256; }
        else if (ct == 10) { base = (bf16_t*)(ws + WS_AK); ldc = 256; colt = 0; }
        else if (ct == 11) { base = (bf16_t*)(ws + WS_AV); ldc = 256; colt = 0; }
        else if (ct < 16) { base = (bf16_t*)(ws + WS_GM); ldc = 1024; colt = (ct - 12) * 256; }
        else { base = (bf16_t*)(ws + WS_GA); ldc = 1024; colt = (ct - 16) * 256; }
        const int row0 = u.pm * BM + wr * 64 + fr, col0 = colt + wc * 32 + 8 * fq;
#pragma unroll
        for (int ai = 0; ai < 2; ++ai)
#pragma unroll
            for (int m = 0; m < 4; ++m) { bf16_t* rowp = base + (size_t)(row0 + ai * HALF + m * 16) * ldc + col0;
#pragma unroll
                for (int bj = 0; bj < 2; ++bj) { const f32x4 v0 = acc[ai][bj][m][0], v1 = acc[ai][bj][m][1];
                    u32x4 w; w.x = cvt_pk_bf16(v0[0], v0[1]); w.y = cvt_pk_bf16(v0[2], v0[3]); w.z = cvt_pk_bf16(v1[0], v1[1]); w.w = cvt_pk_bf16(v1[2], v1[3]);
                    *(u32x4*)(rowp + bj * HALF) = w; } }
    }
};
#define PG8_SCR_SETUP const unsigned lo16 = (threadIdx.x & 63u) * 16u; const int wid_ = __builtin_amdgcn_readfirstlane(threadIdx.x >> 6); \
        unsigned char* sa_u = scr + ((size_t)(blockIdx.x * 2 + 0) * 8 + wid_) * 16384; unsigned char* sb_u = scr + ((size_t)(blockIdx.x * 2 + 1) * 8 + wid_) * 16384;
#define sa(k) (sa_u + (k) * 1024 + lo16)
#define sb(k) (sb_u + (k) * 1024 + lo16)
struct EpiGate {
    static constexpr bool PERM = true; static constexpr int NVM = 16;
    unsigned char* scr;
    DI bool keep(const Unit&) const { return false; }
    DI void operator()(f32x4 (&acc)[2][2][4][2], const Unit& u, int wr, int wc, int fr, int fq) const {
        PG8_SCR_SETUP
        if (u.sel == 0) {
#pragma unroll
            for (int ai = 0; ai < 2; ++ai)
#pragma unroll
                for (int m = 0; m < 4; ++m)
#pragma unroll
                    for (int bj = 0; bj < 2; ++bj) { float v[8];
#pragma unroll
                        for (int e = 0; e < 8; ++e) v[e] = sigmoidf_(acc[ai][bj][m][e >> 2][e & 3]);
                        u32x4 w; w.x = pk2(v[0], v[1]); w.y = pk2(v[2], v[3]); w.z = pk2(v[4], v[5]); w.w = pk2(v[6], v[7]);
                        *(u32x4*)sa(ai * 8 + m * 2 + bj) = w; }
        } else {
#pragma unroll
            for (int ai = 0; ai < 2; ++ai) {
                u32x4 A8[4][2];
#pragma unroll
                for (int m = 0; m < 4; ++m)
#pragma unroll
                    for (int bj = 0; bj < 2; ++bj) A8[m][bj] = *(const u32x4*)sa(ai * 8 + m * 2 + bj);
#pragma unroll
                for (int m = 0; m < 4; ++m)
#pragma unroll
                    for (int bj = 0; bj < 2; ++bj) { float r[8], b[8];
#pragma unroll
                        for (int e = 0; e < 8; ++e) { const float av = (e & 1) ? bfhi(A8[m][bj][e >> 1]) : bflo(A8[m][bj][e >> 1]); const float den = 1.f + __expf(-acc[ai][bj][m][e >> 2][e & 3]);
                            b[e] = __builtin_amdgcn_rcpf(den); r[e] = av * den; }
                        u32x4 wr_, wb_; wr_.x = pk2(r[0], r[1]); wr_.y = pk2(r[2], r[3]); wr_.z = pk2(r[4], r[5]); wr_.w = pk2(r[6], r[7]);
                        wb_.x = pk2(b[0], b[1]); wb_.y = pk2(b[2], b[3]); wb_.z = pk2(b[4], b[5]); wb_.w = pk2(b[6], b[7]);
                        *(u32x4*)sa(ai * 8 + m * 2 + bj) = wr_; *(u32x4*)sb(ai * 8 + m * 2 + bj) = wb_; }
            }
        }
    }
};
struct EpiMix {
    static constexpr bool PERM = true; static constexpr int NVM = 16;
    bf16_t* Y; unsigned char* scr;
    DI bool keep(const Unit& u) const { return u.sel == 0; }
    DI void operator()(f32x4 (&acc)[2][2][4][2], const Unit& u, int wr, int wc, int fr, int fq) const {
        PG8_SCR_SETUP
        if (u.sel == 0) {
#pragma unroll
            for (int ai = 0; ai < 2; ++ai) {
                u32x4 A8[4][2];
#pragma unroll
                for (int m = 0; m < 4; ++m)
#pragma unroll
                    for (int bj = 0; bj < 2; ++bj) A8[m][bj] = *(const u32x4*)sa(ai * 8 + m * 2 + bj);
#pragma unroll
                for (int m = 0; m < 4; ++m)
#pragma unroll
                    for (int bj = 0; bj < 2; ++bj)
#pragma unroll
                        for (int e = 0; e < 8; ++e) { const float rv = (e & 1) ? bfhi(A8[m][bj][e >> 1]) : bflo(A8[m][bj][e >> 1]); acc[ai][bj][m][e >> 2][e & 3] *= rv; }
            }
        } else {
            const int row0 = u.pm * BM + wr * 64 + fr, col0 = u.pn * BM + wc * 32 + 8 * fq;
#pragma unroll
            for (int ai = 0; ai < 2; ++ai) {
                u32x4 B8[4][2];
#pragma unroll
                for (int m = 0; m < 4; ++m)
#pragma unroll
                    for (int bj = 0; bj < 2; ++bj) B8[m][bj] = *(const u32x4*)sb(ai * 8 + m * 2 + bj);
#pragma unroll
                for (int m = 0; m < 4; ++m)
#pragma unroll
                    for (int bj = 0; bj < 2; ++bj) { float v[8];
#pragma unroll
                        for (int e = 0; e < 8; ++e) { const float bv = (e & 1) ? bfhi(B8[m][bj][e >> 1]) : bflo(B8[m][bj][e >> 1]); v[e] = acc[ai][bj][m][e >> 2][e & 3] * bv; }
                        u32x4 w; w.x = pk2(v[0], v[1]); w.y = pk2(v[2], v[3]); w.z = pk2(v[4], v[5]); w.w = pk2(v[6], v[7]);
                        *(u32x4*)(Y + (size_t)(row0 + ai * HALF + m * 16) * DM + col0 + bj * HALF) = w; }
            }
        }
    }
};
#undef PG8_SCR_SETUP
#undef sa
#undef sb
template <bool WITH_HN> struct EpiRes {
    static constexpr bool PERM = true; static constexpr int NVM = 16;
    const float* xp; const float* xs; float* out; bf16_t* hn; float* ss;
    DI bool keep(const Unit&) const { return false; }
    template <int Q> DI void ld(f32x4 (&B)[2][2][2], const Unit& u, int wr, int fr, int cb0) const {
#pragma unroll
        for (int mm = 0; mm < 2; ++mm) { const int t = u.pm * BM + (Q >> 1) * HALF + wr * 64 + (2 * (Q & 1) + mm) * 16 + fr; const float* br = xrow_ptr(xp, xs, t);
#pragma unroll
            for (int bj = 0; bj < 2; ++bj)
#pragma unroll
                for (int n = 0; n < 2; ++n) B[mm][bj][n] = *(const f32x4*)(br + cb0 + bj * HALF + 4 * n); }
    }
    template <int Q> DI void st(const f32x4 (&B)[2][2][2], const f32x4 (&acc)[2][2][4][2], const Unit& u, int wr, int wc, int fr, int fq, int cb0) const {
#pragma unroll
        for (int mm = 0; mm < 2; ++mm) { const int m = 2 * (Q & 1) + mm, ai = Q >> 1; const int t = u.pm * BM + ai * HALF + wr * 64 + m * 16 + fr; float ssq = 0.f;
#pragma unroll
            for (int bj = 0; bj < 2; ++bj) { const int c = cb0 + bj * HALF;
                const f32x4 h0 = B[mm][bj][0] + acc[ai][bj][m][0], h1 = B[mm][bj][1] + acc[ai][bj][m][1];
                ssq += ((h0[0] * h0[0] + h0[1] * h0[1]) + (h0[2] * h0[2] + h0[3] * h0[3])) + ((h1[0] * h1[0] + h1[1] * h1[1]) + (h1[2] * h1[2] + h1[3] * h1[3]));
                u32x4 w; w.x = cvt_pk_bf16(h0[0], h0[1]); w.y = cvt_pk_bf16(h0[2], h0[3]); w.z = cvt_pk_bf16(h1[0], h1[1]); w.w = cvt_pk_bf16(h1[2], h1[3]); *(u32x4*)(hn + (size_t)t * DM + c) = w; }
            ssq += __shfl_xor(ssq, 16); ssq += __shfl_xor(ssq, 32); if (fq == 0) ss[(size_t)t * 16 + u.pn * 4 + wc] = ssq; }
    }
    DI void operator()(f32x4 (&acc)[2][2][4][2], const Unit& u, int wr, int wc, int fr, int fq) const {
        const int cb0 = u.pn * BM + wc * 32 + 8 * fq;
        f32x4 B0[2][2][2], B1[2][2][2];
        ld<0>(B0, u, wr, fr, cb0); ld<1>(B1, u, wr, fr, cb0);
        st<0>(B0, acc, u, wr, wc, fr, fq, cb0); ld<2>(B0, u, wr, fr, cb0);
        st<1>(B1, acc, u, wr, wc, fr, fq, cb0); ld<3>(B1, u, wr, fr, cb0);
        st<2>(B0, acc, u, wr, wc, fr, fq, cb0); st<3>(B1, acc, u, wr, wc, fr, fq, cb0);
    }
};
DI float dpp_ror1(float x) { return __builtin_bit_cast(float, __builtin_amdgcn_update_dpp(0, __builtin_bit_cast(int, x), 0x121, 0xf, 0xf, false)); }
DI float dpp_rol1(float x) { return __builtin_bit_cast(float, __builtin_amdgcn_update_dpp(0, __builtin_bit_cast(int, x), 0x12F, 0xf, 0xf, false)); }
struct EpiConv {
    static constexpr bool PERM = true; static constexpr int NVM = 0;
    bf16_t* G; const float* ss; const float* cw; const float* cb; LAS float* xch;
    DI bool keep(const Unit&) const { return false; }
    DI void operator()(f32x4 (&acc)[2][2][4][2], const Unit& u, int wr, int wc, int fr, int fq) const {
        const int t0 = 254 * u.pm - 1 + 128 * wr + 8 * fr;
        unsigned upz = 0, dnz = 0, stm = 0;
        f32x4 P8[8];
#pragma unroll
        for (int idx = 0; idx < 8; ++idx) { const int t = t0 + idx; const int tc = t < 0 ? 0 : (t >= MTOK ? MTOK - 1 : t); P8[idx] = *(const f32x4*)(ss + (size_t)tc * 16 + 4 * fq); }
#pragma unroll
        for (int idx = 0; idx < 8; ++idx) { const int rho = 128 * wr + 8 * fr + idx, t = t0 + idx;
            const f32x4 p = P8[idx]; float s = (p[0] + p[1]) + (p[2] + p[3]); s += __shfl_xor(s, 16); s += __shfl_xor(s, 32);
            const float rs = __builtin_amdgcn_rsqf(s * (1.f / DM) + EPS);
#pragma unroll
            for (int bj = 0; bj < 2; ++bj)
#pragma unroll
                for (int n = 0; n < 2; ++n) acc[idx >> 2][bj][idx & 3][n] *= rs;
            if (seq_start(t)) upz |= 1u << idx;
            if (t + 1 >= MTOK || seq_start(t + 1)) dnz |= 1u << idx;
            if (rho >= 1 && rho <= 254 && t < MTOK) stm |= 1u << idx; }
        const bool anyb = __builtin_amdgcn_ballot_w64((upz | dnz) != 0u) != 0ull;
        f32x4 X[2][2];
        { LAS float* xw = xch + ((wr * 4 + wc) * 4 + fq) * 16; LAS const float* xr = xch + (((wr ^ 1) * 4 + wc) * 4 + fq) * 16;
          if (wr == 0) { if (fr == 15) {
#pragma unroll
              for (int bj = 0; bj < 2; ++bj)
#pragma unroll
                  for (int n = 0; n < 2; ++n) *(LAS f32x4*)(xw + (bj * 2 + n) * 4) = acc[1][bj][3][n]; } }
          else { if (fr == 0) {
#pragma unroll
              for (int bj = 0; bj < 2; ++bj)
#pragma unroll
                  for (int n = 0; n < 2; ++n) *(LAS f32x4*)(xw + (bj * 2 + n) * 4) = acc[0][bj][0][n]; } }
          asm volatile("s_waitcnt lgkmcnt(0)" ::: "memory"); __builtin_amdgcn_s_barrier(); asm volatile("" ::: "memory");
#pragma unroll
          for (int bj = 0; bj < 2; ++bj)
#pragma unroll
              for (int n = 0; n < 2; ++n) X[bj][n] = *(LAS const f32x4*)(xr + (bj * 2 + n) * 4); }
        const bool xup = (wr == 1) && (fr == 0), xdn = (wr == 0) && (fr == 15);
        f32x4 W[2][4];
#define LOADW(n_) _Pragma("unroll") for (int bj = 0; bj < 2; ++bj) { const int cc = bj * DFF + u.pn * 128 + wc * 32 + 8 * fq + 4 * (n_); \
            W[bj][0] = *(const f32x4*)(cw + cc); W[bj][1] = *(const f32x4*)(cw + NUP + cc); W[bj][2] = *(const f32x4*)(cw + 2 * NUP + cc); W[bj][3] = *(const f32x4*)(cb + cc); }
        LOADW(0)
        unsigned pk[2][8][2];
#pragma unroll
        for (int n = 0; n < 2; ++n) {
            const int ch = u.pn * 128 + wc * 32 + 8 * fq + 4 * n;
            float ca[8][4];
#pragma unroll
            for (int bj = 0; bj < 2; ++bj) {
                const f32x4 w0 = W[bj][0], w1 = W[bj][1], w2 = W[bj][2], bb = W[bj][3];
#pragma unroll
                for (int jp = 0; jp < 2; ++jp) {
                    const f32n2 w0p = {w0[2 * jp], w0[2 * jp + 1]}, w1p = {w1[2 * jp], w1[2 * jp + 1]}, w2p = {w2[2 * jp], w2[2 * jp + 1]}, bbp = {bb[2 * jp], bb[2 * jp + 1]};
                    f32n2 v[8];
#pragma unroll
                    for (int idx = 0; idx < 8; ++idx) v[idx] = (f32n2){acc[idx >> 2][bj][idx & 3][n][2 * jp], acc[idx >> 2][bj][idx & 3][n][2 * jp + 1]};
                    f32n2 up0 = {dpp_ror1(v[7].x), dpp_ror1(v[7].y)}, dn7 = {dpp_rol1(v[0].x), dpp_rol1(v[0].y)};
                    if (xup) up0 = (f32n2){X[bj][n][2 * jp], X[bj][n][2 * jp + 1]};
                    if (xdn) dn7 = (f32n2){X[bj][n][2 * jp], X[bj][n][2 * jp + 1]};
                    f32n2 cv[8];
#pragma unroll
                    for (int idx = 0; idx < 8; ++idx) { f32n2 up = idx ? v[idx > 0 ? idx - 1 : 0] : up0, dn = idx < 7 ? v[idx < 7 ? idx + 1 : 7] : dn7;
                        if (anyb) { if ((upz >> idx) & 1u) up = (f32n2){0.f, 0.f}; if ((dnz >> idx) & 1u) dn = (f32n2){0.f, 0.f}; }
                        cv[idx] = w0p * up + (w1p * v[idx] + (w2p * dn + bbp)); }
                    if (bj == 0) {
#pragma unroll
                        for (int idx = 0; idx < 8; ++idx) { ca[idx][2 * jp] = cv[idx].x; ca[idx][2 * jp + 1] = cv[idx].y; }
                    } else {
#pragma unroll
                        for (int idx = 0; idx < 8; ++idx) { const f32n2 a2 = {ca[idx][2 * jp], ca[idx][2 * jp + 1]}; const f32n2 sg = {sigmoidf_(a2.x), sigmoidf_(a2.y)};
                            const f32n2 r2 = (a2 * sg) * cv[idx]; ca[idx][2 * jp] = r2.x; ca[idx][2 * jp + 1] = r2.y; }
                    } } }
#pragma unroll
            for (int idx = 0; idx < 8; ++idx) { pk[n][idx][0] = cvt_pk_bf16_asm(ca[idx][0], ca[idx][1]); pk[n][idx][1] = cvt_pk_bf16_asm(ca[idx][2], ca[idx][3]); }
            if (n == 0) { LOADW(1) }
            (void)ch;
        }
        { const int ch0 = u.pn * 128 + wc * 32 + 8 * fq;
#pragma unroll
          for (int idx = 0; idx < 8; ++idx) if ((stm >> idx) & 1u) { u32x4 w; w.x = pk[0][idx][0]; w.y = pk[0][idx][1]; w.z = pk[1][idx][0]; w.w = pk[1][idx][1]; *(u32x4*)(G + (size_t)(t0 + idx) * DFF + ch0) = w; } }
#undef LOADW
    }
};
struct EpiFinal {
    static constexpr bool PERM = true; static constexpr int NVM = 32;
    float* out; const bf16_t* hn; const float* nfw; unsigned* xs; unsigned* cnt;
    DI bool keep(const Unit&) const { return false; }
    template <int Q> DI void ld(f32x4 (&B)[2][2][2], const Unit& u, int wr, int fr, int cb0) const {
#pragma unroll
        for (int mm = 0; mm < 2; ++mm) { const int t = u.pm * BM + (Q >> 1) * HALF + wr * 64 + (2 * (Q & 1) + mm) * 16 + fr; const bf16_t* br = hn + (size_t)t * DM;
#pragma unroll
            for (int bj = 0; bj < 2; ++bj) { const u32x4 w = *(const u32x4*)(br + cb0 + bj * HALF);
                B[mm][bj][0] = (f32x4){bflo(w.x), bfhi(w.x), bflo(w.y), bfhi(w.y)}; B[mm][bj][1] = (f32x4){bflo(w.z), bfhi(w.z), bflo(w.w), bfhi(w.w)}; } }
    }
    template <int Q> DI void add(const f32x4 (&B)[2][2][2], f32x4 (&acc)[2][2][4][2], const Unit& u, int wr, int wc, int fr, int fq) const {
#pragma unroll
        for (int mm = 0; mm < 2; ++mm) { const int m = 2 * (Q & 1) + mm, ai = Q >> 1; const int t = u.pm * BM + ai * HALF + wr * 64 + m * 16 + fr; float ssq = 0.f;
#pragma unroll
            for (int bj = 0; bj < 2; ++bj)
#pragma unroll
                for (int n = 0; n < 2; ++n) { const f32x4 hv = B[mm][bj][n] + acc[ai][bj][m][n]; acc[ai][bj][m][n] = hv; ssq += (hv[0] * hv[0] + hv[1] * hv[1]) + (hv[2] * hv[2] + hv[3] * hv[3]); }
            ssq += __shfl_xor(ssq, 16); ssq += __shfl_xor(ssq, 32);
            if (fq == 0) __hip_atomic_store(xs + (size_t)t * 16 + u.pn * 4 + wc, __float_as_uint(ssq), __ATOMIC_RELAXED, __HIP_MEMORY_SCOPE_AGENT); }
    }
    DI void operator()(f32x4 (&acc)[2][2][4][2], const Unit& u, int wr, int wc, int fr, int fq) const {
        const int lane = threadIdx.x & 63, cb0 = u.pn * BM + wc * 32 + 8 * fq;
        { f32x4 B0[2][2][2], B1[2][2][2];
          ld<0>(B0, u, wr, fr, cb0); ld<1>(B1, u, wr, fr, cb0);
          add<0>(B0, acc, u, wr, wc, fr, fq); ld<2>(B0, u, wr, fr, cb0);
          add<1>(B1, acc, u, wr, wc, fr, fq); ld<3>(B1, u, wr, fr, cb0);
          add<2>(B0, acc, u, wr, wc, fr, fq); add<3>(B1, acc, u, wr, wc, fr, fq); }
        asm volatile("s_waitcnt vmcnt(0)" ::: "memory");
        unsigned* cw_ = cnt + 64 * u.pm;
        if (lane == 0) __hip_atomic_fetch_add(cw_, 1u, __ATOMIC_RELAXED, __HIP_MEMORY_SCOPE_AGENT);
        f32x4 W4[2][2];
#pragma unroll
        for (int bj = 0; bj < 2; ++bj)
#pragma unroll
            for (int n = 0; n < 2; ++n) W4[bj][n] = *(const f32x4*)(nfw + cb0 + bj * HALF + 4 * n);
        while ((unsigned)__builtin_amdgcn_readfirstlane(__hip_atomic_load(cw_, __ATOMIC_RELAXED, __HIP_MEMORY_SCOPE_AGENT)) < 32u) __builtin_amdgcn_s_sleep(2);
        asm volatile("" ::: "memory");
        unsigned Pp[8][4];
#pragma unroll
        for (int idx = 0; idx < 8; ++idx) { const int t = u.pm * BM + (idx >> 2) * HALF + wr * 64 + (idx & 3) * 16 + fr; const unsigned* xp_ = xs + (size_t)t * 16 + 4 * fq;
#pragma unroll
            for (int q = 0; q < 4; ++q) Pp[idx][q] = __hip_atomic_load(xp_ + q, __ATOMIC_RELAXED, __HIP_MEMORY_SCOPE_AGENT); }
#pragma unroll
        for (int idx = 0; idx < 8; ++idx) { const int ai = idx >> 2, m = idx & 3; const int t = u.pm * BM + ai * HALF + wr * 64 + m * 16 + fr; float* orow = out + (size_t)t * DM;
            float s = (__uint_as_float(Pp[idx][0]) + __uint_as_float(Pp[idx][1])) + (__uint_as_float(Pp[idx][2]) + __uint_as_float(Pp[idx][3]));
            s += __shfl_xor(s, 16); s += __shfl_xor(s, 32);
            const float rs = 1.f / sqrtf(s * (1.f / DM) + EPS);
#pragma unroll
            for (int bj = 0; bj < 2; ++bj)
#pragma unroll
                for (int n = 0; n < 2; ++n) *(f32x4*)(orow + cb0 + bj * HALF + 4 * n) = acc[ai][bj][m][n] * rs * W4[bj][n]; }
    }
};
}

DI void transpose_item(const float* W, int ldw, int src_col0, int k0, bf16_t* WT, int K, int dst_row0, const float* kscale, float nscale, LAS float* scr, int lane) {
    float wv[32];
#pragma unroll
    for (int i = 0; i < 32; ++i) { const int kk = 2 * i + (lane >> 5); wv[i] = W[(size_t)(k0 + kk) * ldw + src_col0 + (lane & 31)]; }
#pragma unroll
    for (int i = 0; i < 32; ++i) { const int kk = 2 * i + (lane >> 5); const float s = kscale ? kscale[k0 + kk] * nscale : nscale;
        scr[kk * 33 + (lane & 31)] = wv[i] * s; }
    asm volatile("s_waitcnt lgkmcnt(0)" ::: "memory");
    const int c = lane & 7;
#pragma unroll
    for (int j = 0; j < 4; ++j) { const int n = (lane >> 3) + 8 * j; const LAS float* s = scr + (8 * c) * 33 + n;
        u32x4 o; o.x = pk2(s[0 * 33], s[1 * 33]); o.y = pk2(s[2 * 33], s[3 * 33]); o.z = pk2(s[4 * 33], s[5 * 33]); o.w = pk2(s[6 * 33], s[7 * 33]);
        *(u32x4*)(WT + (size_t)(dst_row0 + n) * K + k0 + 8 * c) = o; }
    asm volatile("s_waitcnt lgkmcnt(0)" ::: "memory");
}
DI float reduce16(const float (&p)[16], int lane) {
    const bool b5 = lane & 32, b4 = lane & 16, b3 = lane & 8, b2 = lane & 4;
    float q[8], r[4], s[2];
#pragma unroll
    for (int j = 0; j < 8; ++j) { const float send = b5 ? p[j] : p[j + 8], keep = b5 ? p[j + 8] : p[j]; q[j] = keep + __shfl_xor(send, 32); }
#pragma unroll
    for (int j = 0; j < 4; ++j) { const float send = b4 ? q[j] : q[j + 4], keep = b4 ? q[j + 4] : q[j]; r[j] = keep + __shfl_xor(send, 16); }
#pragma unroll
    for (int j = 0; j < 2; ++j) { const float send = b3 ? r[j] : r[j + 2], keep = b3 ? r[j + 2] : r[j]; s[j] = keep + __shfl_xor(send, 8); }
    const float send = b2 ? s[0] : s[1], keep = b2 ? s[1] : s[0]; float v = keep + __shfl_xor(send, 4);
    v += __shfl_xor(v, 2); v += __shfl_xor(v, 1); return v;
}

struct ChunkVec { float g0, g1, b0, b1, cm0, cm1, btot, gmax; int s0, s1; };
struct ChunkGates { float i0, f0, i1, f1; int s0, s1; };
DI ChunkGates chunk_gates_load(int d, const float* gates, int t0, int head, int lane) {
    ChunkGates q; const int e0 = 2 * lane, e1 = e0 + 1; q.s0 = d ? 127 - e0 : e0; q.s1 = d ? 127 - e1 : e1;
    const float* g0p = gates + (size_t)(t0 + q.s0) * 16 + d * 4 + head; const float* g1p = gates + (size_t)(t0 + q.s1) * 16 + d * 4 + head;
    q.i0 = g0p[0]; q.f0 = g0p[8]; q.i1 = g1p[0]; q.f1 = g1p[8]; return q;
}
DI ChunkVec chunk_vectors_from(const ChunkGates& q, int lane) {
    ChunkVec r; r.s0 = q.s0; r.s1 = q.s1;
    const float i0 = q.i0, f0 = q.f0, i1 = q.i1, f1 = q.f1;
    const float lf0 = logsigmoid_(f0), lf1 = logsigmoid_(f1);
    float ps = lf0 + lf1;
#pragma unroll
    for (int o = 1; o < 64; o <<= 1) { const float t = __shfl_up(ps, o); if (lane >= o) ps += t; }
    const float excl = ps - (lf0 + lf1); r.b0 = excl + lf0; r.b1 = r.b0 + lf1;
    r.g0 = i0 - r.b0; r.g1 = i1 - r.b1;
    float cm = fmaxf(r.g0, r.g1);
#pragma unroll
    for (int o = 1; o < 64; o <<= 1) { const float t = __shfl_up(cm, o); if (lane >= o) cm = fmaxf(cm, t); }
    float ex = __shfl_up(cm, 1); if (lane == 0) ex = -INFINITY;
    r.cm0 = fmaxf(ex, r.g0); r.cm1 = fmaxf(r.cm0, r.g1);
    r.btot = __shfl(r.b1, 63); r.gmax = __shfl(r.cm1, 63);
    return r;
}
DI ChunkVec chunk_vectors(int d, const float* gates, int t0, int head, int lane) { return chunk_vectors_from(chunk_gates_load(d, gates, t0, head, lane), lane); }

struct Ctx {
    const float* in[17]; float* out; unsigned char* ws;
};

DI void summary_prefetch(const Ctx& c, int chunk, int head, int tid, u32x4 (&v8r)[4], u32x4 (&k8r)[4]) {
    const bf16_t* MK = (const bf16_t*)(c.ws + WS_MK); const bf16_t* MV = (const bf16_t*)(c.ws + WS_MV); const int t0 = chunk * 128;
#pragma unroll
    for (int i = 0; i < 4; ++i) { const int idx = tid + 512 * i, s = idx & 127, ch = idx >> 7; const size_t go = (size_t)(t0 + s) * 512 + head * 128 + ch * 8; v8r[i] = *(const u32x4*)(MV + go); k8r[i] = *(const u32x4*)(MK + go); }
}
DI void summary_unit(LAS unsigned char* lds, const Ctx& c, int chunk, int head, int nchunk, int nhead, u32x4 (&v8r)[4], u32x4 (&k8r)[4], int tid, int lane, int wid) {
    asm volatile("" : "+v"(tid), "+v"(lane));
    const int t0 = chunk * 128, fr = lane & 15, fq = lane >> 4;
    LAS bf16_t* LVT = (LAS bf16_t*)lds; LAS bf16_t* LKF = (LAS bf16_t*)(lds + 34816); LAS bf16_t* LKB = (LAS bf16_t*)(lds + 69632); LAS float* vW = (LAS float*)(lds + 104448);
    const float* gates = (const float*)(c.ws + WS_GATES);
    const bf16_t* MK = (const bf16_t*)(c.ws + WS_MK); const bf16_t* MV = (const bf16_t*)(c.ws + WS_MV);
    if (wid < 2) { const int d = wid; const ChunkVec v = chunk_vectors(d, gates, t0, head, lane);
        vW[d * 128 + v.s0] = __expf(v.g0 - v.gmax); vW[d * 128 + v.s1] = __expf(v.g1 - v.gmax);
        if (lane == 0) { float* sc = (float*)(c.ws + WS_CHSC) + ((size_t)(d * NCHUNK + chunk) * 4 + head) * 2; sc[0] = v.btot; sc[1] = v.btot + v.gmax; } }
    __syncthreads();
#pragma unroll
    for (int i = 0; i < 4; ++i) { const int idx = tid + 512 * i, s = idx & 127, ch = idx >> 7;
        const u32x4 v8 = v8r[i], k8 = k8r[i]; const float wf = vW[s], wb = vW[128 + s];
#pragma unroll
        for (int e = 0; e < 8; ++e) { const unsigned vw = v8[e >> 1], kw = k8[e >> 1]; const float kf = (e & 1) ? bfhi(kw) : bflo(kw);
            LVT[(8 * ch + e) * 136 + s] = (bf16_t)((e & 1) ? (vw >> 16) : (vw & 0xffffu));
            const unsigned fb = pk2(wf * kf, wb * kf); LKF[(8 * ch + e) * 136 + s] = (bf16_t)(fb & 0xffffu); LKB[(8 * ch + e) * 136 + s] = (bf16_t)(fb >> 16); } }
    summary_prefetch(c, nchunk, nhead, tid, v8r, k8r);
    __syncthreads();
    const int d = wid & 1, cgp = wid >> 1;
    LAS const unsigned char* LKD = (LAS const unsigned char*)(d ? LKB : LKF);
    bf16x8 Y[2][4];
#pragma unroll
    for (int ci = 0; ci < 2; ++ci)
#pragma unroll
        for (int ks = 0; ks < 4; ++ks) Y[ci][ks] = *(LAS const bf16x8*)(LKD + (32 * cgp + 8 * (fr >> 2) + 4 * ci + (fr & 3)) * 272 + (32 * ks + 8 * fq) * 2);
    bf16_t* ST = (bf16_t*)(c.out) + ((size_t)(d * NCHUNK + chunk) * 4 + head) * ST_ELEMS;
#pragma unroll
    for (int rt = 0; rt < 9; ++rt) {
        bf16x8 X[4];
#pragma unroll
        for (int ks = 0; ks < 4; ++ks) {
            if (rt < 8) X[ks] = *(LAS const bf16x8*)((LAS const unsigned char*)LVT + (16 * rt + fr) * 272 + (32 * ks + 8 * fq) * 2);
            else { const short o = fr == 0 ? (short)0x3F80 : (short)0; X[ks] = (bf16x8){o, o, o, o, o, o, o, o}; } }
        f32x4 a2[2];
#pragma unroll
        for (int ci = 0; ci < 2; ++ci) { a2[ci] = (f32x4){0.f, 0.f, 0.f, 0.f};
#pragma unroll
            for (int ks = 0; ks < 4; ++ks) a2[ci] = MFMA16(Y[ci][ks], X[ks], a2[ci]); }
        { const int v = 16 * rt + fr, k = 32 * cgp + 8 * fq;
          if (rt < 8 || fr == 0) { u32x4 w; w.x = pk2(a2[0][0], a2[0][1]); w.y = pk2(a2[0][2], a2[0][3]); w.z = pk2(a2[1][0], a2[1][1]); w.w = pk2(a2[1][2], a2[1][3]); *(u32x4*)(ST + (size_t)v * 128 + k) = w; } }
    }
    __syncthreads();
}

DI void attn_unit(LAS unsigned char* lds, const Ctx& c, int qb2, int hk, int tid, int lane, int wid) {
    asm volatile("" : "+v"(tid), "+v"(lane));
    const int t0 = qb2 * 256, fr = lane & 15, fq = lane >> 4;
    const int nseq = qb2 < 64 ? qb2 : ((qb2 - 64) & 15), Nseq = qb2 < 64 ? 64 : 16, pos0 = nseq * 256;
    const bool bv0 = nseq >= 1, bv3 = nseq + 1 < Nseq;
    LAS unsigned char* LKB = lds; LAS bf16_t* LVT = (LAS bf16_t*)(lds + 73728);
    const bf16_t* AK = (const bf16_t*)(c.ws + WS_AK); const bf16_t* AV = (const bf16_t*)(c.ws + WS_AV); const bf16_t* AQ = (const bf16_t*)(c.ws + WS_AQ);
    const float* rope = (const float*)(c.ws + WS_ROPE);
    const int g = wid >> 2, rg = wid & 3, hq = 2 * hk + g, r0 = 64 * rg;
#define ATT_OK(j) ((((j) >> 7) == 0) ? bv0 : ((((j) >> 7) == 3) ? bv3 : true))
    u32x4 kb[6];
#pragma unroll
    for (int i = 0; i < 6; ++i) { const int idx = tid + 512 * i; const int j = idx / 6, ch = 2 + (idx - 6 * j); const bool ok = ATT_OK(j);
        const int tok = ok ? t0 - 128 + j : t0 + (j & 127); kb[i] = *(const u32x4*)((const char*)AK + (unsigned)((tok * 256 + hk * 64 + ch * 8) * 2)); }
    u32x4 kx1, kx2; f32x4 ktb[4];
    { const int j = tid; const bool ok = ATT_OK(j); const int tok = ok ? t0 - 128 + j : t0 + (j & 127);
      const unsigned ko = (unsigned)((tok * 256 + hk * 64) * 2); kx1 = *(const u32x4*)((const char*)AK + ko); kx2 = *(const u32x4*)((const char*)AK + ko + 16u);
      const unsigned to = (unsigned)((ok ? pos0 - 128 + j : 0) * 64);
#pragma unroll
      for (int q = 0; q < 4; ++q) ktb[q] = *(const f32x4*)((const char*)rope + to + 16u * q); }
    u32x4 vb[8];
#pragma unroll
    for (int i = 0; i < 8; ++i) { const int idx = tid + 512 * i, ch = idx >> 9, j = idx & 511; const bool ok = ATT_OK(j);
        const int tok = ok ? t0 - 128 + j : t0 + (j & 127); vb[i] = *(const u32x4*)((const char*)AV + (unsigned)((tok * 256 + hk * 64 + ch * 8) * 2)); }
#pragma unroll
    for (int i = 0; i < 6; ++i) { const int idx = tid + 512 * i; const int j = idx / 6, ch = 2 + (idx - 6 * j); const bool ok = ATT_OK(j);
        *(LAS u32x4*)(LKB + j * 144 + ch * 16) = ok ? kb[i] : (u32x4){0u, 0u, 0u, 0u}; }
    { const int j = tid; const bool ok = ATT_OK(j);
      float ra[8], rb[8];
#pragma unroll
      for (int e = 0; e < 8; ++e) { const float a = (e & 1) ? bfhi(kx1[e >> 1]) : bflo(kx1[e >> 1]), b = (e & 1) ? bfhi(kx2[e >> 1]) : bflo(kx2[e >> 1]); const float cs = ktb[e >> 2][e & 3], sn = ktb[2 + (e >> 2)][e & 3];
          ra[e] = a * cs - b * sn; rb[e] = b * cs + a * sn; }
      u32x4 o1, o2; o1.x = pk2(ra[0], ra[1]); o1.y = pk2(ra[2], ra[3]); o1.z = pk2(ra[4], ra[5]); o1.w = pk2(ra[6], ra[7]); o2.x = pk2(rb[0], rb[1]); o2.y = pk2(rb[2], rb[3]); o2.z = pk2(rb[4], rb[5]); o2.w = pk2(rb[6], rb[7]);
      if (!ok) { o1 = (u32x4){0u, 0u, 0u, 0u}; o2 = o1; }
      *(LAS u32x4*)(LKB + j * 144) = o1; *(LAS u32x4*)(LKB + j * 144 + 16) = o2; }
#pragma unroll
    for (int i = 0; i < 8; ++i) { const int idx = tid + 512 * i, ch = idx >> 9, j = idx & 511; const bool ok = ATT_OK(j);
        const u32x4 v8 = ok ? vb[i] : (u32x4){0u, 0u, 0u, 0u};
#pragma unroll
        for (int e = 0; e < 8; ++e) { const unsigned vw = v8[e >> 1]; LVT[(8 * ch + e) * 520 + j] = (bf16_t)((e & 1) ? (vw >> 16) : (vw & 0xffffu)); } }
    asm volatile("" ::: "memory");
    const float sink = c.in[7][hq] * 1.4426950408889634f;
    bf16x8 Xq[4][2];
#pragma unroll
    for (int mi = 0; mi < 4; ++mi) { const int rho = r0 + 16 * mi + fr; const unsigned qo = (unsigned)(((t0 + rho) * 512 + hq * 64 + 8 * fq) * 2);
#pragma unroll
        for (int ks = 0; ks < 2; ++ks) {
            u32x4 q = *(const u32x4*)((const char*)AQ + qo + 64u * ks);
            if (ks == 0) { u32x4 pr; pr.x = __shfl_xor(q.x, 16); pr.y = __shfl_xor(q.y, 16); pr.z = __shfl_xor(q.z, 16); pr.w = __shfl_xor(q.w, 16);
                if (fq < 2) { float r[8]; const float* tb = rope + (size_t)(pos0 + rho) * 16;
#pragma unroll
                    for (int e = 0; e < 8; ++e) { const float own = (e & 1) ? bfhi(q[e >> 1]) : bflo(q[e >> 1]), oth = (e & 1) ? bfhi(pr[e >> 1]) : bflo(pr[e >> 1]); const float cs = tb[e], sn = tb[8 + e];
                        r[e] = fq == 0 ? (own * cs - oth * sn) : (own * cs + oth * sn); }
                    q.x = pk2(r[0], r[1]); q.y = pk2(r[2], r[3]); q.z = pk2(r[4], r[5]); q.w = pk2(r[6], r[7]); } }
            Xq[mi][ks] = __builtin_bit_cast(bf16x8, q); } }
    __syncthreads();
    f32x4 O[4][4]; float mrow[4], lrow[4];
#pragma unroll
    for (int mi = 0; mi < 4; ++mi) { mrow[mi] = sink; lrow[mi] = fq == 0 ? 1.f : 0.f;
#pragma unroll
        for (int nd = 0; nd < 4; ++nd) O[mi][nd] = (f32x4){0.f, 0.f, 0.f, 0.f}; }
    for (int kt = 0; kt < 10; ++kt) {
        const int j0 = r0 + 32 * kt;
        if (!ATT_OK(j0)) continue;
#pragma unroll
        for (int mh = 0; mh < 2; ++mh) {
            const int ra0 = r0 + 32 * mh;
            if (j0 + 31 < ra0 || j0 > ra0 + 31 + 256) continue;
            f32x4 S[2][2];
#pragma unroll
            for (int m2 = 0; m2 < 2; ++m2)
#pragma unroll
                for (int ni = 0; ni < 2; ++ni) S[m2][ni] = (f32x4){0.f, 0.f, 0.f, 0.f};
#pragma unroll
            for (int ks = 0; ks < 2; ++ks)
#pragma unroll
                for (int ni = 0; ni < 2; ++ni) { const bf16x8 Yk = *(LAS const bf16x8*)(LKB + (j0 + 16 * ni + fr) * 144 + (32 * ks + 8 * fq) * 2);
#pragma unroll
                    for (int m2 = 0; m2 < 2; ++m2) S[m2][ni] = MFMA16(Yk, Xq[2 * mh + m2][ks], S[m2][ni]); }
            bf16x8 Xp[2];
#pragma unroll
            for (int m2 = 0; m2 < 2; ++m2) { const int mi = 2 * mh + m2; const int rhoa = r0 + 16 * mi, rho = rhoa + fr;
                const bool full = (j0 >= rhoa + 15) && (j0 + 31 <= rhoa + 256);
                float mx = -INFINITY;
                if (full) {
#pragma unroll
                    for (int ni = 0; ni < 2; ++ni)
#pragma unroll
                        for (int jj = 0; jj < 4; ++jj) mx = fmaxf(mx, S[m2][ni][jj]);
                } else {
#pragma unroll
                    for (int ni = 0; ni < 2; ++ni)
#pragma unroll
                        for (int jj = 0; jj < 4; ++jj) { const int j = j0 + 16 * ni + 4 * fq + jj; const bool ok = (j >= rho) && (j <= rho + 256);
                            const float sv = ok ? S[m2][ni][jj] : -INFINITY; S[m2][ni][jj] = sv; mx = fmaxf(mx, sv); }
                }
                if (__builtin_amdgcn_ballot_w64(mx > mrow[mi] + 6.0f) != 0ull) {
                    mx = fmaxf(mx, __shfl_xor(mx, 16)); mx = fmaxf(mx, __shfl_xor(mx, 32));
                    const float mnew = fmaxf(mrow[mi], mx), alpha = __builtin_amdgcn_exp2f(mrow[mi] - mnew); mrow[mi] = mnew; lrow[mi] *= alpha;
#pragma unroll
                    for (int nd = 0; nd < 4; ++nd) O[mi][nd] *= alpha; }
                const float mref = mrow[mi];
                float p[8], ps = 0.f;
#pragma unroll
                for (int e = 0; e < 8; ++e) { p[e] = __builtin_amdgcn_exp2f(S[m2][e >> 2][e & 3] - mref); ps += p[e]; }
                lrow[mi] += ps;
                Xp[m2] = pack8(p); }
#pragma unroll
            for (int nd = 0; nd < 4; ++nd) { const LAS bf16_t* vp = LVT + (16 * nd + fr) * 520 + j0 + 4 * fq;
                const s16x4 lo = *(LAS const s16x4*)vp, hi = *(LAS const s16x4*)(vp + 16);
                const bf16x8 Yv = (bf16x8){lo[0], lo[1], lo[2], lo[3], hi[0], hi[1], hi[2], hi[3]};
#pragma unroll
                for (int m2 = 0; m2 < 2; ++m2) O[2 * mh + m2][nd] = MFMA16(Yv, Xp[m2], O[2 * mh + m2][nd]); }
        }
    }
#pragma unroll
    for (int mi = 0; mi < 4; ++mi) { float l = lrow[mi]; l += __shfl_xor(l, 16); l += __shfl_xor(l, 32); const float inv = 1.f / l;
        bf16_t* op = (bf16_t*)(c.ws + WS_HMOA) + (size_t)(t0 + r0 + 16 * mi + fr) * 1024 + 512 + hq * 64 + 4 * fq;
#pragma unroll
        for (int nd = 0; nd < 4; ++nd) { const f32x4 o = O[mi][nd] * inv; u32x2 w; w.x = pk2(o[0], o[1]); w.y = pk2(o[2], o[3]); *(u32x2*)(op + 16 * nd) = w; } }
    __syncthreads();
#undef ATT_OK
}

DI void scan_item(const Ctx& c, int st, int slice, int lane) {
    const int seq = st >> 3, head = (st >> 1) & 3, d = st & 1;
    const int chunk0 = seq == 0 ? 0 : 128 + 32 * (seq - 1), nch = seq == 0 ? 128 : 32;
    const int e0 = slice * 512 + lane * 8; const bool act = e0 < ST_ELEMS;
    bf16_t* CST = (bf16_t*)c.out; const float* CHSC = (const float*)(c.ws + WS_CHSC); float* MP = (float*)(c.ws + WS_MPREV);
    float C[8];
#pragma unroll
    for (int e = 0; e < 8; ++e) C[e] = 0.f;
    float m = 0.f;
    for (int i0 = 0; i0 < nch; i0 += 8) {
        u32x4 ld[8]; float bt[8], ml[8];
#pragma unroll
        for (int u = 0; u < 8; ++u) { const int ch = d ? chunk0 + nch - 1 - (i0 + u) : chunk0 + i0 + u; const size_t ti = (size_t)(d * NCHUNK + ch) * 4 + head;
            ld[u] = act ? *(const u32x4*)(CST + ti * ST_ELEMS + e0) : (u32x4){0u, 0u, 0u, 0u}; bt[u] = CHSC[ti * 2]; ml[u] = CHSC[ti * 2 + 1]; }
#pragma unroll
        for (int u = 0; u < 8; ++u) { const int ch = d ? chunk0 + nch - 1 - (i0 + u) : chunk0 + i0 + u; const size_t ti = (size_t)(d * NCHUNK + ch) * 4 + head;
            if (slice == 0 && lane == 0) MP[ti] = m;
            u32x4 o; o.x = pk2(C[0], C[1]); o.y = pk2(C[2], C[3]); o.z = pk2(C[4], C[5]); o.w = pk2(C[6], C[7]);
            if (act) *(u32x4*)(CST + ti * ST_ELEMS + e0) = o;
            const float mn = fmaxf(bt[u] + m, ml[u]), sp = __expf(bt[u] + m - mn), sl = __expf(ml[u] - mn); m = mn;
#pragma unroll
            for (int e = 0; e < 8; ++e) { const unsigned w = ld[u][e >> 1]; const float cl = (e & 1) ? bfhi(w) : bflo(w); C[e] = sp * C[e] + sl * cl; } }
    }
}

template <int DIR> DI void dir_pass(const f32x4 (&S)[8], const bf16x8 (&Xq)[4], LAS const unsigned char* LS, LAS const unsigned char* LVTb, LAS const float* vec, int trow, int fr, int fq, f32x4 (&hs)[8]) {
    f32x4 acc[9];
#pragma unroll
    for (int nt = 0; nt < 9; ++nt) { acc[nt] = (f32x4){0.f, 0.f, 0.f, 0.f};
#pragma unroll
        for (int ks = 0; ks < 4; ++ks) { const bf16x8 Y = *(LAS const bf16x8*)(LS + (16 * nt + fr) * 272 + (32 * ks + 8 * fq) * 2); acc[nt] = MFMA16(Y, Xq[ks], acc[nt]); } asm volatile("" ::: "memory"); }
    const float Mt = vec[128 + trow], ex = vec[256 + trow], iw = vec[384 + trow];
#pragma unroll
    for (int nt = 0; nt < 9; ++nt) acc[nt] *= iw;
    bf16x8 Xp[4];
#pragma unroll
    for (int kp = 0; kp < 4; ++kp) { float p[8];
#pragma unroll
        for (int h2 = 0; h2 < 2; ++h2) { const int n = 2 * kp + h2; const f32x4 g4 = *(LAS const f32x4*)(vec + 16 * n + 4 * fq);
#pragma unroll
            for (int j = 0; j < 4; ++j) { const int s = 16 * n + 4 * fq + j; const bool ok = DIR == 0 ? (s <= trow) : (s >= trow);
                p[4 * h2 + j] = ok ? S[n][j] * __builtin_amdgcn_exp2f(g4[j] - Mt) : 0.f; } }
        Xp[kp] = pack8(p); }
#pragma unroll
    for (int nt = 0; nt < 8; ++nt)
#pragma unroll
        for (int kp = 0; kp < 4; ++kp) { LAS const unsigned char* vp = LVTb + (16 * nt + fr) * 272 + (32 * kp + 4 * fq) * 2;
            const s16x4 lo = *(LAS const s16x4*)vp, hi = *(LAS const s16x4*)(vp + 32);
            const bf16x8 Y = (bf16x8){lo[0], lo[1], lo[2], lo[3], hi[0], hi[1], hi[2], hi[3]};
            acc[nt] = MFMA16(Y, Xp[kp], acc[nt]); if (kp == 3) asm volatile("" ::: "memory"); }
    { const short o = fr == 0 ? (short)0x3F80 : (short)0; const bf16x8 ones = (bf16x8){o, o, o, o, o, o, o, o};
#pragma unroll
        for (int kp = 0; kp < 4; ++kp) acc[8] = MFMA16(ones, Xp[kp], acc[8]); }
    const float den = __shfl(acc[8][0], fr);
    const float inv = 1.f / fmaxf(fabsf(den), ex);
#pragma unroll
    for (int nt = 0; nt < 8; ++nt) { if (DIR == 0) hs[nt] = acc[nt] * inv; else hs[nt] += acc[nt] * inv; }
}
DI void mlstm_prefetch_states(const Ctx& c, int chunk, int head, int tid, u32x4 (&sbr)[5], u32x4 (&sfr)[5]) {
    const bf16_t* CSTF = (const bf16_t*)c.out + ((size_t)(0 * NCHUNK + chunk) * 4 + head) * ST_ELEMS; const bf16_t* CSTB = (const bf16_t*)c.out + ((size_t)(1 * NCHUNK + chunk) * 4 + head) * ST_ELEMS;
#pragma unroll
    for (int i = 0; i < 5; ++i) { int idx = tid + 512 * i; idx = idx < 2304 ? idx : 2303; const int r = idx >> 4, ch = idx & 15, rc = r < 129 ? r : 128;
        sbr[i] = *(const u32x4*)(CSTB + rc * 128 + ch * 8); sfr[i] = *(const u32x4*)(CSTF + rc * 128 + ch * 8); }
}
DI void mlstm_out_unit(LAS unsigned char* lds, const Ctx& c, int chunk, int head, int nchunk, int nhead, u32x4 (&sbr)[5], u32x4 (&sfr)[5], int tid, int lane, int wid) {
    asm volatile("" : "+v"(tid), "+v"(lane));
    const int t0 = chunk * 128, fr = lane & 15, fq = lane >> 4;
    LAS unsigned char* LQ = lds; LAS unsigned char* LK = lds + 34816; LAS unsigned char* LVTb = lds + 73984; LAS unsigned char* LSB = lds + 108800; LAS float* vec = (LAS float*)(lds + 147968);
    LAS bf16_t* LVT = (LAS bf16_t*)LVTb;
    const bf16_t* MQ = (const bf16_t*)(c.ws + WS_MQ); const bf16_t* MK = (const bf16_t*)(c.ws + WS_MK); const bf16_t* MV = (const bf16_t*)(c.ws + WS_MV); bf16_t* MO = (bf16_t*)(c.ws + WS_MO);
    const bf16_t* CSTF = (const bf16_t*)c.out + ((size_t)(0 * NCHUNK + chunk) * 4 + head) * ST_ELEMS; const bf16_t* CSTB = (const bf16_t*)c.out + ((size_t)(1 * NCHUNK + chunk) * 4 + head) * ST_ELEMS;
    ChunkGates cgq; cgq.i0 = cgq.f0 = cgq.i1 = cgq.f1 = 0.f; cgq.s0 = cgq.s1 = 0; float mp_early = 0.f;
    if (wid < 2) { cgq = chunk_gates_load(wid, (const float*)(c.ws + WS_GATES), t0, head, lane); mp_early = ((const float*)(c.ws + WS_MPREV))[(size_t)(wid * NCHUNK + chunk) * 4 + head]; }
    u32x4 qr[4], kr[4], vr[4];
#pragma unroll
    for (int i = 0; i < 4; ++i) { const int idx = tid + 512 * i, r = idx >> 4, ch = idx & 15; const size_t go = (size_t)(t0 + r) * 512 + head * 128 + ch * 8; qr[i] = *(const u32x4*)(MQ + go); kr[i] = *(const u32x4*)(MK + go); }
#pragma unroll
    for (int i = 0; i < 4; ++i) { const int idx = tid + 512 * i, s = idx & 127, ch = idx >> 7; vr[i] = *(const u32x4*)(MV + (size_t)(t0 + s) * 512 + head * 128 + ch * 8); }
#pragma unroll
    for (int i = 0; i < 4; ++i) { const int idx = tid + 512 * i, r = idx >> 4, ch = idx & 15; *(LAS u32x4*)(LQ + r * 272 + ch * 16) = qr[i]; *(LAS u32x4*)(LK + r * 272 + ch * 16) = kr[i]; }
#pragma unroll
    for (int i = 0; i < 4; ++i) { const int idx = tid + 512 * i, s = idx & 127, ch = idx >> 7; const u32x4 v8 = vr[i];
#pragma unroll
        for (int e = 0; e < 8; ++e) { const unsigned vw = v8[e >> 1]; LVT[(8 * ch + e) * 136 + s] = (bf16_t)((e & 1) ? (vw >> 16) : (vw & 0xffffu)); } }
#pragma unroll
    for (int i = 0; i < 5; ++i) { int idx = tid + 512 * i; idx = idx < 2304 ? idx : 2303; const int r = idx >> 4, ch = idx & 15;
        *(LAS u32x4*)(LSB + r * 272 + ch * 16) = r < 129 ? sbr[i] : (u32x4){0u, 0u, 0u, 0u}; }
    if (wid < 2) { const int d = wid; const ChunkVec v = chunk_vectors_from(cgq, lane);
        const float mp = mp_early;
        LAS float* vd = vec + d * 512; const float M0 = fmaxf(mp, v.cm0), M1 = fmaxf(mp, v.cm1);
        constexpr float L2E = 1.4426950408889634f;
        vd[v.s0] = v.g0 * L2E; vd[128 + v.s0] = M0 * L2E; vd[256 + v.s0] = __expf(-(v.b0 + M0)); vd[384 + v.s0] = __expf(mp - M0);
        vd[v.s1] = v.g1 * L2E; vd[128 + v.s1] = M1 * L2E; vd[256 + v.s1] = __expf(-(v.b1 + M1)); vd[384 + v.s1] = __expf(mp - M1); }
    __syncthreads();
    const int trow = 16 * wid + fr;
    bf16x8 Xq[4];
#pragma unroll
    for (int ks = 0; ks < 4; ++ks) Xq[ks] = *(LAS const bf16x8*)(LQ + trow * 272 + (32 * ks + 8 * fq) * 2);
    f32x4 S[8];
#pragma unroll
    for (int n = 0; n < 8; ++n) { S[n] = (f32x4){0.f, 0.f, 0.f, 0.f};
#pragma unroll
        for (int ks = 0; ks < 4; ++ks) { const bf16x8 Yk = *(LAS const bf16x8*)(LK + (16 * n + fr) * 272 + (32 * ks + 8 * fq) * 2); S[n] = MFMA16(Yk, Xq[ks], S[n]); } }
    __syncthreads();
#pragma unroll
    for (int i = 0; i < 5; ++i) { int idx = tid + 512 * i; idx = idx < 2304 ? idx : 2303; const int r = idx >> 4, ch = idx & 15;
        *(LAS u32x4*)(LK + r * 272 + ch * 16) = r < 129 ? sfr[i] : (u32x4){0u, 0u, 0u, 0u}; }
    __syncthreads();
    mlstm_prefetch_states(c, nchunk, nhead, tid, sbr, sfr);
    f32x4 hs[8];
    dir_pass<0>(S, Xq, LK, LVTb, vec, trow, fr, fq, hs);
    dir_pass<1>(S, Xq, LSB, LVTb, vec + 512, trow, fr, fq, hs);
    float sum = 0.f;
#pragma unroll
    for (int nt = 0; nt < 8; ++nt) sum += (hs[nt][0] + hs[nt][1]) + (hs[nt][2] + hs[nt][3]);
    sum += __shfl_xor(sum, 16); sum += __shfl_xor(sum, 32);
    const float mean = sum * (1.f / 128.f); float var = 0.f;
#pragma unroll
    for (int nt = 0; nt < 8; ++nt) { hs[nt] -= mean; var += (hs[nt][0] * hs[nt][0] + hs[nt][1] * hs[nt][1]) + (hs[nt][2] * hs[nt][2] + hs[nt][3] * hs[nt][3]); }
    var += __shfl_xor(var, 16); var += __shfl_xor(var, 32);
    const float rstd = __builtin_amdgcn_rsqf(var * (1.f / 128.f) + EPS);
    const float* nw = c.in[6] + head * 128; bf16_t* mop = MO + (size_t)(t0 + trow) * 512 + head * 128;
#pragma unroll
    for (int nt = 0; nt < 8; ++nt) { const int v = 16 * nt + 4 * fq; const u32x2 mo4 = *(const u32x2*)(mop + v); const f32x4 w4 = *(const f32x4*)(nw + v);
        const float o0 = hs[nt][0] * rstd * w4[0] * sigmoidf_(bflo(mo4.x)), o1 = hs[nt][1] * rstd * w4[1] * sigmoidf_(bfhi(mo4.x));
        const float o2 = hs[nt][2] * rstd * w4[2] * sigmoidf_(bflo(mo4.y)), o3 = hs[nt][3] * rstd * w4[3] * sigmoidf_(bfhi(mo4.y));
        u32x2 w; w.x = pk2(o0, o1); w.y = pk2(o2, o3); *(u32x2*)((bf16_t*)(c.ws + WS_HMOA) + (size_t)(t0 + trow) * 1024 + head * 128 + v) = w; }
    __syncthreads();
}

struct Args { const float* in[17]; float* out; unsigned char* ws; int ph_lo, ph_hi; };
constexpr int NPHASE = 9;

__global__ void __launch_bounds__(512, 2) mega(Args args) {
    extern __shared__ __attribute__((aligned(16))) unsigned char lds_raw[];
    LAS unsigned char* lds = (LAS unsigned char*)lds_raw;
    cg::grid_group grid = cg::this_grid();
    const int tid = threadIdx.x, lane = tid & 63, wid = __builtin_amdgcn_readfirstlane(tid >> 6);
    const int G = gridDim.x, gw = blockIdx.x * 8 + wid, NGW = G * 8;
    Ctx c;
#pragma unroll
    for (int i = 0; i < 17; ++i) c.in[i] = args.in[i];
    c.out = args.out; c.ws = args.ws;
    unsigned char* ws = args.ws;
    const int lo = args.ph_lo, hi = args.ph_hi;
#ifndef PH_MASK
#define PH_MASK 0x3ff
#endif
#define IN(k) (((PH_MASK >> (k)) & 1) && lo <= (k) && (k) < hi)
#define REP(k) for (int rep_ = 0; rep_ < (((DUP_MASK >> (k)) & 1) ? 2 : 1); ++rep_)
#define SEAM(k) do { if (IN(k) && IN((k) + 1)) grid.sync(); } while (0)

    REP(0) if (IN(0)) {
        LAS float* scr = (LAS float*)(lds + wid * 16384);
        for (int i = blockIdx.x * 512 + tid; i < 320 * 64; i += G * 512) ((unsigned*)(ws + WS_CTL))[i] = 0u;
        constexpr int I_W1 = 160 * 16, I_PM = 32 * 8, I_PA = 32 * 8, I_WO = 32 * 16, I_UP = 176 * 16, I_WD = 32 * 44;
        constexpr int NITEMS = I_W1 + I_PM + I_PA + I_WO + I_UP + I_WD;
        for (int it = gw; it < NITEMS; it += NGW) {
            int r = it;
            if (r < I_W1) { const int nb = r >> 4, kb = r & 15, dr = 32 * nb, sc = dr < 2048 ? dr : dr + 16;
                const float ns = (dr >= 512 && dr < 1024) ? 0.08838834764831845f : ((dr >= 2048 && dr < 2560) ? 0.18033688011112042f   : 1.f);
                transpose_item(c.in[3], DIN, sc, 64 * kb, (bf16_t*)(ws + WS_W1), 1024, dr, c.in[2], ns, scr, lane); continue; } r -= I_W1;
            if (r < I_PM) { const int nb = r >> 3, kb = r & 7; transpose_item(c.in[8], 1024, 32 * nb, 64 * kb, (bf16_t*)(ws + WS_W1) + (size_t)5120 * 1024, 1024, 32 * nb, nullptr, 1.f, scr, lane); continue; } r -= I_PM;
            if (r < I_PA) { const int nb = r >> 3, kb = r & 7; transpose_item(c.in[9], 1024, 32 * nb, 64 * kb, (bf16_t*)(ws + WS_W1) + (size_t)5120 * 1024 + 512, 1024, 32 * nb, nullptr, 1.f, scr, lane); continue; } r -= I_PA;
            if (r < I_WO) { const int nb = r >> 4, kb = r & 15; transpose_item(c.in[10], 1024, 32 * nb, 64 * kb, (bf16_t*)(ws + WS_WO), 1024, 32 * nb, nullptr, 1.f, scr, lane); continue; } r -= I_WO;
            if (r < I_UP) { const int nb = r >> 4, kb = r & 15, sc = 32 * nb; const int half = sc >= DFF ? 1 : 0, ch = sc - half * DFF; const int dr = 256 * (ch >> 7) + 128 * half + (ch & 127);
                transpose_item(c.in[12], NUP, sc, 64 * kb, (bf16_t*)(ws + WS_WUP), 1024, dr, c.in[11], 1.f, scr, lane); continue; } r -= I_UP;
            { const int nb = r / 44, kb = r - nb * 44; transpose_item(c.in[15], 1024, 32 * nb, 64 * kb, (bf16_t*)(ws + WS_WD), DFF, 32 * nb, nullptr, 1.f, scr, lane); }
        }
        {
            float* rope = (float*)(ws + WS_ROPE);
            for (int i = blockIdx.x * 512 + tid; i < 16384 * 8; i += G * 512) { const int pos = i >> 3, d = i & 7;
                const float invf = d == 0 ? 1.0f : d == 1 ? 0.1939227432012558f : d == 2 ? 0.03760603070259094f : d == 3 ? 0.007292664609849453f : d == 4 ? 0.0014142135623842478f
                                 : d == 5 ? 0.00027424818836152554f : d == 6 ? 5.3182957344688475e-05f : 1.0313385246263351e-05f;
                const float ang = (float)pos * invf; const float k = rintf(ang * 0.15915494309189535f);
                float rr = fmaf(-k, 6.2831854820251465f, ang); rr = fmaf(-k, -1.7484556025237907e-07f, rr);
                rope[pos * 16 + d] = cosf(rr); rope[pos * 16 + 8 + d] = sinf(rr); }
        }
        __syncthreads();
        LAS float* wg = (LAS float*)lds;
        for (int i = tid; i < 16384; i += 512) { const int k = i >> 4, j = i & 15; wg[j * 1024 + k] = c.in[2][k] * c.in[3][(size_t)k * DIN + 2048 + j]; }
        __syncthreads();
        bf16_t* XN = (bf16_t*)(ws + WS_XN); float* gates = (float*)(ws + WS_GATES);
        const float bias = (lane >> 2) < 8 ? c.in[4][lane >> 2] : c.in[5][(lane >> 2) - 8];
        f32x4 va[4], vb[4];
        { const int r0 = gw * 2 < MTOK ? gw * 2 : 0; const f32x4* xa = (const f32x4*)xrow_ptr(c.in[0], c.in[1], r0) + lane; const f32x4* xb = (const f32x4*)xrow_ptr(c.in[0], c.in[1], r0 + 1) + lane;
#pragma unroll
          for (int j = 0; j < 4; ++j) { va[j] = xa[64 * j]; vb[j] = xb[64 * j]; } }
        for (int r0 = gw * 2; r0 < MTOK; r0 += NGW * 2) {
            f32x4 na[4], nb[4];
            { const int rn = r0 + NGW * 2 < MTOK ? r0 + NGW * 2 : r0; const f32x4* xa = (const f32x4*)xrow_ptr(c.in[0], c.in[1], rn) + lane; const f32x4* xb = (const f32x4*)xrow_ptr(c.in[0], c.in[1], rn + 1) + lane;
#pragma unroll
              for (int j = 0; j < 4; ++j) { na[j] = xa[64 * j]; nb[j] = xb[64 * j]; } }
            float sa = 0.f, sb = 0.f;
#pragma unroll
            for (int j = 0; j < 4; ++j) {
                sa += (va[j][0] * va[j][0] + va[j][1] * va[j][1]) + (va[j][2] * va[j][2] + va[j][3] * va[j][3]); sb += (vb[j][0] * vb[j][0] + vb[j][1] * vb[j][1]) + (vb[j][2] * vb[j][2] + vb[j][3] * vb[j][3]); }
            const float rsa = 1.f / sqrtf(wave_sum(sa) * (1.f / DM) + EPS), rsb = 1.f / sqrtf(wave_sum(sb) * (1.f / DM) + EPS);
            float pa[16], pb[16];
#pragma unroll
            for (int g = 0; g < 16; ++g) { float qa = 0.f, qb = 0.f;
#pragma unroll
                for (int j = 0; j < 4; ++j) { const f32x4 w = *(LAS const f32x4*)(wg + g * 1024 + 256 * j + 4 * lane);
                    qa += (va[j][0] * w[0] + va[j][1] * w[1]) + (va[j][2] * w[2] + va[j][3] * w[3]); qb += (vb[j][0] * w[0] + vb[j][1] * w[1]) + (vb[j][2] * w[2] + vb[j][3] * w[3]); }
                pa[g] = qa; pb[g] = qb; asm volatile("" ::: "memory"); }
            const float ga_ = reduce16(pa, lane), gb_ = reduce16(pb, lane);
            if ((lane & 3) == 0) { gates[(size_t)r0 * 16 + (lane >> 2)] = rsa * ga_ + bias; gates[(size_t)(r0 + 1) * 16 + (lane >> 2)] = rsb * gb_ + bias; }
            unsigned long long* oa = (unsigned long long*)(XN + (size_t)r0 * DM) + lane; unsigned long long* ob = (unsigned long long*)(XN + (size_t)(r0 + 1) * DM) + lane;
#pragma unroll
            for (int j = 0; j < 4; ++j) {
                oa[64 * j] = (unsigned long long)pk2(va[j][0] * rsa, va[j][1] * rsa) | ((unsigned long long)pk2(va[j][2] * rsa, va[j][3] * rsa) << 32);
                ob[64 * j] = (unsigned long long)pk2(vb[j][0] * rsb, vb[j][1] * rsb) | ((unsigned long long)pk2(vb[j][2] * rsb, vb[j][3] * rsb) << 32); }
#pragma unroll
            for (int j = 0; j < 4; ++j) { va[j] = na[j]; vb[j] = nb[j]; }
        }
        __syncthreads();
    }
    SEAM(0);

    if (IN(1)) {
        pg8::Gemm g{(const bf16_t*)(ws + WS_XN), (const bf16_t*)(ws + WS_W1), nullptr, nullptr, 1024};
        pg8::DupOrder S; S.s.init(MTOK / 256, 12, G, (int)blockIdx.x); S.dup = (DUP_MASK >> 1) & 1;
        pg8::EpiProj E{ws};
        pg8::gemm_phase<pg8::EpiProj, pg8::DupOrder, true, false>(lds, g, S, E);
    }
    SEAM(1);

    if (IN(2)) {
        constexpr int NSU = NCHUNK * 4, NAU = (NCHUNK / 2) * 4;
        u32x4 v8r[4], k8r[4];
        if ((int)blockIdx.x < NSU) summary_prefetch(c, (int)blockIdx.x >> 2, (int)blockIdx.x & 3, tid, v8r, k8r);
        for (int it0 = blockIdx.x; it0 < (((DUP_MASK >> 2) & 1) ? 2 : 1) * (NSU + NAU); it0 += G) { const int it = it0 >= NSU + NAU ? it0 - (NSU + NAU) : it0;
            if (it < NSU) { const int nx = it0 + G < NSU ? it0 + G : it; summary_unit(lds, c, it >> 2, it & 3, nx >> 2, nx & 3, v8r, k8r, tid, lane, wid); }
            else { const int a = it - NSU; attn_unit(lds, c, a >> 2, a & 3, tid, lane, wid); }
        }
    }
    SEAM(2);

    REP(3) if (IN(3)) {
        constexpr int NPI = 8 * 33, NSI = 128 * 33;
        if (NGW > 2 * NPI) {
            if (gw < NPI) scan_item(c, gw / 33, gw % 33, lane);
            else { const int stride = NGW - NPI; for (int j = gw - NPI; j < NSI; j += stride) scan_item(c, 8 + j / 33, j % 33, lane); }
        } else {
            for (int j = gw; j < NPI + NSI; j += NGW) scan_item(c, j / 33, j % 33, lane);
        }
    }
    SEAM(3);

    REP(4) if (IN(4)) {
        u32x4 sbr[5], sfr[5];
        if ((int)blockIdx.x < NCHUNK * 4) mlstm_prefetch_states(c, (int)blockIdx.x >> 2, (int)blockIdx.x & 3, tid, sbr, sfr);
        for (int it = blockIdx.x; it < NCHUNK * 4; it += G) { const int nx = it + G < NCHUNK * 4 ? it + G : it; mlstm_out_unit(lds, c, it >> 2, it & 3, nx >> 2, nx & 3, sbr, sfr, tid, lane, wid); }
    }
    SEAM(4);

    if (IN(5)) {
        const bf16_t* W1t = (const bf16_t*)(ws + WS_W1);
        pg8::Gemm gg{(const bf16_t*)(ws + WS_XN), W1t + (size_t)3072 * 1024, (const bf16_t*)(ws + WS_XN), W1t + (size_t)4096 * 1024, 1024, 0};
        pg8::Gemm gx{(const bf16_t*)(ws + WS_HMOA), W1t + (size_t)5120 * 1024, (const bf16_t*)(ws + WS_HMOA) + 512, W1t + (size_t)5120 * 1024 + 512, 1024, 8};
        pg8::StaticOrder SO; SO.init(MTOK / 256, DM / 256, G, (int)blockIdx.x);
        pg8::EpiGate EG{ws + WS_QSCR}; pg8::EpiMix EM{(bf16_t*)(ws + WS_Y), ws + WS_QSCR};
        pg8::Unit tu;
        for (int k = 0; SO.next(k, tu); ++k) {
            pg8::TileOrder T{tu.pm, tu.pn};
            pg8::gemm_phase<pg8::EpiGate, pg8::TileOrder, true, false>(lds, gg, T, EG);
            pg8::gemm_phase<pg8::EpiMix, pg8::TileOrder, true, false>(lds, gx, T, EM);
        }
    }
    SEAM(5);

    if (IN(6)) {
        pg8::Gemm g{(const bf16_t*)(ws + WS_Y), (const bf16_t*)(ws + WS_WO), nullptr, nullptr, 1024};
        pg8::DupOrder S; S.s.init(MTOK / 256, DM / 256, G, (int)blockIdx.x); S.dup = (DUP_MASK >> 6) & 1;
        pg8::EpiRes<true> E{c.in[0], c.in[1], c.out, (bf16_t*)(ws + WS_HN), (float*)(ws + WS_SS)};
        pg8::gemm_phase<pg8::EpiRes<true>, pg8::DupOrder, true, false>(lds, g, S, E);
    }
    SEAM(6);

    if (IN(7)) {
        pg8::Gemm g{(const bf16_t*)(ws + WS_HN), (const bf16_t*)(ws + WS_WUP), nullptr, nullptr, 1024};
        pg8::DupOrder S; S.s.init(323, NUP / 256, G, (int)blockIdx.x); S.dup = (DUP_MASK >> 7) & 1;
        pg8::EpiConv E{(bf16_t*)(ws + WS_G), (const float*)(ws + WS_SS), c.in[13], c.in[14], (LAS float*)(lds + 131072)};
        pg8::gemm_phase<pg8::EpiConv, pg8::DupOrder, true, true>(lds, g, S, E);
    }
    SEAM(7);

    if (IN(8)) {
        pg8::Gemm g{(const bf16_t*)(ws + WS_G), (const bf16_t*)(ws + WS_WD), nullptr, nullptr, DFF};
        pg8::StaticOrder S; S.init(MTOK / 256, DM / 256, G, (int)blockIdx.x);
        pg8::EpiFinal E{c.out, (const bf16_t*)(ws + WS_HN), c.in[16], (unsigned*)(ws + WS_SS), (unsigned*)(ws + WS_CTL)};
        pg8::gemm_phase<pg8::EpiFinal, pg8::StaticOrder, true, false>(lds, g, S, E);
    }
#undef IN
#undef SEAM
}

extern "C" void kernel_launch(void* const* d_in, const int* in_sizes, int n_in, void* d_out, int out_size, void* d_ws, size_t ws_size, hipStream_t stream) {
    static int grid = 0;
    if (grid == 0) {
        if (n_in != 17 || out_size != MTOK * DM || ws_size < WS_END2) { fprintf(stderr, "kernel_launch: unexpected problem (n_in %d out %d ws %zu)\n", n_in, out_size, ws_size); grid = -1; return; }
        int dev = 0, cus = 0, per_cu = 0;
        if (hipGetDevice(&dev) != hipSuccess || hipDeviceGetAttribute(&cus, hipDeviceAttributeMultiprocessorCount, dev) != hipSuccess) { grid = -1; return; }
        if (hipFuncSetAttribute((const void*)mega, hipFuncAttributeMaxDynamicSharedMemorySize, LDS_BYTES) != hipSuccess) { fprintf(stderr, "kernel_launch: hipFuncSetAttribute failed\n"); grid = -1; return; }
        if (hipOccupancyMaxActiveBlocksPerMultiprocessor(&per_cu, (const void*)mega, 512, LDS_BYTES) != hipSuccess || per_cu < 1) { fprintf(stderr, "kernel_launch: occupancy query says %d\n", per_cu); per_cu = 1; }
        (void)hipGetLastError();
        grid = cus * per_cu;
    }
    if (grid < 0) return;
    Args a{};
    for (int i = 0; i < 17; ++i) a.in[i] = (const float*)d_in[i];
    a.out = (float*)d_out; a.ws = (unsigned char*)d_ws;
#if MK_SINGLE
    a.ph_lo = 0; a.ph_hi = NPHASE;
    void* kargs[] = {&a};
    hipError_t e = hipLaunchCooperativeKernel((const void*)mega, dim3(grid), dim3(512), kargs, LDS_BYTES, stream);
    if (e != hipSuccess) fprintf(stderr, "cooperative launch failed: %s (grid %d)\n", hipGetErrorString(e), grid);
#else
    for (int p = 0; p < NPHASE; ++p) { a.ph_lo = p; a.ph_hi = p + 1; hipLaunchKernelGGL(mega, dim3(grid), dim3(512), LDS_BYTES, stream, a); }
#endif
}
```

```cpp
#include <hip/hip_runtime.h>
#include <hip/hip_cooperative_groups.h>
#include <cstdio>
#include <cstdint>
namespace cg = cooperative_groups;

#ifndef DUP_MASK
#define DUP_MASK 0
#endif
#ifndef MK_SINGLE
#define MK_SINGLE 1
#endif

#define LAS __attribute__((address_space(3)))
#define DI __device__ __forceinline__
typedef unsigned short bf16_t;
typedef short bf16x8 __attribute__((ext_vector_type(8)));
typedef short s16x4 __attribute__((ext_vector_type(4)));
typedef float f32x4 __attribute__((ext_vector_type(4)));
typedef unsigned u32x4 __attribute__((ext_vector_type(4)));
typedef unsigned u32x2 __attribute__((ext_vector_type(2)));

constexpr int MTOK = 81920, DM = 1024, NPROJ = 5120, DIN = 5136, DFF = 2816, NUP = 5632;
constexpr int NCHUNK = 640, PROMPT = 16384;
constexpr float EPS = 1e-6f;
constexpr int ST_ELEMS = 129 * 128;
constexpr size_t ST_BYTES = (size_t)ST_ELEMS * 2;

constexpr size_t MiB = 1u << 20;
constexpr size_t WS_CTL = 0;
constexpr size_t WS_W1 = 2 * MiB, WS_WPM = 13 * MiB, WS_WPA = 14 * MiB, WS_WO = 15 * MiB, WS_WUP = 17 * MiB, WS_WD = 28 * MiB;
constexpr size_t WS_ROPE = 34 * MiB, WS_GATES = 35 * MiB, WS_SS = 40 * MiB, WS_CHSC = 46 * MiB, WS_MPREV = 47 * MiB;
constexpr size_t WS_MQ = 64 * MiB, WS_MK = 144 * MiB, WS_MV = 224 * MiB, WS_MO = 304 * MiB, WS_AQ = 384 * MiB, WS_AK = 464 * MiB, WS_AV = 504 * MiB,
                 WS_GM = 544 * MiB, WS_GA = 704 * MiB, WS_END = 864 * MiB;
constexpr size_t WS_Y = 64 * MiB, WS_HN = 224 * MiB, WS_G = 384 * MiB;
constexpr size_t WS_OA = 864 * MiB, WS_HM = 944 * MiB, WS_END2 = 1024 * MiB;
constexpr size_t OUT_CST = 0;
constexpr size_t WS_XN = WS_GM, WS_QSCR = WS_GA;
constexpr size_t WS_HMOA = 864 * MiB;
constexpr int LDS_BYTES = 152064;

typedef __bf16 bf16n2 __attribute__((ext_vector_type(2)));
typedef float f32n2 __attribute__((ext_vector_type(2)));
DI unsigned pk2(float lo, float hi) { const f32n2 v = {lo, hi}; return __builtin_bit_cast(unsigned, __builtin_convertvector(v, bf16n2)); }
DI unsigned f2bf(float f) { return pk2(f, f) & 0xffffu; }
DI float bflo(unsigned w) { return __uint_as_float(w << 16); }
DI float bfhi(unsigned w) { return __uint_as_float(w & 0xffff0000u); }
DI unsigned cvt_pk_bf16_asm(float lo, float hi) { unsigned r; asm volatile("v_cvt_pk_bf16_f32 %0, %1, %2" : "=v"(r) : "v"(lo), "v"(hi)); return r; }
DI unsigned cvt_pk_bf16(float lo, float hi) { return pk2(lo, hi); }
DI float wave_sum(float v) {
#pragma unroll
    for (int o = 1; o < 64; o <<= 1) v += __shfl_xor(v, o);
    return v;
}
DI float sigmoidf_(float x) { return __builtin_amdgcn_rcpf(1.f + __expf(-x)); }
DI float logsigmoid_(float x) { return x >= 0.f ? -log1pf(expf(-x)) : x - log1pf(expf(x)); }
#define MFMA16(a, b, c) __builtin_amdgcn_mfma_f32_16x16x32_bf16((a), (b), (c), 0, 0, 0)
DI bf16x8 pack8(const float (&p)[8]) {
    u32x4 w; w.x = pk2(p[0], p[1]); w.y = pk2(p[2], p[3]); w.z = pk2(p[4], p[5]); w.w = pk2(p[6], p[7]);
    return __builtin_bit_cast(bf16x8, w);
}
DI const float* xrow_ptr(const float* xp, const float* xs, int t) { return t < PROMPT ? xp + (size_t)t * DM : xs + (size_t)(t - PROMPT) * DM; }
DI bool seq_start(int t) { return t == 0 || (t >= PROMPT && (t & 4095) == 0); }

namespace pg8 {
constexpr int BM = 256, BK = 64, HALF = 128, HTB = HALF * BK * 2, STAGE_BYTES = 8 * HTB, NXCD = 8, WGM = 8;
DI int lds_byte(int r, int c) { const int st = (r >> 4) * 2 + (c >> 5), rr = r & 15, cc = c & 31, ob = rr * 64 + cc * 2; return st * 1024 + (ob ^ (((ob >> 9) & 1) << 5)); }
DI void stage_rc(int b, int& R, int& C) { const int st = b / 1024, sb = b % 1024, swz = sb ^ (((sb >> 9) & 1) << 5); R = (st >> 1) * 16 + swz / 64; C = (st & 1) * 32 + (swz % 64) / 2; }
DI int perm32(int rho) { const int n = rho >> 4, i = rho & 15; return 8 * (i >> 2) + 4 * n + (i & 3); }

struct Unit { int pm, pn, sel; };
struct Gemm { const bf16_t* A; const bf16_t* Bt; const bf16_t* A2; const bf16_t* Bt2; int K; int ntk = 0; };

struct StaticOrder {
    int nM, nN, nwg, G, c;
    DI void init(int nM_, int nN_, int G_, int c_) { nM = nM_; nN = nN_; nwg = nM * nN; G = G_; c = c_; }
    DI bool next(int i, Unit& u) const {
        const long L = (long)i * G + c; if (L >= nwg) return false;
        int wgid = (int)L; { const int q = nwg / NXCD, r = nwg % NXCD, xcd = wgid % NXCD, off = wgid / NXCD; wgid = (xcd < r ? xcd * (q + 1) : r * (q + 1) + (xcd - r) * q) + off; }
        const int nig = WGM * nN, gid = wgid / nig, fm = gid * WGM, gsz = (nM - fm) < WGM ? (nM - fm) : WGM;
        u.pm = fm + ((wgid % nig) % gsz); u.pn = (wgid % nig) / gsz; u.sel = 0; return true;
    }
};
struct DupOrder { StaticOrder s; int dup; DI bool next(int i, Unit& u) const { return s.next(dup ? (i >> 1) : i, u); } };
struct TileOrder { int pm, pn; DI bool next(int i, Unit& u) const { if (i >= 2) return false; u.pm = pm; u.pn = pn; u.sel = i; return true; } };
struct PairOrder {
    StaticOrder s;
    DI bool next(int i, Unit& u) const { if (!s.next(i >> 1, u)) return false; u.sel = i & 1; return true; }
};

template <class Epi, class Sched, bool ALIGN_EPI, bool CONVA>
DI void gemm_phase(LAS unsigned char* lds, const Gemm g, const Sched& S, const Epi& E) {
    const int tid = threadIdx.x, wid = __builtin_amdgcn_readfirstlane(tid >> 6), lane = tid & 63, wr = wid >> 2, wc = wid & 3, fr = lane & 15, fq = lane >> 4;
    const int K = g.K; const int nt = g.ntk ? g.ntk : K / BK;
    unsigned voffA[2], voffB[2];
#pragma unroll
    for (int i = 0; i < 2; ++i) { int R, C; stage_rc(tid * 16 + i * 8192, R, C); const int Rb = Epi::PERM ? ((R & ~31) + perm32(R & 31)) : R;
        const int Ra = CONVA ? (128 * (R >> 6) + 8 * (R & 15) + ((R >> 4) & 3)) : R;
        voffA[i] = (unsigned)(Ra * K + C) * 2u; voffB[i] = (unsigned)(Rb * K + C) * 2u; }
    const size_t kstep = (size_t)(BK * 2);
    const size_t hstepB = (size_t)HALF * K * 2, tstepB = 2 * hstepB;
    const size_t hstepA = CONVA ? (size_t)4 * K * 2 : hstepB, tstepA = CONVA ? (size_t)254 * K * 2 : tstepB;
    const long abias = CONVA ? -(long)K * 2 : 0;
    const unsigned ldsw = (unsigned)wid * 1024u;
    const int aoff = lds_byte(wr * 64 + fr, fq * 8), boff = lds_byte(wc * 32 + fr, fq * 8);
#define PG8_SA(b, h) (((b) * 2 + (h)) * HTB)
#define PG8_SB(b, h) ((4 + (b) * 2 + (h)) * HTB)
#define PG8_STAGE(bufoff, gbase, voff) do { _Pragma("unroll") for (int _i = 0; _i < 2; ++_i) \
        __builtin_amdgcn_global_load_lds((const unsigned*)((const char*)(gbase) + (voff)[_i]), (LAS unsigned*)(lds + (bufoff) + ldsw + _i * 8192), 16, 0, 0); } while (0)
#define PG8_LDA(dst, b, h) do { _Pragma("unroll") for (int m = 0; m < 4; ++m) _Pragma("unroll") for (int k = 0; k < 2; ++k) dst[m][k] = *(const LAS bf16x8*)(lds + PG8_SA(b, h) + aoff + m * 2048 + k * 1024); } while (0)
#define PG8_LDB(dst, b, h) do { _Pragma("unroll") for (int n = 0; n < 2; ++n) _Pragma("unroll") for (int k = 0; k < 2; ++k) dst[n][k] = *(const LAS bf16x8*)(lds + PG8_SB(b, h) + boff + n * 2048 + k * 1024); } while (0)
#define PG8_MMA(ai, bj, At, Bt) do { __builtin_amdgcn_s_setprio(1); _Pragma("unroll") for (int m = 0; m < 4; ++m) _Pragma("unroll") for (int n = 0; n < 2; ++n) _Pragma("unroll") for (int k = 0; k < 2; ++k) \
        acc[ai][bj][m][n] = __builtin_amdgcn_mfma_f32_16x16x32_bf16(Bt[n][k], At[m][k], acc[ai][bj][m][n], 0, 0, 0); __builtin_amdgcn_s_setprio(0); } while (0)
#define PG8_WAIT_V(n) asm volatile("s_waitcnt vmcnt(" #n ")" ::: "memory")
#define PG8_WAIT_L(n) asm volatile("s_waitcnt lgkmcnt(" #n ")" ::: "memory")
#define PG8_WAIT_VN(n) asm volatile("s_waitcnt vmcnt(%0)" :: "n"(n) : "memory")
#define PG8_BAR __builtin_amdgcn_s_barrier()
#define PG8_SCHED __builtin_amdgcn_sched_barrier(0)
    Unit cur, nxt; int ui = 0;
    if (!S.next(0, cur)) return;
    f32x4 acc[2][2][4][2];
#pragma unroll
    for (int a = 0; a < 2; ++a)
#pragma unroll
        for (int b = 0; b < 2; ++b)
#pragma unroll
            for (int m = 0; m < 4; ++m)
#pragma unroll
                for (int n = 0; n < 2; ++n) acc[a][b][m][n] = (f32x4){0.f, 0.f, 0.f, 0.f};
    bf16x8 At[4][2], B0[2][2], B1[2][2];
    const char* cA = (const char*)(cur.sel ? g.A2 : g.A) + (size_t)cur.pm * tstepA + abias; const char* cB = (const char*)(cur.sel ? g.Bt2 : g.Bt) + (size_t)cur.pn * tstepB;
    PG8_STAGE(PG8_SB(0, 0), cB, voffB); PG8_STAGE(PG8_SB(0, 1), cB + hstepB, voffB); PG8_STAGE(PG8_SA(0, 0), cA, voffA); PG8_STAGE(PG8_SA(0, 1), cA + hstepA, voffA);
    if (wr == 1) PG8_BAR;
    PG8_WAIT_V(2); PG8_BAR;
    PG8_STAGE(PG8_SB(1, 0), cB + kstep, voffB); PG8_STAGE(PG8_SA(1, 0), cA + kstep, voffA); PG8_STAGE(PG8_SB(1, 1), cB + hstepB + kstep, voffB);
    PG8_WAIT_V(6); PG8_BAR;
    for (;;) {
        const bool has_next = S.next(ui + 1, nxt);
        const char* nA = has_next ? (const char*)(nxt.sel ? g.A2 : g.A) + (size_t)nxt.pm * tstepA + abias : cA;
        const char* nB = has_next ? (const char*)(nxt.sel ? g.Bt2 : g.Bt) + (size_t)nxt.pn * tstepB : cB;
#define PG8_KBODY(W12) do { \
            PG8_LDB(B0, 0, 0); PG8_LDB(B1, 0, 1); PG8_SCHED; PG8_LDA(At, 0, 0); PG8_STAGE(PG8_SA(1, 1), a1 + hstepA, voffA); \
            W12; PG8_WAIT_L(0); PG8_BAR; PG8_MMA(0, 0, At, B0); PG8_MMA(0, 1, At, B1); PG8_BAR; PG8_SCHED; \
            PG8_LDA(At, 0, 1); PG8_STAGE(PG8_SB(0, 0), b2, voffB); PG8_STAGE(PG8_SB(0, 1), b2 + hstepB, voffB); PG8_STAGE(PG8_SA(0, 0), a2, voffA); \
            W12; PG8_WAIT_L(0); PG8_BAR; PG8_MMA(1, 0, At, B0); PG8_MMA(1, 1, At, B1); PG8_BAR; PG8_SCHED; \
            PG8_LDB(B0, 1, 0); PG8_LDB(B1, 1, 1); PG8_SCHED; PG8_LDA(At, 1, 0); PG8_STAGE(PG8_SA(0, 1), a2 + hstepA, voffA); \
            PG8_WAIT_V(8); PG8_WAIT_L(0); PG8_BAR; PG8_MMA(0, 0, At, B0); PG8_MMA(0, 1, At, B1); PG8_BAR; PG8_SCHED; \
            PG8_LDA(At, 1, 1); PG8_STAGE(PG8_SB(1, 0), b3, voffB); PG8_STAGE(PG8_SB(1, 1), b3 + hstepB, voffB); PG8_STAGE(PG8_SA(1, 0), a3, voffA); \
            PG8_WAIT_V(8); PG8_WAIT_L(0); PG8_BAR; PG8_MMA(1, 0, At, B0); PG8_MMA(1, 1, At, B1); PG8_BAR; PG8_SCHED; } while (0)
        for (int t = 0; t < nt; t += 2) {
            const bool last = (t == nt - 2);
            const char* a1 = cA + (size_t)(t + 1) * kstep;
            const char* a2 = last ? nA : cA + (size_t)(t + 2) * kstep; const char* b2 = last ? nB : cB + (size_t)(t + 2) * kstep;
            const char* a3 = a2 + kstep; const char* b3 = b2 + kstep;
            PG8_KBODY(PG8_WAIT_V(8));
        }
#undef PG8_KBODY
        if constexpr (ALIGN_EPI) { if (wr == 0) PG8_BAR; }
        E(acc, cur, wr, wc, fr, fq);
        if (!has_next) break;
        if (!E.keep(cur)) {
#pragma unroll
            for (int a = 0; a < 2; ++a)
#pragma unroll
                for (int b = 0; b < 2; ++b)
#pragma unroll
                    for (int m = 0; m < 4; ++m)
#pragma unroll
                        for (int n = 0; n < 2; ++n) acc[a][b][m][n] = (f32x4){0.f, 0.f, 0.f, 0.f};
        }
        cur = nxt; cA = nA; cB = nB; ++ui;
        if constexpr (ALIGN_EPI) { if (wr == 1) PG8_BAR; }
    }
    PG8_WAIT_V(0);
    if constexpr (!ALIGN_EPI) { if (wr == 0) PG8_BAR; }
    PG8_BAR;
#undef PG8_SA
#undef PG8_SB
#undef PG8_STAGE
#undef PG8_LDA
#undef PG8_LDB
#undef PG8_MMA
#undef PG8_WAIT_V
#undef PG8_WAIT_L
#undef PG8_WAIT_VN
#undef PG8_BAR
#undef PG8_SCHED
}

struct EpiProj {
    static constexpr bool PERM = true; static constexpr int NVM = 16;
    unsigned char* ws;
    DI bool keep(const Unit&) const { return false; }
    DI void operator()(f32x4 (&acc)[2][2][4][2], const Unit& u, int wr, int wc, int fr, int fq) const {
        const int ct = u.pn; bf16_t* base; int ldc, colt;
        if (ct < 8) { base = (bf16_t*)(ws + WS_MQ + (size_t)(ct >> 1) * (80 * MiB)); ldc = 512; colt = (ct & 1) * 256; }
        else if (ct < 10) { base = (bf16_t*)(ws + WS_AQ); ldc = 512; colt = (ct - 8) * 256; }
        else if (ct == 10) { base = (bf16_t*)(ws + WS_AK); ldc = 256; colt = 0; }
        else if (ct == 11) { base = (bf16_t*)(ws + WS_AV); ldc = 256; colt = 0; }
        else if (ct < 16) { base = (bf16_t*)(ws + WS_GM); ldc = 1024; colt = (ct - 12) * 256; }
        else { base = (bf16_t*)(ws + WS_GA); ldc = 1024; colt = (ct - 16) * 256; }
        const int row0 = u.pm * BM + wr * 64 + fr, col0 = colt + wc * 32 + 8 * fq;
#pragma unroll
        for (int ai = 0; ai < 2; ++ai)
#pragma unroll
            for (int m = 0; m < 4; ++m) { bf16_t* rowp = base + (size_t)(row0 + ai * HALF + m * 16) * ldc + col0;
#pragma unroll
                for (int bj = 0; bj < 2; ++bj) { const f32x4 v0 = acc[ai][bj][m][0], v1 = acc[ai][bj][m][1];
                    u32x4 w; w.x = cvt_pk_bf16(v0[0], v0[1]); w.y = cvt_pk_bf16(v0[2], v0[3]); w.z = cvt_pk_bf16(v1[0], v1[1]); w.w = cvt_pk_bf16(v1[2], v1[3]);
                    *(u32x4*)(rowp + bj * HALF) = w; } }
    }
};
#define PG8_SCR_SETUP const unsigned lo16 = (threadIdx.x & 63u) * 16u; const int wid_ = __builtin_amdgcn_readfirstlane(threadIdx.x >> 6); \
        unsigned char* sa_u = scr + ((size_t)(blockIdx.x * 2 + 0) * 8 + wid_) * 16384; unsigned char* sb_u = scr + ((size_t)(blockIdx.x * 2 + 1) * 8 + wid_) * 16384;
#define sa(k) (sa_u + (k) * 1024 + lo16)
#define sb(k) (sb_u + (k) * 1024 + lo16)
struct EpiGate {
    static constexpr bool PERM = true; static constexpr int NVM = 16;
    unsigned char* scr;
    DI bool keep(const Unit&) const { return false; }
    DI void operator()(f32x4 (&acc)[2][2][4][2], const Unit& u, int wr, int wc, int fr, int fq) const {
        PG8_SCR_SETUP
        if (u.sel == 0) {
#pragma unroll
            for (int ai = 0; ai < 2; ++ai)
#pragma unroll
                for (int m = 0; m < 4; ++m)
#pragma unroll
                    for (int bj = 0; bj < 2; ++bj) { float v[8];
#pragma unroll
                        for (int e = 0; e < 8; ++e) v[e] = sigmoidf_(acc[ai][bj][m][e >> 2][e & 3]);
                        u32x4 w; w.x = pk2(v[0], v[1]); w.y = pk2(v[2], v[3]); w.z = pk2(v[4], v[5]); w.w = pk2(v[6], v[7]);
                        *(u32x4*)sa(ai * 8 + m * 2 + bj) = w; }
        } else {
#pragma unroll
            for (int ai = 0; ai < 2; ++ai) {
                u32x4 A8[4][2];
#pragma unroll
                for (int m = 0; m < 4; ++m)
#pragma unroll
                    for (int bj = 0; bj < 2; ++bj) A8[m][bj] = *(const u32x4*)sa(ai * 8 + m * 2 + bj);
#pragma unroll
                for (int m = 0; m < 4; ++m)
#pragma unroll
                    for (int bj = 0; bj < 2; ++bj) { float r[8], b[8];
#pragma unroll
                        for (int e = 0; e < 8; ++e) { const float av = (e & 1) ? bfhi(A8[m][bj][e >> 1]) : bflo(A8[m][bj][e >> 1]); const float den = 1.f + __expf(-acc[ai][bj][m][e >> 2][e & 3]);
                            b[e] = __builtin_amdgcn_rcpf(den); r[e] = av * den; }
                        u32x4 wr_, wb_; wr_.x = pk2(r[0], r[1]); wr_.y = pk2(r[2], r[3]); wr_.z = pk2(r[4], r[5]); wr_.w = pk2(r[6], r[7]);
                        wb_.x = pk2(b[0], b[1]); wb_.y = pk2(b[2], b[3]); wb_.z = pk2(b[4], b[5]); wb_.w = pk2(b[6], b[7]);
                        *(u32x4*)sa(ai * 8 + m * 2 + bj) = wr_; *(u32x4*)sb(ai * 8 + m * 2 + bj) = wb_; }
            }
        }
    }
};
struct EpiMix {
    static constexpr bool PERM = true; static constexpr int NVM = 16;
    bf16_t* Y; unsigned char* scr;
    DI bool keep(const Unit& u) const { return u.sel == 0; }
    DI void operator()(f32x4 (&acc)[2][2][4][2], const Unit& u, int wr, int wc, int fr, int fq) const {
        PG8_SCR_SETUP
        if (u.sel == 0) {
#pragma unroll
            for (int ai = 0; ai < 2; ++ai) {
                u32x4 A8[4][2];
#pragma unroll
                for (int m = 0; m < 4; ++m)
#pragma unroll
                    for (int bj = 0; bj < 2; ++bj) A8[m][bj] = *(const u32x4*)sa(ai * 8 + m * 2 + bj);
#pragma unroll
                for (int m = 0; m < 4; ++m)
#pragma unroll
                    for (int bj = 0; bj < 2; ++bj)
#pragma unroll
                        for (int e = 0; e < 8; ++e) { const float rv = (e & 1) ? bfhi(A8[m][bj][e >> 1]) : bflo(A8[m][bj][e >> 1]); acc[ai][bj][m][e >> 2][e & 3] *= rv; }
            }
        } else {
            const int row0 = u.pm * BM + wr * 64 + fr, col0 = u.pn * BM + wc * 32 + 8 * fq;
#pragma unroll
            for (int ai = 0; ai < 2; ++ai) {
                u32x4 B8[4][2];
#pragma unroll
                for (int m = 0; m < 4; ++m)
#pragma unroll
                    for (int bj = 0; bj < 2; ++bj) B8[m][bj] = *(const u32x4*)sb(ai * 8 + m * 2 + bj);
#pragma unroll
                for (int m = 0; m < 4; ++m)
#pragma unroll
                    for (int bj = 0; bj < 2; ++bj) { float v[8];
#pragma unroll
                        for (int e = 0; e < 8; ++e) { const float bv = (e & 1) ? bfhi(B8[m][bj][e >> 1]) : bflo(B8[m][bj][e >> 1]); v[e] = acc[ai][bj][m][e >> 2][e & 3] * bv; }
                        u32x4 w; w.x = pk2(v[0], v[1]); w.y = pk2(v[2], v[3]); w.z = pk2(v[4], v[5]); w.w = pk2(v[6], v[7]);
                        *(u32x4*)(Y + (size_t)(row0 + ai * HALF + m * 16) * DM + col0 + bj * HALF) = w; }
            }
        }
    }
};
#undef PG8_SCR_SETUP
#undef sa
#undef sb
template <bool WITH_HN> struct EpiRes {
    static constexpr bool PERM = true; static constexpr int NVM = 16;
    const float* xp; const float* xs; float* out; bf16_t* hn; float* ss;
    DI bool keep(const Unit&) const { return false; }
    template <int Q> DI void ld(f32x4 (&B)[2][2][2], const Unit& u, int wr, int fr, int cb0) const {
#pragma unroll
        for (int mm = 0; mm < 2; ++mm) { const int t = u.pm * BM + (Q >> 1) * HALF + wr * 64 + (2 * (Q & 1) + mm) * 16 + fr; const float* br = xrow_ptr(xp, xs, t);
#pragma unroll
            for (int bj = 0; bj < 2; ++bj)
#pragma unroll
                for (int n = 0; n < 2; ++n) B[mm][bj][n] = *(const f32x4*)(br + cb0 + bj * HALF + 4 * n); }
    }
    template <int Q> DI void st(const f32x4 (&B)[2][2][2], const f32x4 (&acc)[2][2][4][2], const Unit& u, int wr, int wc, int fr, int fq, int cb0) const {
#pragma unroll
        for (int mm = 0; mm < 2; ++mm) { const int m = 2 * (Q & 1) + mm, ai = Q >> 1; const int t = u.pm * BM + ai * HALF + wr * 64 + m * 16 + fr; float ssq = 0.f;
#pragma unroll
            for (int bj = 0; bj < 2; ++bj) { const int c = cb0 + bj * HALF;
                const f32x4 h0 = B[mm][bj][0] + acc[ai][bj][m][0], h1 = B[mm][bj][1] + acc[ai][bj][m][1];
                ssq += ((h0[0] * h0[0] + h0[1] * h0[1]) + (h0[2] * h0[2] + h0[3] * h0[3])) + ((h1[0] * h1[0] + h1[1] * h1[1]) + (h1[2] * h1[2] + h1[3] * h1[3]));
                u32x4 w; w.x = cvt_pk_bf16(h0[0], h0[1]); w.y = cvt_pk_bf16(h0[2], h0[3]); w.z = cvt_pk_bf16(h1[0], h1[1]); w.w = cvt_pk_bf16(h1[2], h1[3]); *(u32x4*)(hn + (size_t)t * DM + c) = w; }
            ssq += __shfl_xor(ssq, 16); ssq += __shfl_xor(ssq, 32); if (fq == 0) ss[(size_t)t * 16 + u.pn * 4 + wc] = ssq; }
    }
    DI void operator()(f32x4 (&acc)[2][2][4][2], const Unit& u, int wr, int wc, int fr, int fq) const {
        const int cb0 = u.pn * BM + wc * 32 + 8 * fq;
        f32x4 B0[2][2][2], B1[2][2][2];
        ld<0>(B0, u, wr, fr, cb0); ld<1>(B1, u, wr, fr, cb0);
        st<0>(B0, acc, u, wr, wc, fr, fq, cb0); ld<2>(B0, u, wr, fr, cb0);
        st<1>(B1, acc, u, wr, wc, fr, fq, cb0); ld<3>(B1, u, wr, fr, cb0);
        st<2>(B0, acc, u, wr, wc, fr, fq, cb0); st<3>(B1, acc, u, wr, wc, fr, fq, cb0);
    }
};
DI float dpp_ror1(float x) { return __builtin_bit_cast(float, __builtin_amdgcn_update_dpp(0, __builtin_bit_cast(int, x), 0x121, 0xf, 0xf, false)); }
DI float dpp_rol1(float x) { return __builtin_bit_cast(float, __builtin_amdgcn_update_dpp(0, __builtin_bit_cast(int, x), 0x12F, 0xf, 0xf, false)); }
struct EpiConv {
    static constexpr bool PERM = true; static constexpr int NVM = 0;
    bf16_t* G; const float* ss; const float* cw; const float* cb; LAS float* xch;
    DI bool keep(const Unit&) const { return false; }
    DI void operator()(f32x4 (&acc)[2][2][4][2], const Unit& u, int wr, int wc, int fr, int fq) const {
        const int t0 = 254 * u.pm - 1 + 128 * wr + 8 * fr;
        unsigned upz = 0, dnz = 0, stm = 0;
        f32x4 P8[8];
#pragma unroll
        for (int idx = 0; idx < 8; ++idx) { const int t = t0 + idx; const int tc = t < 0 ? 0 : (t >= MTOK ? MTOK - 1 : t); P8[idx] = *(const f32x4*)(ss + (size_t)tc * 16 + 4 * fq); }
#pragma unroll
        for (int idx = 0; idx < 8; ++idx) { const int rho = 128 * wr + 8 * fr + idx, t = t0 + idx;
            const f32x4 p = P8[idx]; float s = (p[0] + p[1]) + (p[2] + p[3]); s += __shfl_xor(s, 16); s += __shfl_xor(s, 32);
            const float rs = __builtin_amdgcn_rsqf(s * (1.f / DM) + EPS);
#pragma unroll
            for (int bj = 0; bj < 2; ++bj)
#pragma unroll
                for (int n = 0; n < 2; ++n) acc[idx >> 2][bj][idx & 3][n] *= rs;
            if (seq_start(t)) upz |= 1u << idx;
            if (t + 1 >= MTOK || seq_start(t + 1)) dnz |= 1u << idx;
            if (rho >= 1 && rho <= 254 && t < MTOK) stm |= 1u << idx; }
        const bool anyb = __builtin_amdgcn_ballot_w64((upz | dnz) != 0u) != 0ull;
        f32x4 X[2][2];
        { LAS float* xw = xch + ((wr * 4 + wc) * 4 + fq) * 16; LAS const float* xr = xch + (((wr ^ 1) * 4 + wc) * 4 + fq) * 16;
          if (wr == 0) { if (fr == 15) {
#pragma unroll
              for (int bj = 0; bj < 2; ++bj)
#pragma unroll
                  for (int n = 0; n < 2; ++n) *(LAS f32x4*)(xw + (bj * 2 + n) * 4) = acc[1][bj][3][n]; } }
          else { if (fr == 0) {
#pragma unroll
              for (int bj = 0; bj < 2; ++bj)
#pragma unroll
                  for (int n = 0; n < 2; ++n) *(LAS f32x4*)(xw + (bj * 2 + n) * 4) = acc[0][bj][0][n]; } }
          asm volatile("s_waitcnt lgkmcnt(0)" ::: "memory"); __builtin_amdgcn_s_barrier(); asm volatile("" ::: "memory");
#pragma unroll
          for (int bj = 0; bj < 2; ++bj)
#pragma unroll
              for (int n = 0; n < 2; ++n) X[bj][n] = *(LAS const f32x4*)(xr + (bj * 2 + n) * 4); }
        const bool xup = (wr == 1) && (fr == 0), xdn = (wr == 0) && (fr == 15);
        f32x4 W[2][4];
#define LOADW(n_) _Pragma("unroll") for (int bj = 0; bj < 2; ++bj) { const int cc = bj * DFF + u.pn * 128 + wc * 32 + 8 * fq + 4 * (n_); \
            W[bj][0] = *(const f32x4*)(cw + cc); W[bj][1] = *(const f32x4*)(cw + NUP + cc); W[bj][2] = *(const f32x4*)(cw + 2 * NUP + cc); W[bj][3] = *(const f32x4*)(cb + cc); }
        LOADW(0)
        unsigned pk[2][8][2];
#pragma unroll
        for (int n = 0; n < 2; ++n) {
            const int ch = u.pn * 128 + wc * 32 + 8 * fq + 4 * n;
            float ca[8][4];
#pragma unroll
            for (int bj = 0; bj < 2; ++bj) {
                const f32x4 w0 = W[bj][0], w1 = W[bj][1], w2 = W[bj][2], bb = W[bj][3];
#pragma unroll
                for (int jp = 0; jp < 2; ++jp) {
                    const f32n2 w0p = {w0[2 * jp], w0[2 * jp + 1]}, w1p = {w1[2 * jp], w1[2 * jp + 1]}, w2p = {w2[2 * jp], w2[2 * jp + 1]}, bbp = {bb[2 * jp], bb[2 * jp + 1]};
                    f32n2 v[8];
#pragma unroll
                    for (int idx = 0; idx < 8; ++idx) v[idx] = (f32n2){acc[idx >> 2][bj][idx & 3][n][2 * jp], acc[idx >> 2][bj][idx & 3][n][2 * jp + 1]};
                    f32n2 up0 = {dpp_ror1(v[7].x), dpp_ror1(v[7].y)}, dn7 = {dpp_rol1(v[0].x), dpp_rol1(v[0].y)};
                    if (xup) up0 = (f32n2){X[bj][n][2 * jp], X[bj][n][2 * jp + 1]};
                    if (xdn) dn7 = (f32n2){X[bj][n][2 * jp], X[bj][n][2 * jp + 1]};
                    f32n2 cv[8];
#pragma unroll
                    for (int idx = 0; idx < 8; ++idx) { f32n2 up = idx ? v[idx > 0 ? idx - 1 : 0] : up0, dn = idx < 7 ? v[idx < 7 ? idx + 1 : 7] : dn7;
                        if (anyb) { if ((upz >> idx) & 1u) up = (f32n2){0.f, 0.f}; if ((dnz >> idx) & 1u) dn = (f32n2){0.f, 0.f}; }
                        cv[idx] = w0p * up + (w1p * v[idx] + (w2p * dn + bbp)); }
                    if (bj == 0) {
#pragma unroll
                        for (int idx = 0; idx < 8; ++idx) { ca[idx][2 * jp] = cv[idx].x; ca[idx][2 * jp + 1] = cv[idx].y; }
                    } else {
#pragma unroll
                        for (int idx = 0; idx < 8; ++idx) { const f32n2 a2 = {ca[idx][2 * jp], ca[idx][2 * jp + 1]}; const f32n2 sg = {sigmoidf_(a2.x), sigmoidf_(a2.y)};
                            const f32n2 r2 = (a2 * sg) * cv[idx]; ca[idx][2 * jp] = r2.x; ca[idx][2 * jp + 1] = r2.y; }
                    } } }
#pragma unroll
            for (int idx = 0; idx < 8; ++idx) { pk[n][idx][0] = cvt_pk_bf16_asm(ca[idx][0], ca[idx][1]); pk[n][idx][1] = cvt_pk_bf16_asm(ca[idx][2], ca[idx][3]); }
            if (n == 0) { LOADW(1) }
            (void)ch;
        }
        { const int ch0 = u.pn * 128 + wc * 32 + 8 * fq;
#pragma unroll
          for (int idx = 0; idx < 8; ++idx) if ((stm >> idx) & 1u) { u32x4 w; w.x = pk[0][idx][0]; w.y = pk[0][idx][1]; w.z = pk[1][idx][0]; w.w = pk[1][idx][1]; *(u32x4*)(G + (size_t)(t0 + idx) * DFF + ch0) = w; } }
#undef LOADW
    }
};
struct EpiFinal {
    static constexpr bool PERM = true; static constexpr int NVM = 32;
    float* out; const bf16_t* hn; const float* nfw; unsigned* xs; unsigned* cnt;
    DI bool keep(const Unit&) const { return false; }
    template <int Q> DI void ld(f32x4 (&B)[2][2][2], const Unit& u, int wr, int fr, int cb0) const {
#pragma unroll
        for (int mm = 0; mm < 2; ++mm) { const int t = u.pm * BM + (Q >> 1) * HALF + wr * 64 + (2 * (Q & 1) + mm) * 16 + fr; const bf16_t* br = hn + (size_t)t * DM;
#pragma unroll
            for (int bj = 0; bj < 2; ++bj) { const u32x4 w = *(const u32x4*)(br + cb0 + bj * HALF);
                B[mm][bj][0] = (f32x4){bflo(w.x), bfhi(w.x), bflo(w.y), bfhi(w.y)}; B[mm][bj][1] = (f32x4){bflo(w.z), bfhi(w.z), bflo(w.w), bfhi(w.w)}; } }
    }
    template <int Q> DI void add(const f32x4 (&B)[2][2][2], f32x4 (&acc)[2][2][4][2], const Unit& u, int wr, int wc, int fr, int fq) const {
#pragma unroll
        for (int mm = 0; mm < 2; ++mm) { const int m = 2 * (Q & 1) + mm, ai = Q >> 1; const int t = u.pm * BM + ai * HALF + wr * 64 + m * 16 + fr; float ssq = 0.f;
#pragma unroll
            for (int bj = 0; bj < 2; ++bj)
#pragma unroll
                for (int n = 0; n < 2; ++n) { const f32x4 hv = B[mm][bj][n] + acc[ai][bj][m][n]; acc[ai][bj][m][n] = hv; ssq += (hv[0] * hv[0] + hv[1] * hv[1]) + (hv[2] * hv[2] + hv[3] * hv[3]); }
            ssq += __shfl_xor(ssq, 16); ssq += __shfl_xor(ssq, 32);
            if (fq == 0) __hip_atomic_store(xs + (size_t)t * 16 + u.pn * 4 + wc, __float_as_uint(ssq), __ATOMIC_RELAXED, __HIP_MEMORY_SCOPE_AGENT); }
    }
    DI void operator()(f32x4 (&acc)[2][2][4][2], const Unit& u, int wr, int wc, int fr, int fq) const {
        const int lane = threadIdx.x & 63, cb0 = u.pn * BM + wc * 32 + 8 * fq;
        { f32x4 B0[2][2][2], B1[2][2][2];
          ld<0>(B0, u, wr, fr, cb0); ld<1>(B1, u, wr, fr, cb0);
          add<0>(B0, acc, u, wr, wc, fr, fq); ld<2>(B0, u, wr, fr, cb0);
          add<1>(B1, acc, u, wr, wc, fr, fq); ld<3>(B1, u, wr, fr, cb0);
          add<2>(B0, acc, u, wr, wc, fr, fq); add<3>(B1, acc, u, wr, wc, fr, fq); }
        asm volatile("s_waitcnt vmcnt(0)" ::: "memory");
        unsigned* cw_ = cnt + 64 * u.pm;
        if (lane == 0) __hip_atomic_fetch_add(cw_, 1u, __ATOMIC_RELAXED, __HIP_MEMORY_SCOPE_AGENT);
        f32x4 W4[2][2];
#pragma unroll
        for (int bj = 0; bj < 2; ++bj)
#pragma unroll
            for (int n = 0; n < 2; ++n) W4[bj][n] = *(const f32x4*)(nfw + cb0 + bj * HALF + 4 * n);
        while ((unsigned)__builtin_amdgcn_readfirstlane(__hip_atomic_load(cw_, __ATOMIC_RELAXED, __HIP_MEMORY_SCOPE_AGENT)) < 32u) __builtin_amdgcn_s_sleep(2);
        asm volatile("" ::: "memory");
        unsigned Pp[8][4];
#pragma unroll
        for (int idx = 0; idx < 8; ++idx) { const int t = u.pm * BM + (idx >> 2) * HALF + wr * 64 + (idx & 3) * 16 + fr; const unsigned* xp_ = xs + (size_t)t * 16 + 4 * fq;
#pragma unroll
            for (int q = 0; q < 4; ++q) Pp[idx][q] = __hip_atomic_load(xp_ + q, __ATOMIC_RELAXED, __HIP_MEMORY_SCOPE_AGENT); }
#pragma unroll
        for (int idx = 0; idx < 8; ++idx) { const int ai = idx >> 2, m = idx & 3; const int t = u.pm * BM + ai * HALF + wr * 64 + m * 16 + fr; float* orow = out + (size_t)t * DM;
            float s = (__uint_as_float(Pp[idx][0]) + __uint_as_float(Pp[idx][1])) + (__uint_as_float(Pp[idx][2]) + __uint_as_float(Pp[idx][3]));
            s += __shfl_xor(s, 16); s += __shfl_xor(s, 32);
            const float rs = 1.f / sqrtf(s * (1.f / DM) + EPS);
#pragma unroll
            for (int bj = 0; bj < 2; ++bj)
#pragma unroll
                for (int n = 0; n < 2; ++n) *(f32x4*)(orow + cb0 + bj * HALF + 4 * n) = acc[ai][bj][m][n] * rs * W4[bj][n]; }
    }
};
}

DI void transpose_item(const float* W, int ldw, int src_col0, int k0, bf16_t* WT, int K, int dst_row0, const float* kscale, float nscale, LAS float* scr, int lane) {
    float wv[32];
#pragma unroll
    for (int i = 0; i < 32; ++i) { const int kk = 2 * i + (lane >> 5); wv[i] = W[(size_t)(k0 + kk) * ldw + src_col0 + (lane & 31)]; }
#pragma unroll
    for (int i = 0; i < 32; ++i) { const int kk = 2 * i + (lane >> 5); const float s = kscale ? kscale[k0 + kk] * nscale : nscale;
        scr[kk * 33 + (lane & 31)] = wv[i] * s; }
    asm volatile("s_waitcnt lgkmcnt(0)" ::: "memory");
    const int c = lane & 7;
#pragma unroll
    for (int j = 0; j < 4; ++j) { const int n = (lane >> 3) + 8 * j; const LAS float* s = scr + (8 * c) * 33 + n;
        u32x4 o; o.x = pk2(s[0 * 33], s[1 * 33]); o.y = pk2(s[2 * 33], s[3 * 33]); o.z = pk2(s[4 * 33], s[5 * 33]); o.w = pk2(s[6 * 33], s[7 * 33]);
        *(u32x4*)(WT + (size_t)(dst_row0 + n) * K + k0 + 8 * c) = o; }
    asm volatile("s_waitcnt lgkmcnt(0)" ::: "memory");
}
DI float reduce16(const float (&p)[16], int lane) {
    const bool b5 = lane & 32, b4 = lane & 16, b3 = lane & 8, b2 = lane & 4;
    float q[8], r[4], s[2];
#pragma unroll
    for (int j = 0; j < 8; ++j) { const float send = b5 ? p[j] : p[j + 8], keep = b5 ? p[j + 8] : p[j]; q[j] = keep + __shfl_xor(send, 32); }
#pragma unroll
    for (int j = 0; j < 4; ++j) { const float send = b4 ? q[j] : q[j + 4], keep = b4 ? q[j + 4] : q[j]; r[j] = keep + __shfl_xor(send, 16); }
#pragma unroll
    for (int j = 0; j < 2; ++j) { const float send = b3 ? r[j] : r[j + 2], keep = b3 ? r[j + 2] : r[j]; s[j] = keep + __shfl_xor(send, 8); }
    const float send = b2 ? s[0] : s[1], keep = b2 ? s[1] : s[0]; float v = keep + __shfl_xor(send, 4);
    v += __shfl_xor(v, 2); v += __shfl_xor(v, 1); return v;
}

struct ChunkVec { float g0, g1, b0, b1, cm0, cm1, btot, gmax; int s0, s1; };
struct ChunkGates { float i0, f0, i1, f1; int s0, s1; };
DI ChunkGates chunk_gates_load(int d, const float* gates, int t0, int head, int lane) {
    ChunkGates q; const int e0 = 2 * lane, e1 = e0 + 1; q.s0 = d ? 127 - e0 : e0; q.s1 = d ? 127 - e1 : e1;
    const float* g0p = gates + (size_t)(t0 + q.s0) * 16 + d * 4 + head; const float* g1p = gates + (size_t)(t0 + q.s1) * 16 + d * 4 + head;
    q.i0 = g0p[0]; q.f0 = g0p[8]; q.i1 = g1p[0]; q.f1 = g1p[8]; return q;
}
DI ChunkVec chunk_vectors_from(const ChunkGates& q, int lane) {
    ChunkVec r; r.s0 = q.s0; r.s1 = q.s1;
    const float i0 = q.i0, f0 = q.f0, i1 = q.i1, f1 = q.f1;
    const float lf0 = logsigmoid_(f0), lf1 = logsigmoid_(f1);
    float ps = lf0 + lf1;
#pragma unroll
    for (int o = 1; o < 64; o <<= 1) { const float t = __shfl_up(ps, o); if (lane >= o) ps += t; }
    const float excl = ps - (lf0 + lf1); r.b0 = excl + lf0; r.b1 = r.b0 + lf1;
    r.g0 = i0 - r.b0; r.g1 = i1 - r.b1;
    float cm = fmaxf(r.g0, r.g1);
#pragma unroll
    for (int o = 1; o < 64; o <<= 1) { const float t = __shfl_up(cm, o); if (lane >= o) cm = fmaxf(cm, t); }
    float ex = __shfl_up(cm, 1); if (lane == 0) ex = -INFINITY;
    r.cm0 = fmaxf(ex, r.g0); r.cm1 = fmaxf(r.cm0, r.g1);
    r.btot = __shfl(r.b1, 63); r.gmax = __shfl(r.cm1, 63);
    return r;
}
DI ChunkVec chunk_vectors(int d, const float* gates, int t0, int head, int lane) { return chunk_vectors_from(chunk_gates_load(d, gates, t0, head, lane), lane); }

struct Ctx {
    const float* in[17]; float* out; unsigned char* ws;
};

DI void summary_prefetch(const Ctx& c, int chunk, int head, int tid, u32x4 (&v8r)[4], u32x4 (&k8r)[4]) {
    const bf16_t* MK = (const bf16_t*)(c.ws + WS_MK); const bf16_t* MV = (const bf16_t*)(c.ws + WS_MV); const int t0 = chunk * 128;
#pragma unroll
    for (int i = 0; i < 4; ++i) { const int idx = tid + 512 * i, s = idx & 127, ch = idx >> 7; const size_t go = (size_t)(t0 + s) * 512 + head * 128 + ch * 8; v8r[i] = *(const u32x4*)(MV + go); k8r[i] = *(const u32x4*)(MK + go); }
}
DI void summary_unit(LAS unsigned char* lds, const Ctx& c, int chunk, int head, int nchunk, int nhead, u32x4 (&v8r)[4], u32x4 (&k8r)[4], int tid, int lane, int wid) {
    asm volatile("" : "+v"(tid), "+v"(lane));
    const int t0 = chunk * 128, fr = lane & 15, fq = lane >> 4;
    LAS bf16_t* LVT = (LAS bf16_t*)lds; LAS bf16_t* LKF = (LAS bf16_t*)(lds + 34816); LAS bf16_t* LKB = (LAS bf16_t*)(lds + 69632); LAS float* vW = (LAS float*)(lds + 104448);
    const float* gates = (const float*)(c.ws + WS_GATES);
    const bf16_t* MK = (const bf16_t*)(c.ws + WS_MK); const bf16_t* MV = (const bf16_t*)(c.ws + WS_MV);
    if (wid < 2) { const int d = wid; const ChunkVec v = chunk_vectors(d, gates, t0, head, lane);
        vW[d * 128 + v.s0] = __expf(v.g0 - v.gmax); vW[d * 128 + v.s1] = __expf(v.g1 - v.gmax);
        if (lane == 0) { float* sc = (float*)(c.ws + WS_CHSC) + ((size_t)(d * NCHUNK + chunk) * 4 + head) * 2; sc[0] = v.btot; sc[1] = v.btot + v.gmax; } }
    __syncthreads();
#pragma unroll
    for (int i = 0; i < 4; ++i) { const int idx = tid + 512 * i, s = idx & 127, ch = idx >> 7;
        const u32x4 v8 = v8r[i], k8 = k8r[i]; const float wf = vW[s], wb = vW[128 + s];
#pragma unroll
        for (int e = 0; e < 8; ++e) { const unsigned vw = v8[e >> 1], kw = k8[e >> 1]; const float kf = (e & 1) ? bfhi(kw) : bflo(kw);
            LVT[(8 * ch + e) * 136 + s] = (bf16_t)((e & 1) ? (vw >> 16) : (vw & 0xffffu));
            const unsigned fb = pk2(wf * kf, wb * kf); LKF[(8 * ch + e) * 136 + s] = (bf16_t)(fb & 0xffffu); LKB[(8 * ch + e) * 136 + s] = (bf16_t)(fb >> 16); } }
    summary_prefetch(c, nchunk, nhead, tid, v8r, k8r);
    __syncthreads();
    const int d = wid & 1, cgp = wid >> 1;
    LAS const unsigned char* LKD = (LAS const unsigned char*)(d ? LKB : LKF);
    bf16x8 Y[2][4];
#pragma unroll
    for (int ci = 0; ci < 2; ++ci)
#pragma unroll
        for (int ks = 0; ks < 4; ++ks) Y[ci][ks] = *(LAS const bf16x8*)(LKD + (32 * cgp + 8 * (fr >> 2) + 4 * ci + (fr & 3)) * 272 + (32 * ks + 8 * fq) * 2);
    bf16_t* ST = (bf16_t*)(c.out) + ((size_t)(d * NCHUNK + chunk) * 4 + head) * ST_ELEMS;
#pragma unroll
    for (int rt = 0; rt < 9; ++rt) {
        bf16x8 X[4];
#pragma unroll
        for (int ks = 0; ks < 4; ++ks) {
            if (rt < 8) X[ks] = *(LAS const bf16x8*)((LAS const unsigned char*)LVT + (16 * rt + fr) * 272 + (32 * ks + 8 * fq) * 2);
            else { const short o = fr == 0 ? (short)0x3F80 : (short)0; X[ks] = (bf16x8){o, o, o, o, o, o, o, o}; } }
        f32x4 a2[2];
#pragma unroll
        for (int ci = 0; ci < 2; ++ci) { a2[ci] = (f32x4){0.f, 0.f, 0.f, 0.f};
#pragma unroll
            for (int ks = 0; ks < 4; ++ks) a2[ci] = MFMA16(Y[ci][ks], X[ks], a2[ci]); }
        { const int v = 16 * rt + fr, k = 32 * cgp + 8 * fq;
          if (rt < 8 || fr == 0) { u32x4 w; w.x = pk2(a2[0][0], a2[0][1]); w.y = pk2(a2[0][2], a2[0][3]); w.z = pk2(a2[1][0], a2[1][1]); w.w = pk2(a2[1][2], a2[1][3]); *(u32x4*)(ST + (size_t)v * 128 + k) = w; } }
    }
    __syncthreads();
}

DI void attn_unit(LAS unsigned char* lds, const Ctx& c, int qb2, int hk, int tid, int lane, int wid) {
    asm volatile("" : "+v"(tid), "+v"(lane));
    const int t0 = qb2 * 256, fr = lane & 15, fq = lane >> 4;
    const int nseq = qb2 < 64 ? qb2 : ((qb2 - 64) & 15), Nseq = qb2 < 64 ? 64 : 16, pos0 = nseq * 256;
    const bool bv0 = nseq >= 1, bv3 = nseq + 1 < Nseq;
    LAS unsigned char* LKB = lds; LAS bf16_t* LVT = (LAS bf16_t*)(lds + 73728);
    const bf16_t* AK = (const bf16_t*)(c.ws + WS_AK); const bf16_t* AV = (const bf16_t*)(c.ws + WS_AV); const bf16_t* AQ = (const bf16_t*)(c.ws + WS_AQ);
    const float* rope = (const float*)(c.ws + WS_ROPE);
    const int g = wid >> 2, rg = wid & 3, hq = 2 * hk + g, r0 = 64 * rg;
#define ATT_OK(j) ((((j) >> 7) == 0) ? bv0 : ((((j) >> 7) == 3) ? bv3 : true))
    u32x4 kb[6];
#pragma unroll
    for (int i = 0; i < 6; ++i) { const int idx = tid + 512 * i; const int j = idx / 6, ch = 2 + (idx - 6 * j); const bool ok = ATT_OK(j);
        const int tok = ok ? t0 - 128 + j : t0 + (j & 127); kb[i] = *(const u32x4*)((const char*)AK + (unsigned)((tok * 256 + hk * 64 + ch * 8) * 2)); }
    u32x4 kx1, kx2; f32x4 ktb[4];
    { const int j = tid; const bool ok = ATT_OK(j); const int tok = ok ? t0 - 128 + j : t0 + (j & 127);
      const unsigned ko = (unsigned)((tok * 256 + hk * 64) * 2); kx1 = *(const u32x4*)((const char*)AK + ko); kx2 = *(const u32x4*)((const char*)AK + ko + 16u);
      const unsigned to = (unsigned)((ok ? pos0 - 128 + j : 0) * 64);
#pragma unroll
      for (int q = 0; q < 4; ++q) ktb[q] = *(const f32x4*)((const char*)rope + to + 16u * q); }
    u32x4 vb[8];
#pragma unroll
    for (int i = 0; i < 8; ++i) { const int idx = tid + 512 * i, ch = idx >> 9, j = idx & 511; const bool ok = ATT_OK(j);
        const int tok = ok ? t0 - 128 + j : t0 + (j & 127); vb[i] = *(const u32x4*)((const char*)AV + (unsigned)((tok * 256 + hk * 64 + ch * 8) * 2)); }
#pragma unroll
    for (int i = 0; i < 6; ++i) { const int idx = tid + 512 * i; const int j = idx / 6, ch = 2 + (idx - 6 * j); const bool ok = ATT_OK(j);
        *(LAS u32x4*)(LKB + j * 144 + ch * 16) = ok ? kb[i] : (u32x4){0u, 0u, 0u, 0u}; }
    { const int j = tid; const bool ok = ATT_OK(j);
      float ra[8], rb[8];
#pragma unroll
      for (int e = 0; e < 8; ++e) { const float a = (e & 1) ? bfhi(kx1[e >> 1]) : bflo(kx1[e >> 1]), b = (e & 1) ? bfhi(kx2[e >> 1]) : bflo(kx2[e >> 1]); const float cs = ktb[e >> 2][e & 3], sn = ktb[2 + (e >> 2)][e & 3];
          ra[e] = a * cs - b * sn; rb[e] = b * cs + a * sn; }
      u32x4 o1, o2; o1.x = pk2(ra[0], ra[1]); o1.y = pk2(ra[2], ra[3]); o1.z = pk2(ra[4], ra[5]); o1.w = pk2(ra[6], ra[7]); o2.x = pk2(rb[0], rb[1]); o2.y = pk2(rb[2], rb[3]); o2.z = pk2(rb[4], rb[5]); o2.w = pk2(rb[6], rb[7]);
      if (!ok) { o1 = (u32x4){0u, 0u, 0u, 0u}; o2 = o1; }
      *(LAS u32x4*)(LKB + j * 144) = o1; *(LAS u32x4*)(LKB + j * 144 + 16) = o2; }
#pragma unroll
    for (int i = 0; i < 8; ++i) { const int idx = tid + 512 * i, ch = idx >> 9, j = idx & 511; const bool ok = ATT_OK(j);
        const u32x4 v8 = ok ? vb[i] : (u32x4){0u, 0u, 0u, 0u};
#pragma unroll
        for (int e = 0; e < 8; ++e) { const unsigned vw = v8[e >> 1]; LVT[(8 * ch + e) * 520 + j] = (bf16_t)((e & 1) ? (vw >> 16) : (vw & 0xffffu)); } }
    asm volatile("" ::: "memory");
    const float sink = c.in[7][hq] * 1.4426950408889634f;
    bf16x8 Xq[4][2];
#pragma unroll
    for (int mi = 0; mi < 4; ++mi) { const int rho = r0 + 16 * mi + fr; const unsigned qo = (unsigned)(((t0 + rho) * 512 + hq * 64 + 8 * fq) * 2);
#pragma unroll
        for (int ks = 0; ks < 2; ++ks) {
            u32x4 q = *(const u32x4*)((const char*)AQ + qo + 64u * ks);
            if (ks == 0) { u32x4 pr; pr.x = __shfl_xor(q.x, 16); pr.y = __shfl_xor(q.y, 16); pr.z = __shfl_xor(q.z, 16); pr.w = __shfl_xor(q.w, 16);
                if (fq < 2) { float r[8]; const float* tb = rope + (size_t)(pos0 + rho) * 16;
#pragma unroll
                    for (int e = 0; e < 8; ++e) { const float own = (e & 1) ? bfhi(q[e >> 1]) : bflo(q[e >> 1]), oth = (e & 1) ? bfhi(pr[e >> 1]) : bflo(pr[e >> 1]); const float cs = tb[e], sn = tb[8 + e];
                        r[e] = fq == 0 ? (own * cs - oth * sn) : (own * cs + oth * sn); }
                    q.x = pk2(r[0], r[1]); q.y = pk2(r[2], r[3]); q.z = pk2(r[4], r[5]); q.w = pk2(r[6], r[7]); } }
            Xq[mi][ks] = __builtin_bit_cast(bf16x8, q); } }
    __syncthreads();
    f32x4 O[4][4]; float mrow[4], lrow[4];
#pragma unroll
    for (int mi = 0; mi < 4; ++mi) { mrow[mi] = sink; lrow[mi] = fq == 0 ? 1.f : 0.f;
#pragma unroll
        for (int nd = 0; nd < 4; ++nd) O[mi][nd] = (f32x4){0.f, 0.f, 0.f, 0.f}; }
    for (int kt = 0; kt < 10; ++kt) {
        const int j0 = r0 + 32 * kt;
        if (!ATT_OK(j0)) continue;
#pragma unroll
        for (int mh = 0; mh < 2; ++mh) {
            const int ra0 = r0 + 32 * mh;
            if (j0 + 31 < ra0 || j0 > ra0 + 31 + 256) continue;
            f32x4 S[2][2];
#pragma unroll
            for (int m2 = 0; m2 < 2; ++m2)
#pragma unroll
                for (int ni = 0; ni < 2; ++ni) S[m2][ni] = (f32x4){0.f, 0.f, 0.f, 0.f};
#pragma unroll
            for (int ks = 0; ks < 2; ++ks)
#pragma unroll
                for (int ni = 0; ni < 2; ++ni) { const bf16x8 Yk = *(LAS const bf16x8*)(LKB + (j0 + 16 * ni + fr) * 144 + (32 * ks + 8 * fq) * 2);
#pragma unroll
                    for (int m2 = 0; m2 < 2; ++m2) S[m2][ni] = MFMA16(Yk, Xq[2 * mh + m2][ks], S[m2][ni]); }
            bf16x8 Xp[2];
#pragma unroll
            for (int m2 = 0; m2 < 2; ++m2) { const int mi = 2 * mh + m2; const int rhoa = r0 + 16 * mi, rho = rhoa + fr;
                const bool full = (j0 >= rhoa + 15) && (j0 + 31 <= rhoa + 256);
                float mx = -INFINITY;
                if (full) {
#pragma unroll
                    for (int ni = 0; ni < 2; ++ni)
#pragma unroll
                        for (int jj = 0; jj < 4; ++jj) mx = fmaxf(mx, S[m2][ni][jj]);
                } else {
#pragma unroll
                    for (int ni = 0; ni < 2; ++ni)
#pragma unroll
                        for (int jj = 0; jj < 4; ++jj) { const int j = j0 + 16 * ni + 4 * fq + jj; const bool ok = (j >= rho) && (j <= rho + 256);
                            const float sv = ok ? S[m2][ni][jj] : -INFINITY; S[m2][ni][jj] = sv; mx = fmaxf(mx, sv); }
                }
                if (__builtin_amdgcn_ballot_w64(mx > mrow[mi] + 6.0f) != 0ull) {
                    mx = fmaxf(mx, __shfl_xor(mx, 16)); mx = fmaxf(mx, __shfl_xor(mx, 32));
                    const float mnew = fmaxf(mrow[mi], mx), alpha = __builtin_amdgcn_exp2f(mrow[mi] - mnew); mrow[mi] = mnew; lrow[mi] *= alpha;
#pragma unroll
                    for (int nd = 0; nd < 4; ++nd) O[mi][nd] *= alpha; }
                const float mref = mrow[mi];
                float p[8], ps = 0.f;
#pragma unroll
                for (int e = 0; e < 8; ++e) { p[e] = __builtin_amdgcn_exp2f(S[m2][e >> 2][e & 3] - mref); ps += p[e]; }
                lrow[mi] += ps;
                Xp[m2] = pack8(p); }
#pragma unroll
            for (int nd = 0; nd < 4; ++nd) { const LAS bf16_t* vp = LVT + (32 * (nd >> 1) + 8 * (fr >> 2) + 4 * (nd & 1) + (fr & 3)) * 520 + j0 + 4 * fq;
                const s16x4 lo = *(LAS const s16x4*)vp, hi = *(LAS const s16x4*)(vp + 16);
                const bf16x8 Yv = (bf16x8){lo[0], lo[1], lo[2], lo[3], hi[0], hi[1], hi[2], hi[3]};
#pragma unroll
                for (int m2 = 0; m2 < 2; ++m2) O[2 * mh + m2][nd] = MFMA16(Yv, Xp[m2], O[2 * mh + m2][nd]); }
        }
    }
#pragma unroll
    for (int mi = 0; mi < 4; ++mi) { float l = lrow[mi]; l += __shfl_xor(l, 16); l += __shfl_xor(l, 32); const float inv = 1.f / l;
        bf16_t* op = (bf16_t*)(c.ws + WS_HMOA) + (size_t)(t0 + r0 + 16 * mi + fr) * 1024 + 512 + hq * 64 + 8 * fq;
#pragma unroll
        for (int p2 = 0; p2 < 2; ++p2) { const f32x4 o0 = O[mi][2 * p2] * inv, o1 = O[mi][2 * p2 + 1] * inv;
            u32x4 w; w.x = pk2(o0[0], o0[1]); w.y = pk2(o0[2], o0[3]); w.z = pk2(o1[0], o1[1]); w.w = pk2(o1[2], o1[3]); *(u32x4*)(op + 32 * p2) = w; } }
    __syncthreads();
#undef ATT_OK
}

DI void scan_item(const Ctx& c, int st, int slice, int lane) {
    const int seq = st >> 3, head = (st >> 1) & 3, d = st & 1;
    const int chunk0 = seq == 0 ? 0 : 128 + 32 * (seq - 1), nch = seq == 0 ? 128 : 32;
    const int e0 = slice * 512 + lane * 8; const bool act = e0 < ST_ELEMS;
    bf16_t* CST = (bf16_t*)c.out; const float* CHSC = (const float*)(c.ws + WS_CHSC); float* MP = (float*)(c.ws + WS_MPREV);
    float C[8];
#pragma unroll
    for (int e = 0; e < 8; ++e) C[e] = 0.f;
    float m = 0.f;
    for (int i0 = 0; i0 < nch; i0 += 8) {
        u32x4 ld[8]; float bt[8], ml[8];
#pragma unroll
        for (int u = 0; u < 8; ++u) { const int ch = d ? chunk0 + nch - 1 - (i0 + u) : chunk0 + i0 + u; const size_t ti = (size_t)(d * NCHUNK + ch) * 4 + head;
            ld[u] = act ? *(const u32x4*)(CST + ti * ST_ELEMS + e0) : (u32x4){0u, 0u, 0u, 0u}; bt[u] = CHSC[ti * 2]; ml[u] = CHSC[ti * 2 + 1]; }
#pragma unroll
        for (int u = 0; u < 8; ++u) { const int ch = d ? chunk0 + nch - 1 - (i0 + u) : chunk0 + i0 + u; const size_t ti = (size_t)(d * NCHUNK + ch) * 4 + head;
            if (slice == 0 && lane == 0) MP[ti] = m;
            u32x4 o; o.x = pk2(C[0], C[1]); o.y = pk2(C[2], C[3]); o.z = pk2(C[4], C[5]); o.w = pk2(C[6], C[7]);
            if (act) *(u32x4*)(CST + ti * ST_ELEMS + e0) = o;
            const float mn = fmaxf(bt[u] + m, ml[u]), sp = __expf(bt[u] + m - mn), sl = __expf(ml[u] - mn); m = mn;
#pragma unroll
            for (int e = 0; e < 8; ++e) { const unsigned w = ld[u][e >> 1]; const float cl = (e & 1) ? bfhi(w) : bflo(w); C[e] = sp * C[e] + sl * cl; } }
    }
}

template <int DIR> DI void dir_pass(const f32x4 (&S)[8], const bf16x8 (&Xq)[4], LAS const unsigned char* LS, LAS const unsigned char* LVTb, LAS const float* vec, int trow, int fr, int fq, f32x4 (&hs)[8]) {
    f32x4 acc[9];
#pragma unroll
    for (int nt = 0; nt < 9; ++nt) { acc[nt] = (f32x4){0.f, 0.f, 0.f, 0.f};
#pragma unroll
        for (int ks = 0; ks < 4; ++ks) { const bf16x8 Y = *(LAS const bf16x8*)(LS + (16 * nt + fr) * 272 + (32 * ks + 8 * fq) * 2); acc[nt] = MFMA16(Y, Xq[ks], acc[nt]); } asm volatile("" ::: "memory"); }
    const float Mt = vec[128 + trow], ex = vec[256 + trow], iw = vec[384 + trow];
#pragma unroll
    for (int nt = 0; nt < 9; ++nt) acc[nt] *= iw;
    bf16x8 Xp[4];
#pragma unroll
    for (int kp = 0; kp < 4; ++kp) { float p[8];
#pragma unroll
        for (int h2 = 0; h2 < 2; ++h2) { const int n = 2 * kp + h2; const f32x4 g4 = *(LAS const f32x4*)(vec + 16 * n + 4 * fq);
#pragma unroll
            for (int j = 0; j < 4; ++j) { const int s = 16 * n + 4 * fq + j; const bool ok = DIR == 0 ? (s <= trow) : (s >= trow);
                p[4 * h2 + j] = ok ? S[n][j] * __builtin_amdgcn_exp2f(g4[j] - Mt) : 0.f; } }
        Xp[kp] = pack8(p); }
#pragma unroll
    for (int nt = 0; nt < 8; ++nt)
#pragma unroll
        for (int kp = 0; kp < 4; ++kp) { LAS const unsigned char* vp = LVTb + (16 * nt + fr) * 272 + (32 * kp + 4 * fq) * 2;
            const s16x4 lo = *(LAS const s16x4*)vp, hi = *(LAS const s16x4*)(vp + 32);
            const bf16x8 Y = (bf16x8){lo[0], lo[1], lo[2], lo[3], hi[0], hi[1], hi[2], hi[3]};
            acc[nt] = MFMA16(Y, Xp[kp], acc[nt]); if (kp == 3) asm volatile("" ::: "memory"); }
    { const short o = fr == 0 ? (short)0x3F80 : (short)0; const bf16x8 ones = (bf16x8){o, o, o, o, o, o, o, o};
#pragma unroll
        for (int kp = 0; kp < 4; ++kp) acc[8] = MFMA16(ones, Xp[kp], acc[8]); }
    const float den = __shfl(acc[8][0], fr);
    const float inv = 1.f / fmaxf(fabsf(den), ex);
#pragma unroll
    for (int nt = 0; nt < 8; ++nt) { if (DIR == 0) hs[nt] = acc[nt] * inv; else hs[nt] += acc[nt] * inv; }
}
DI void mlstm_prefetch_states(const Ctx& c, int chunk, int head, int tid, u32x4 (&sbr)[5], u32x4 (&sfr)[5]) {
    const bf16_t* CSTF = (const bf16_t*)c.out + ((size_t)(0 * NCHUNK + chunk) * 4 + head) * ST_ELEMS; const bf16_t* CSTB = (const bf16_t*)c.out + ((size_t)(1 * NCHUNK + chunk) * 4 + head) * ST_ELEMS;
#pragma unroll
    for (int i = 0; i < 5; ++i) { int idx = tid + 512 * i; idx = idx < 2304 ? idx : 2303; const int r = idx >> 4, ch = idx & 15, rc = r < 129 ? r : 128;
        sbr[i] = *(const u32x4*)(CSTB + rc * 128 + ch * 8); sfr[i] = *(const u32x4*)(CSTF + rc * 128 + ch * 8); }
}
DI void mlstm_out_unit(LAS unsigned char* lds, const Ctx& c, int chunk, int head, int nchunk, int nhead, u32x4 (&sbr)[5], u32x4 (&sfr)[5], int tid, int lane, int wid) {
    asm volatile("" : "+v"(tid), "+v"(lane));
    const int t0 = chunk * 128, fr = lane & 15, fq = lane >> 4;
    LAS unsigned char* LQ = lds; LAS unsigned char* LK = lds + 34816; LAS unsigned char* LVTb = lds + 73984; LAS unsigned char* LSB = lds + 108800; LAS float* vec = (LAS float*)(lds + 147968);
    LAS bf16_t* LVT = (LAS bf16_t*)LVTb;
    const bf16_t* MQ = (const bf16_t*)(c.ws + WS_MQ); const bf16_t* MK = (const bf16_t*)(c.ws + WS_MK); const bf16_t* MV = (const bf16_t*)(c.ws + WS_MV); bf16_t* MO = (bf16_t*)(c.ws + WS_MO);
    const bf16_t* CSTF = (const bf16_t*)c.out + ((size_t)(0 * NCHUNK + chunk) * 4 + head) * ST_ELEMS; const bf16_t* CSTB = (const bf16_t*)c.out + ((size_t)(1 * NCHUNK + chunk) * 4 + head) * ST_ELEMS;
    ChunkGates cgq; cgq.i0 = cgq.f0 = cgq.i1 = cgq.f1 = 0.f; cgq.s0 = cgq.s1 = 0; float mp_early = 0.f;
    if (wid < 2) { cgq = chunk_gates_load(wid, (const float*)(c.ws + WS_GATES), t0, head, lane); mp_early = ((const float*)(c.ws + WS_MPREV))[(size_t)(wid * NCHUNK + chunk) * 4 + head]; }
    u32x4 qr[4], kr[4], vr[4];
#pragma unroll
    for (int i = 0; i < 4; ++i) { const int idx = tid + 512 * i, r = idx >> 4, ch = idx & 15; const size_t go = (size_t)(t0 + r) * 512 + head * 128 + ch * 8; qr[i] = *(const u32x4*)(MQ + go); kr[i] = *(const u32x4*)(MK + go); }
#pragma unroll
    for (int i = 0; i < 4; ++i) { const int idx = tid + 512 * i, s = idx & 127, ch = idx >> 7; vr[i] = *(const u32x4*)(MV + (size_t)(t0 + s) * 512 + head * 128 + ch * 8); }
#pragma unroll
    for (int i = 0; i < 4; ++i) { const int idx = tid + 512 * i, r = idx >> 4, ch = idx & 15; *(LAS u32x4*)(LQ + r * 272 + ch * 16) = qr[i]; *(LAS u32x4*)(LK + r * 272 + ch * 16) = kr[i]; }
#pragma unroll
    for (int i = 0; i < 4; ++i) { const int idx = tid + 512 * i, s = idx & 127, ch = idx >> 7; const u32x4 v8 = vr[i];
#pragma unroll
        for (int e = 0; e < 8; ++e) { const unsigned vw = v8[e >> 1]; LVT[(8 * ch + e) * 136 + s] = (bf16_t)((e & 1) ? (vw >> 16) : (vw & 0xffffu)); } }
#pragma unroll
    for (int i = 0; i < 5; ++i) { int idx = tid + 512 * i; idx = idx < 2304 ? idx : 2303; const int r = idx >> 4, ch = idx & 15;
        *(LAS u32x4*)(LSB + r * 272 + ch * 16) = r < 129 ? sbr[i] : (u32x4){0u, 0u, 0u, 0u}; }
    if (wid < 2) { const int d = wid; const ChunkVec v = chunk_vectors_from(cgq, lane);
        const float mp = mp_early;
        LAS float* vd = vec + d * 512; const float M0 = fmaxf(mp, v.cm0), M1 = fmaxf(mp, v.cm1);
        constexpr float L2E = 1.4426950408889634f;
        vd[v.s0] = v.g0 * L2E; vd[128 + v.s0] = M0 * L2E; vd[256 + v.s0] = __expf(-(v.b0 + M0)); vd[384 + v.s0] = __expf(mp - M0);
        vd[v.s1] = v.g1 * L2E; vd[128 + v.s1] = M1 * L2E; vd[256 + v.s1] = __expf(-(v.b1 + M1)); vd[384 + v.s1] = __expf(mp - M1); }
    __syncthreads();
    const int trow = 16 * wid + fr;
    bf16x8 Xq[4];
#pragma unroll
    for (int ks = 0; ks < 4; ++ks) Xq[ks] = *(LAS const bf16x8*)(LQ + trow * 272 + (32 * ks + 8 * fq) * 2);
    f32x4 S[8];
#pragma unroll
    for (int n = 0; n < 8; ++n) { S[n] = (f32x4){0.f, 0.f, 0.f, 0.f};
#pragma unroll
        for (int ks = 0; ks < 4; ++ks) { const bf16x8 Yk = *(LAS const bf16x8*)(LK + (16 * n + fr) * 272 + (32 * ks + 8 * fq) * 2); S[n] = MFMA16(Yk, Xq[ks], S[n]); } }
    __syncthreads();
#pragma unroll
    for (int i = 0; i < 5; ++i) { int idx = tid + 512 * i; idx = idx < 2304 ? idx : 2303; const int r = idx >> 4, ch = idx & 15;
        *(LAS u32x4*)(LK + r * 272 + ch * 16) = r < 129 ? sfr[i] : (u32x4){0u, 0u, 0u, 0u}; }
    __syncthreads();
    mlstm_prefetch_states(c, nchunk, nhead, tid, sbr, sfr);
    f32x4 hs[8];
    dir_pass<0>(S, Xq, LK, LVTb, vec, trow, fr, fq, hs);
    dir_pass<1>(S, Xq, LSB, LVTb, vec + 512, trow, fr, fq, hs);
    float sum = 0.f;
#pragma unroll
    for (int nt = 0; nt < 8; ++nt) sum += (hs[nt][0] + hs[nt][1]) + (hs[nt][2] + hs[nt][3]);
    sum += __shfl_xor(sum, 16); sum += __shfl_xor(sum, 32);
    const float mean = sum * (1.f / 128.f); float var = 0.f;
#pragma unroll
    for (int nt = 0; nt < 8; ++nt) { hs[nt] -= mean; var += (hs[nt][0] * hs[nt][0] + hs[nt][1] * hs[nt][1]) + (hs[nt][2] * hs[nt][2] + hs[nt][3] * hs[nt][3]); }
    var += __shfl_xor(var, 16); var += __shfl_xor(var, 32);
    const float rstd = __builtin_amdgcn_rsqf(var * (1.f / 128.f) + EPS);
    const float* nw = c.in[6] + head * 128; bf16_t* mop = MO + (size_t)(t0 + trow) * 512 + head * 128;
#pragma unroll
    for (int nt = 0; nt < 8; ++nt) { const int v = 16 * nt + 4 * fq; const u32x2 mo4 = *(const u32x2*)(mop + v); const f32x4 w4 = *(const f32x4*)(nw + v);
        const float o0 = hs[nt][0] * rstd * w4[0] * sigmoidf_(bflo(mo4.x)), o1 = hs[nt][1] * rstd * w4[1] * sigmoidf_(bfhi(mo4.x));
        const float o2 = hs[nt][2] * rstd * w4[2] * sigmoidf_(bflo(mo4.y)), o3 = hs[nt][3] * rstd * w4[3] * sigmoidf_(bfhi(mo4.y));
        u32x2 w; w.x = pk2(o0, o1); w.y = pk2(o2, o3); *(u32x2*)((bf16_t*)(c.ws + WS_HMOA) + (size_t)(t0 + trow) * 1024 + head * 128 + v) = w; }
    __syncthreads();
}

struct Args { const float* in[17]; float* out; unsigned char* ws; int ph_lo, ph_hi; };
constexpr int NPHASE = 9;

__global__ void __launch_bounds__(512, 2) mega(Args args) {
    extern __shared__ __attribute__((aligned(16))) unsigned char lds_raw[];
    LAS unsigned char* lds = (LAS unsigned char*)lds_raw;
    cg::grid_group grid = cg::this_grid();
    const int tid = threadIdx.x, lane = tid & 63, wid = __builtin_amdgcn_readfirstlane(tid >> 6);
    const int G = gridDim.x, gw = blockIdx.x * 8 + wid, NGW = G * 8;
    Ctx c;
#pragma unroll
    for (int i = 0; i < 17; ++i) c.in[i] = args.in[i];
    c.out = args.out; c.ws = args.ws;
    unsigned char* ws = args.ws;
    const int lo = args.ph_lo, hi = args.ph_hi;
#ifndef PH_MASK
#define PH_MASK 0x3ff
#endif
#define IN(k) (((PH_MASK >> (k)) & 1) && lo <= (k) && (k) < hi)
#define REP(k) for (int rep_ = 0; rep_ < (((DUP_MASK >> (k)) & 1) ? 2 : 1); ++rep_)
#define SEAM(k) do { if (IN(k) && IN((k) + 1)) grid.sync(); } while (0)

    REP(0) if (IN(0)) {
        LAS float* scr = (LAS float*)(lds + wid * 16384);
        for (int i = blockIdx.x * 512 + tid; i < 320 * 64; i += G * 512) ((unsigned*)(ws + WS_CTL))[i] = 0u;
        constexpr int I_W1 = 160 * 16, I_PM = 32 * 8, I_PA = 32 * 8, I_WO = 32 * 16, I_UP = 176 * 16, I_WD = 32 * 44;
        constexpr int NITEMS = I_W1 + I_PM + I_PA + I_WO + I_UP + I_WD;
        for (int it = gw; it < NITEMS; it += NGW) {
            int r = it;
            if (r < I_W1) { const int nb = r >> 4, kb = r & 15, dr = 32 * nb, sc = dr < 2048 ? dr : dr + 16;
                const float ns = (dr >= 512 && dr < 1024) ? 0.08838834764831845f : ((dr >= 2048 && dr < 2560) ? 0.18033688011112042f   : 1.f);
                transpose_item(c.in[3], DIN, sc, 64 * kb, (bf16_t*)(ws + WS_W1), 1024, dr, c.in[2], ns, scr, lane); continue; } r -= I_W1;
            if (r < I_PM) { const int nb = r >> 3, kb = r & 7; transpose_item(c.in[8], 1024, 32 * nb, 64 * kb, (bf16_t*)(ws + WS_W1) + (size_t)5120 * 1024, 1024, 32 * nb, nullptr, 1.f, scr, lane); continue; } r -= I_PM;
            if (r < I_PA) { const int nb = r >> 3, kb = r & 7; transpose_item(c.in[9], 1024, 32 * nb, 64 * kb, (bf16_t*)(ws + WS_W1) + (size_t)5120 * 1024 + 512, 1024, 32 * nb, nullptr, 1.f, scr, lane); continue; } r -= I_PA;
            if (r < I_WO) { const int nb = r >> 4, kb = r & 15; transpose_item(c.in[10], 1024, 32 * nb, 64 * kb, (bf16_t*)(ws + WS_WO), 1024, 32 * nb, nullptr, 1.f, scr, lane); continue; } r -= I_WO;
            if (r < I_UP) { const int nb = r >> 4, kb = r & 15, sc = 32 * nb; const int half = sc >= DFF ? 1 : 0, ch = sc - half * DFF; const int dr = 256 * (ch >> 7) + 128 * half + (ch & 127);
                transpose_item(c.in[12], NUP, sc, 64 * kb, (bf16_t*)(ws + WS_WUP), 1024, dr, c.in[11], 1.f, scr, lane); continue; } r -= I_UP;
            { const int nb = r / 44, kb = r - nb * 44; transpose_item(c.in[15], 1024, 32 * nb, 64 * kb, (bf16_t*)(ws + WS_WD), DFF, 32 * nb, nullptr, 1.f, scr, lane); }
        }
        {
            float* rope = (float*)(ws + WS_ROPE);
            for (int i = blockIdx.x * 512 + tid; i < 16384 * 8; i += G * 512) { const int pos = i >> 3, d = i & 7;
                const float invf = d == 0 ? 1.0f : d == 1 ? 0.1939227432012558f : d == 2 ? 0.03760603070259094f : d == 3 ? 0.007292664609849453f : d == 4 ? 0.0014142135623842478f
                                 : d == 5 ? 0.00027424818836152554f : d == 6 ? 5.3182957344688475e-05f : 1.0313385246263351e-05f;
                const float ang = (float)pos * invf; const float k = rintf(ang * 0.15915494309189535f);
                float rr = fmaf(-k, 6.2831854820251465f, ang); rr = fmaf(-k, -1.7484556025237907e-07f, rr);
                rope[pos * 16 + d] = cosf(rr); rope[pos * 16 + 8 + d] = sinf(rr); }
        }
        __syncthreads();
        LAS float* wg = (LAS float*)lds;
        for (int i = tid; i < 16384; i += 512) { const int k = i >> 4, j = i & 15; wg[j * 1024 + k] = c.in[2][k] * c.in[3][(size_t)k * DIN + 2048 + j]; }
        __syncthreads();
        bf16_t* XN = (bf16_t*)(ws + WS_XN); float* gates = (float*)(ws + WS_GATES);
        const float bias = (lane >> 2) < 8 ? c.in[4][lane >> 2] : c.in[5][(lane >> 2) - 8];
        f32x4 va[4], vb[4];
        { const int r0 = gw * 2 < MTOK ? gw * 2 : 0; const f32x4* xa = (const f32x4*)xrow_ptr(c.in[0], c.in[1], r0) + lane; const f32x4* xb = (const f32x4*)xrow_ptr(c.in[0], c.in[1], r0 + 1) + lane;
#pragma unroll
          for (int j = 0; j < 4; ++j) { va[j] = xa[64 * j]; vb[j] = xb[64 * j]; } }
        for (int r0 = gw * 2; r0 < MTOK; r0 += NGW * 2) {
            f32x4 na[4], nb[4];
            { const int rn = r0 + NGW * 2 < MTOK ? r0 + NGW * 2 : r0; const f32x4* xa = (const f32x4*)xrow_ptr(c.in[0], c.in[1], rn) + lane; const f32x4* xb = (const f32x4*)xrow_ptr(c.in[0], c.in[1], rn + 1) + lane;
#pragma unroll
              for (int j = 0; j < 4; ++j) { na[j] = xa[64 * j]; nb[j] = xb[64 * j]; } }
            float sa = 0.f, sb = 0.f;
#pragma unroll
            for (int j = 0; j < 4; ++j) {
                sa += (va[j][0] * va[j][0] + va[j][1] * va[j][1]) + (va[j][2] * va[j][2] + va[j][3] * va[j][3]); sb += (vb[j][0] * vb[j][0] + vb[j][1] * vb[j][1]) + (vb[j][2] * vb[j][2] + vb[j][3] * vb[j][3]); }
            const float rsa = 1.f / sqrtf(wave_sum(sa) * (1.f / DM) + EPS), rsb = 1.f / sqrtf(wave_sum(sb) * (1.f / DM) + EPS);
            float pa[16], pb[16];
#pragma unroll
            for (int g = 0; g < 16; ++g) { float qa = 0.f, qb = 0.f;
#pragma unroll
                for (int j = 0; j < 4; ++j) { const f32x4 w = *(LAS const f32x4*)(wg + g * 1024 + 256 * j + 4 * lane);
                    qa += (va[j][0] * w[0] + va[j][1] * w[1]) + (va[j][2] * w[2] + va[j][3] * w[3]); qb += (vb[j][0] * w[0] + vb[j][1] * w[1]) + (vb[j][2] * w[2] + vb[j][3] * w[3]); }
                pa[g] = qa; pb[g] = qb; asm volatile("" ::: "memory"); }
            const float ga_ = reduce16(pa, lane), gb_ = reduce16(pb, lane);
            if ((lane & 3) == 0) { gates[(size_t)r0 * 16 + (lane >> 2)] = rsa * ga_ + bias; gates[(size_t)(r0 + 1) * 16 + (lane >> 2)] = rsb * gb_ + bias; }
            unsigned long long* oa = (unsigned long long*)(XN + (size_t)r0 * DM) + lane; unsigned long long* ob = (unsigned long long*)(XN + (size_t)(r0 + 1) * DM) + lane;
#pragma unroll
            for (int j = 0; j < 4; ++j) {
                oa[64 * j] = (unsigned long long)pk2(va[j][0] * rsa, va[j][1] * rsa) | ((unsigned long long)pk2(va[j][2] * rsa, va[j][3] * rsa) << 32);
                ob[64 * j] = (unsigned long long)pk2(vb[j][0] * rsb, vb[j][1] * rsb) | ((unsigned long long)pk2(vb[j][2] * rsb, vb[j][3] * rsb) << 32); }
#pragma unroll
            for (int j = 0; j < 4; ++j) { va[j] = na[j]; vb[j] = nb[j]; }
        }
        __syncthreads();
    }
    SEAM(0);

    if (IN(1)) {
        pg8::Gemm g{(const bf16_t*)(ws + WS_XN), (const bf16_t*)(ws + WS_W1), nullptr, nullptr, 1024};
        pg8::DupOrder S; S.s.init(MTOK / 256, 12, G, (int)blockIdx.x); S.dup = (DUP_MASK >> 1) & 1;
        pg8::EpiProj E{ws};
        pg8::gemm_phase<pg8::EpiProj, pg8::DupOrder, true, false>(lds, g, S, E);
    }
    SEAM(1);

    if (IN(2)) {
        constexpr int NSU = NCHUNK * 4, NAU = (NCHUNK / 2) * 4;
        u32x4 v8r[4], k8r[4];
        if ((int)blockIdx.x < NSU) summary_prefetch(c, (int)blockIdx.x >> 2, (int)blockIdx.x & 3, tid, v8r, k8r);
        for (int it0 = blockIdx.x; it0 < (((DUP_MASK >> 2) & 1) ? 2 : 1) * (NSU + NAU); it0 += G) { const int it = it0 >= NSU + NAU ? it0 - (NSU + NAU) : it0;
            if (it < NSU) { const int nx = it0 + G < NSU ? it0 + G : it; summary_unit(lds, c, it >> 2, it & 3, nx >> 2, nx & 3, v8r, k8r, tid, lane, wid); }
            else { const int a = it - NSU; attn_unit(lds, c, a >> 2, a & 3, tid, lane, wid); }
        }
    }
    SEAM(2);

    REP(3) if (IN(3)) {
        constexpr int NPI = 8 * 33, NSI = 128 * 33;
        if (NGW > 2 * NPI) {
            if (gw < NPI) scan_item(c, gw / 33, gw % 33, lane);
            else { const int stride = NGW - NPI; for (int j = gw - NPI; j < NSI; j += stride) scan_item(c, 8 + j / 33, j % 33, lane); }
        } else {
            for (int j = gw; j < NPI + NSI; j += NGW) scan_item(c, j / 33, j % 33, lane);
        }
    }
    SEAM(3);

    REP(4) if (IN(4)) {
        u32x4 sbr[5], sfr[5];
        if ((int)blockIdx.x < NCHUNK * 4) mlstm_prefetch_states(c, (int)blockIdx.x >> 2, (int)blockIdx.x & 3, tid, sbr, sfr);
        for (int it = blockIdx.x; it < NCHUNK * 4; it += G) { const int nx = it + G < NCHUNK * 4 ? it + G : it; mlstm_out_unit(lds, c, it >> 2, it & 3, nx >> 2, nx & 3, sbr, sfr, tid, lane, wid); }
    }
    SEAM(4);

    if (IN(5)) {
        const bf16_t* W1t = (const bf16_t*)(ws + WS_W1);
        pg8::Gemm gg{(const bf16_t*)(ws + WS_XN), W1t + (size_t)3072 * 1024, (const bf16_t*)(ws + WS_XN), W1t + (size_t)4096 * 1024, 1024, 0};
        pg8::Gemm gx{(const bf16_t*)(ws + WS_HMOA), W1t + (size_t)5120 * 1024, (const bf16_t*)(ws + WS_HMOA) + 512, W1t + (size_t)5120 * 1024 + 512, 1024, 8};
        pg8::StaticOrder SO; SO.init(MTOK / 256, DM / 256, G, (int)blockIdx.x);
        pg8::EpiGate EG{ws + WS_QSCR}; pg8::EpiMix EM{(bf16_t*)(ws + WS_Y), ws + WS_QSCR};
        pg8::Unit tu;
        for (int k = 0; SO.next(k, tu); ++k) {
            pg8::TileOrder T{tu.pm, tu.pn};
            pg8::gemm_phase<pg8::EpiGate, pg8::TileOrder, true, false>(lds, gg, T, EG);
            pg8::gemm_phase<pg8::EpiMix, pg8::TileOrder, true, false>(lds, gx, T, EM);
        }
    }
    SEAM(5);

    if (IN(6)) {
        pg8::Gemm g{(const bf16_t*)(ws + WS_Y), (const bf16_t*)(ws + WS_WO), nullptr, nullptr, 1024};
        pg8::DupOrder S; S.s.init(MTOK / 256, DM / 256, G, (int)blockIdx.x); S.dup = (DUP_MASK >> 6) & 1;
        pg8::EpiRes<true> E{c.in[0], c.in[1], c.out, (bf16_t*)(ws + WS_HN), (float*)(ws + WS_SS)};
        pg8::gemm_phase<pg8::EpiRes<true>, pg8::DupOrder, true, false>(lds, g, S, E);
    }
    SEAM(6);

    if (IN(7)) {
        pg8::Gemm g{(const bf16_t*)(ws + WS_HN), (const bf16_t*)(ws + WS_WUP), nullptr, nullptr, 1024};
        pg8::DupOrder S; S.s.init(323, NUP / 256, G, (int)blockIdx.x); S.dup = (DUP_MASK >> 7) & 1;
        pg8::EpiConv E{(bf16_t*)(ws + WS_G), (const float*)(ws + WS_SS), c.in[13], c.in[14], (LAS float*)(lds + 131072)};
        pg8::gemm_phase<pg8::EpiConv, pg8::DupOrder, true, true>(lds, g, S, E);
    }
    SEAM(7);

    if (IN(8)) {
        pg8::Gemm g{(const bf16_t*)(ws + WS_G), (const bf16_t*)(ws + WS_WD), nullptr, nullptr, DFF};
        pg8::StaticOrder S; S.init(MTOK / 256, DM / 256, G, (int)blockIdx.x);
        pg8::EpiFinal E{c.out, (const bf16_t*)(ws + WS_HN), c.in[16], (unsigned*)(ws + WS_SS), (unsigned*)(ws + WS_CTL)};
        pg8::gemm_phase<pg8::EpiFinal, pg8::StaticOrder, true, false>(lds, g, S, E);
    }
#undef IN
#undef SEAM
}

extern "C" void kernel_launch(void* const* d_in, const int* in_sizes, int n_in, void* d_out, int out_size, void* d_ws, size_t ws_size, hipStream_t stream) {
    static int grid = 0;
    if (grid == 0) {
        if (n_in != 17 || out_size != MTOK * DM || ws_size < WS_END2) { fprintf(stderr, "kernel_launch: unexpected problem (n_in %d out %d ws %zu)\n", n_in, out_size, ws_size); grid = -1; return; }
        int dev = 0, cus = 0, per_cu = 0;
        if (hipGetDevice(&dev) != hipSuccess || hipDeviceGetAttribute(&cus, hipDeviceAttributeMultiprocessorCount, dev) != hipSuccess) { grid = -1; return; }
        if (hipFuncSetAttribute((const void*)mega, hipFuncAttributeMaxDynamicSharedMemorySize, LDS_BYTES) != hipSuccess) { fprintf(stderr, "kernel_launch: hipFuncSetAttribute failed\n"); grid = -1; return; }
        if (hipOccupancyMaxActiveBlocksPerMultiprocessor(&per_cu, (const void*)mega, 512, LDS_BYTES) != hipSuccess || per_cu < 1) { fprintf(stderr, "kernel_launch: occupancy query says %d\n", per_cu); per_cu = 1; }
        (void)hipGetLastError();
        grid = cus * per_cu;
    }
    if (grid < 0) return;
    Args a{};
    for (int i = 0; i < 17; ++i) a.in[i] = (const float*)d_in[i];
    a.out = (float*)d_out; a.ws = (unsigned char*)d_ws;
#if MK_SINGLE
    a.ph_lo = 0; a.ph_hi = NPHASE;
    void* kargs[] = {&a};
    hipError_t e = hipLaunchCooperativeKernel((const void*)mega, dim3(grid), dim3(512), kargs, LDS_BYTES, stream);
    if (e != hipSuccess) fprintf(stderr, "cooperative launch failed: %s (grid %d)\n", hipGetErrorString(e), grid);
#else
    for (int p = 0; p < NPHASE; ++p) { a.ph_lo = p; a.ph_hi = p + 1; hipLaunchKernelGGL(mega, dim3(grid), dim3(512), LDS_BYTES, stream, a); }
#endif
}
```
